# Optimizing an MI355X kernel written in HIP

```python
import math
import jax, jax.numpy as jnp
from jax import lax
import numpy as np

D_MODEL = 1024
BATCH = 2
SEQ = 8192
DEPTH = 2

ATT_HEADS = 8
ATT_QK_DIM = 64
ATT_V_DIM = 2 * ATT_QK_DIM
ATT_QK_WIDTH = ATT_HEADS * 2 * ATT_QK_DIM
ATT_WIDTH = ATT_HEADS * ATT_V_DIM
Q_BLOCK = 128
ROPE_THETA = 10000.0
LAMBDA_STD = 0.1
CONV_WIDTH = D_MODEL
CONV_TAPS = 31
CONV_LN_EPS = 1e-5
RWKV_WIDTH = D_MODEL
RWKV_HEAD_DIM = 64
RWKV_HEADS = RWKV_WIDTH // RWKV_HEAD_DIM
DECAY_LORA = 64
AAA_LORA = 64
GATE_LORA = 128
RWKV_GN_EPS = 64e-5
ATT_IN = 2 * ATT_QK_WIDTH + ATT_WIDTH
CONV_IN = 2 * CONV_WIDTH
RWKV_IN = 3 * RWKV_WIDTH + DECAY_LORA + AAA_LORA + GATE_LORA
N_BRANCH = 3
GATE_IN = N_BRANCH * D_MODEL
C_IN = ATT_IN + CONV_IN + RWKV_IN + GATE_IN
PEER_HEADS = 8
PEER_TOPK = 16
N_KEYS = 128
N_EXPERTS = N_KEYS * N_KEYS
PEER_QUERY_DIM = 256
PEER_HALF = PEER_QUERY_DIM // 2
PEER_CHUNK = 128
NORM_EPS = 1e-6
MAX_POS_OFFSET = 4096

kernel_name = "hybrid_gated_diffattn_conformer_rwkv7_peer"


def rms_norm(x, gain, eps=NORM_EPS):
    xf = x.astype(jnp.float32)
    y = xf * lax.rsqrt(jnp.mean(xf * xf, axis=-1, keepdims=True) + eps)
    return (y * gain.astype(jnp.float32)).astype(x.dtype)


def modulate(h, shift, scale):
    return h * (1.0 + scale[:, None, :]) + shift[:, None, :]


def rope_tables(positions):
    half = ATT_QK_DIM // 2
    inv = ROPE_THETA ** (-jnp.arange(half, dtype=jnp.float32) / half)
    ang = positions.astype(jnp.float32)[..., None] * inv
    return jnp.cos(ang)[:, :, None, None, :], jnp.sin(ang)[:, :, None, None, :]


def apply_rope(t, cos, sin):
    half = t.shape[-1] // 2
    t1 = t[..., :half].astype(jnp.float32)
    t2 = t[..., half:].astype(jnp.float32)
    return jnp.concatenate([t1 * cos - t2 * sin, t2 * cos + t1 * sin], axis=-1).astype(t.dtype)


def diff_attention(q, k, v, lam, lam_init, head_gain):
    B, S, H, _, dk = q.shape
    dv = v.shape[-1]
    n_blocks = S // Q_BLOCK
    scale = dk ** -0.5
    kpos = jnp.arange(S)

    def block(i):
        qb = lax.dynamic_slice_in_dim(q, i * Q_BLOCK, Q_BLOCK, axis=1)
        s = jnp.einsum('bqhcd,bkhcd->bhcqk', qb, k).astype(jnp.float32) * scale
        qpos = i * Q_BLOCK + jnp.arange(Q_BLOCK)
        causal = kpos[None, :] <= qpos[:, None]
        s = jnp.where(causal, s, -jnp.inf)
        p = jax.nn.softmax(s, axis=-1)
        a = p[:, :, 0] - lam * p[:, :, 1]
        return jnp.einsum('bhqk,bkhd->bqhd', a.astype(v.dtype), v)

    o = lax.map(block, jnp.arange(n_blocks))
    o = jnp.moveaxis(o, 0, 1).reshape(B, S, H, dv)
    o = rms_norm(o, head_gain) * (1.0 - lam_init)
    return o.reshape(B, S, H * dv)


def conformer_conv(zc, conv_w, conv_b, ln_g, ln_b, w_o):
    a, g = jnp.split(zc, 2, axis=-1)
    u = a * jax.nn.sigmoid(g)
    y = lax.conv_general_dilated(
        u, conv_w[:, None, :], window_strides=(1,), padding=[(CONV_TAPS - 1, 0)],
        dimension_numbers=('NWC', 'WIO', 'NWC'), feature_group_count=CONV_WIDTH)
    y = (y + conv_b).astype(jnp.float32)
    mu = jnp.mean(y, axis=-1, keepdims=True)
    var = jnp.mean(jnp.square(y - mu), axis=-1, keepdims=True)
    y = (y - mu) * lax.rsqrt(var + CONV_LN_EPS) * ln_g + ln_b
    y = jax.nn.silu(y).astype(zc.dtype)
    return y @ w_o


def rwkv7_time_mix(zr, mu, w0, w2, a0, a2, g2, k_k, k_a, r_k, gn_g, gn_b, w_o):
    B, S, _ = zr.shape
    H, N = RWKV_HEADS, RWKV_HEAD_DIM
    z_prev = jnp.pad(zr, ((0, 0), (1, 0), (0, 0)))[:, :-1]
    z = zr + mu * (z_prev - zr)
    W = RWKV_WIDTH
    r, k, v, zw, za, zg = jnp.split(
        z, [W, 2 * W, 3 * W, 3 * W + DECAY_LORA, 3 * W + DECAY_LORA + AAA_LORA], axis=-1)
    w = -jax.nn.softplus(-(w0 + jnp.tanh(zw) @ w2)) - 0.5
    decay = jnp.exp(-jnp.exp(w.astype(jnp.float32)))
    a = jax.nn.sigmoid(a0 + za @ a2)
    g = jax.nn.sigmoid(zg) @ g2
    hd = lambda t: t.reshape(B, S, H, N)
    r, k, v, a, decay = hd(r), hd(k), hd(v), hd(a), hd(decay)
    kk = k * k_k.reshape(H, N)
    kkf = kk.astype(jnp.float32)
    kkf = kkf / jnp.maximum(jnp.linalg.norm(kkf, axis=-1, keepdims=True), 1e-12)
    k = k * (1.0 + (a - 1.0) * k_a.reshape(H, N))

    f32t = lambda t: jnp.moveaxis(t.astype(jnp.float32), 1, 0)
    xs = (f32t(r), f32t(decay), f32t(k), f32t(v), f32t(-kkf), f32t(kkf * a.astype(jnp.float32)))

    def step(state, inp):
        r_t, w_t, k_t, v_t, a_t, b_t = inp
        sa = jnp.einsum('bhij,bhj->bhi', state, a_t)
        state = (state * w_t[:, :, None, :] + sa[..., :, None] * b_t[:, :, None, :]
                 + v_t[..., :, None] * k_t[:, :, None, :])
        y_t = jnp.einsum('bhij,bhj->bhi', state, r_t)
        return state, y_t

    s0 = jnp.zeros((B, H, N, N), jnp.float32)
    _, y = lax.scan(step, s0, xs)
    y = jnp.moveaxis(y, 0, 1)
    ym = jnp.mean(y, axis=-1, keepdims=True)
    yv = jnp.mean(jnp.square(y - ym), axis=-1, keepdims=True)
    y = (y - ym) * lax.rsqrt(yv + RWKV_GN_EPS) * gn_g.reshape(H, N) + gn_b.reshape(H, N)
    bonus = jnp.sum((r * k * r_k).astype(jnp.float32), axis=-1, keepdims=True) * v.astype(jnp.float32)
    out = ((y + bonus).reshape(B, S, W)).astype(zr.dtype) * g
    return out @ w_o


def peer_ffn(h, w_q, key1, key2, u, v):
    B, S, D = h.shape
    T = B * S
    hf = h.reshape(T, D)
    q = (hf @ w_q).reshape(T, PEER_HEADS, 2, PEER_HALF)
    s1 = jnp.einsum('thd,nd->thn', q[:, :, 0], key1)
    s2 = jnp.einsum('thd,nd->thn', q[:, :, 1], key2)
    v1, i1 = lax.top_k(s1, PEER_TOPK)
    v2, i2 = lax.top_k(s2, PEER_TOPK)
    cand = (v1[..., :, None] + v2[..., None, :]).reshape(T, PEER_HEADS, PEER_TOPK * PEER_TOPK)
    cidx = (i1[..., :, None] * N_KEYS + i2[..., None, :]).reshape(T, PEER_HEADS, PEER_TOPK * PEER_TOPK)
    top, sel = lax.top_k(cand, PEER_TOPK)
    eid = jnp.take_along_axis(cidx, sel, axis=-1)
    gate = jax.nn.softmax(top.astype(jnp.float32), axis=-1).astype(h.dtype)
    nc = T // PEER_CHUNK

    def chunk(args):
        xc, ec, gc = args
        ug = u[ec]
        act = jax.nn.gelu(jnp.einsum('td,thkd->thk', xc, ug), approximate=False)
        return jnp.einsum('thk,thkd->td', gc * act, v[ec])

    out = lax.map(chunk, (hf.reshape(nc, PEER_CHUNK, D),
                          eid.reshape(nc, PEER_CHUNK, PEER_HEADS, PEER_TOPK),
                          gate.reshape(nc, PEER_CHUNK, PEER_HEADS, PEER_TOPK)))
    return out.reshape(B, S, D)


def setup_inputs(seed: int = 0) -> dict:
    key = jax.random.key(seed)
    ks = iter(jax.random.split(key, 64))
    L, D = DEPTH, D_MODEL
    nrm = lambda shape, s: jax.random.normal(next(ks), shape, jnp.float32) * s
    uni = lambda shape, lo, hi: jax.random.uniform(next(ks), shape, jnp.float32, lo, hi)
    x = nrm((BATCH, SEQ, D), 1.0)
    c = nrm((BATCH, D), 1.0)
    offset = jax.random.randint(next(ks), (BATCH, 1), 0, MAX_POS_OFFSET, dtype=jnp.int32)
    positions = (offset + jnp.arange(SEQ, dtype=jnp.int32)[None, :]).astype(jnp.int32)
    return {
        "x": x,
        "c": c,
        "positions": positions,
        "w_ada": nrm((L, D, 6 * D), 0.1 * D ** -0.5),
        "b_ada": nrm((L, 6 * D), 0.01),
        "norm1_g": 1.0 + nrm((L, D), 0.02),
        "w_in": nrm((L, D, C_IN), D ** -0.5),
        "lam_q1": nrm((L, ATT_QK_DIM), LAMBDA_STD),
        "lam_k1": nrm((L, ATT_QK_DIM), LAMBDA_STD),
        "lam_q2": nrm((L, ATT_QK_DIM), LAMBDA_STD),
        "lam_k2": nrm((L, ATT_QK_DIM), LAMBDA_STD),
        "att_head_g": 1.0 + nrm((L, ATT_HEADS, ATT_V_DIM), 0.02),
        "w_att_o": nrm((L, ATT_WIDTH, D), ATT_WIDTH ** -0.5),
        "conv_w": nrm((L, CONV_TAPS, CONV_WIDTH), CONV_TAPS ** -0.5),
        "conv_b": nrm((L, CONV_WIDTH), 0.01),
        "conv_ln_g": 1.0 + nrm((L, CONV_WIDTH), 0.02),
        "conv_ln_b": nrm((L, CONV_WIDTH), 0.01),
        "w_conv_o": nrm((L, CONV_WIDTH, D), CONV_WIDTH ** -0.5),
        "rwkv_mu": uni((L, RWKV_IN), 0.0, 1.0),
        "rwkv_w0": uni((L, RWKV_WIDTH), -5.0, 0.0),
        "rwkv_w2": nrm((L, DECAY_LORA, RWKV_WIDTH), 0.5 * DECAY_LORA ** -0.5),
        "rwkv_a0": nrm((L, RWKV_WIDTH), 0.1),
        "rwkv_a2": nrm((L, AAA_LORA, RWKV_WIDTH), 0.5 * AAA_LORA ** -0.5),
        "rwkv_g2": nrm((L, GATE_LORA, RWKV_WIDTH), GATE_LORA ** -0.5),
        "rwkv_k_k": 0.85 + nrm((L, RWKV_WIDTH), 0.02),
        "rwkv_k_a": 1.0 + nrm((L, RWKV_WIDTH), 0.02),
        "rwkv_r_k": nrm((L, RWKV_HEADS, RWKV_HEAD_DIM), 0.1),
        "rwkv_gn_g": 1.0 + nrm((L, RWKV_WIDTH), 0.02),
        "rwkv_gn_b": nrm((L, RWKV_WIDTH), 0.01),
        "w_rwkv_o": nrm((L, RWKV_WIDTH, D), RWKV_WIDTH ** -0.5),
        "w_out": nrm((L, D, D), D ** -0.5),
        "norm2_g": 1.0 + nrm((L, D), 0.02),
        "peer_w_q": nrm((L, D, PEER_HEADS * PEER_QUERY_DIM), D ** -0.5),
        "peer_key1": nrm((L, N_KEYS, PEER_HALF), PEER_HALF ** -0.5),
        "peer_key2": nrm((L, N_KEYS, PEER_HALF), PEER_HALF ** -0.5),
        "peer_u": nrm((L, N_EXPERTS, D), D ** -0.5),
        "peer_v": nrm((L, N_EXPERTS, D), PEER_HEADS ** -0.5),
        "final_g": 1.0 + nrm((D,), 0.02),
    }


def reference(x, c, positions, w_ada, b_ada, norm1_g, w_in, lam_q1, lam_k1, lam_q2, lam_k2,
              att_head_g, w_att_o, conv_w, conv_b, conv_ln_g, conv_ln_b, w_conv_o,
              rwkv_mu, rwkv_w0, rwkv_w2, rwkv_a0, rwkv_a2, rwkv_g2, rwkv_k_k, rwkv_k_a, rwkv_r_k,
              rwkv_gn_g, rwkv_gn_b, w_rwkv_o, w_out, norm2_g, peer_w_q, peer_key1, peer_key2,
              peer_u, peer_v, final_g):
    B, S, D = x.shape
    cos, sin = rope_tables(positions)
    c_act = jax.nn.silu(c)
    for l in range(DEPTH):
        ada = c_act @ w_ada[l] + b_ada[l]
        sh1, sc1, gt1, sh2, sc2, gt2 = jnp.split(ada, 6, axis=-1)

        h = modulate(rms_norm(x, norm1_g[l]), sh1, sc1)
        z = h @ w_in[l]
        z_att, z_conv, z_rwkv, z_gate = jnp.split(
            z, [ATT_IN, ATT_IN + CONV_IN, ATT_IN + CONV_IN + RWKV_IN], axis=-1)

        q, k, v = jnp.split(z_att, [ATT_QK_WIDTH, 2 * ATT_QK_WIDTH], axis=-1)
        q = apply_rope(q.reshape(B, S, ATT_HEADS, 2, ATT_QK_DIM), cos, sin)
        k = apply_rope(k.reshape(B, S, ATT_HEADS, 2, ATT_QK_DIM), cos, sin)
        v = v.reshape(B, S, ATT_HEADS, ATT_V_DIM)
        lam_init = 0.8 - 0.6 * math.exp(-0.3 * l)
        lam = (jnp.exp(jnp.sum(lam_q1[l].astype(jnp.float32) * lam_k1[l].astype(jnp.float32)))
               - jnp.exp(jnp.sum(lam_q2[l].astype(jnp.float32) * lam_k2[l].astype(jnp.float32)))
               + lam_init)
        y_att = diff_attention(q, k, v, lam, lam_init, att_head_g[l]) @ w_att_o[l]

        y_conv = conformer_conv(z_conv, conv_w[l], conv_b[l], conv_ln_g[l], conv_ln_b[l], w_conv_o[l])

        y_rwkv = rwkv7_time_mix(z_rwkv, rwkv_mu[l], rwkv_w0[l], rwkv_w2[l], rwkv_a0[l], rwkv_a2[l],
                                rwkv_g2[l], rwkv_k_k[l], rwkv_k_a[l], rwkv_r_k[l],
                                rwkv_gn_g[l], rwkv_gn_b[l], w_rwkv_o[l])

        g_att, g_conv, g_rwkv = jnp.split(jax.nn.sigmoid(z_gate), N_BRANCH, axis=-1)
        merged = g_att * y_att + g_conv * y_conv + g_rwkv * y_rwkv
        x = x + (1.0 + gt1[:, None, :]) * (merged @ w_out[l])

        h = modulate(rms_norm(x, norm2_g[l]), sh2, sc2)
        x = x + (1.0 + gt2[:, None, :]) * peer_ffn(h, peer_w_q[l], peer_key1[l], peer_key2[l],
                                                   peer_u[l], peer_v[l])
    return rms_norm(x, final_g)
```

```cpp
#include <hip/hip_runtime.h>
#include <hip/hip_cooperative_groups.h>
#include <cstdio>
#include <cstdint>
namespace cg = cooperative_groups;

#define DI __device__ __forceinline__
typedef unsigned short bf16_t;
typedef short bf16x8 __attribute__((ext_vector_type(8)));
typedef float f32x2 __attribute__((ext_vector_type(2)));
typedef float f32x4 __attribute__((ext_vector_type(4)));
typedef float f32x16 __attribute__((ext_vector_type(16)));
typedef unsigned u32x2 __attribute__((ext_vector_type(2)));
typedef unsigned u32x4 __attribute__((ext_vector_type(4)));
typedef __bf16 nbf16x2 __attribute__((ext_vector_type(2)));

constexpr int NB = 2, SEQ = 8192, NT = NB * SEQ, DM = 1024, CIN = 11520, DEPTH = 2;
constexpr int NTHREADS = 256;
constexpr size_t MiB = (size_t)1 << 20;
constexpr size_t OFF_CTRL = 0, OFF_ROPE = 1 * MiB, OFF_W = 5 * MiB, OFF_H = 41 * MiB, OFF_Q = 73 * MiB, OFF_K = 105 * MiB,
                 OFF_VT = 137 * MiB, OFF_UC = 169 * MiB, OFF_ZR = 201 * MiB, OFF_ZG = 305 * MiB, OFF_A = 401 * MiB,
                 OFF_LW = 433 * MiB, OFF_YS = 465 * MiB, WS_END = 497 * MiB;
constexpr size_t OFF_CONVP = OFF_H, OFF_ATTP = OFF_UC, OFF_RWKVP = OFF_Q, OFF_MERGED = OFF_K, OFF_PU = OFF_ZR,
                 OFF_PV = OFF_ZR + 32 * MiB, OFF_QP = OFF_ZG, OFF_SCORES = OFF_Q, OFF_EID = OFF_A, OFF_GATE = OFF_A + 8 * MiB;
constexpr size_t W_IN = 0, W_ATTO = (size_t)CIN * 1024 * 2, W_CONVO = W_ATTO + 2 * MiB, W_RWKVO = W_CONVO + 2 * MiB,
                 W_OUT = W_RWKVO + 2 * MiB, W_QP = W_OUT + 2 * MiB, W_KEY1 = W_QP + 4 * MiB, W_KEY2 = W_KEY1 + 32768;
static_assert(W_KEY2 + 32768 <= 36 * MiB, "W region overflow");
constexpr size_t CT_CNT = 0, CT_LAM = 1024, CT_ADA = 65536;
constexpr int RWKV_LD = 3328, ZG_LD = 3072;

enum { I_X = 0, I_C, I_POS, I_WADA, I_BADA, I_N1G, I_WIN, I_LQ1, I_LK1, I_LQ2, I_LK2, I_AHG, I_WATTO, I_CONVW, I_CONVB, I_CLNG, I_CLNB,
       I_WCONVO, I_MU, I_W0, I_W2, I_A0, I_A2, I_G2, I_KK, I_KA, I_RK, I_GNG, I_GNB, I_WRWKVO, I_WOUT, I_N2G, I_WQ, I_KEY1, I_KEY2,
       I_PU, I_PV, I_FG, N_IN };

struct Params {
    const void* in[N_IN];
    float* out;
    char* ws;
    int ph_begin, ph_end;
};

DI unsigned pk2(float lo, float hi) { f32x2 v = {lo, hi}; nbf16x2 b = __builtin_convertvector(v, nbf16x2); return __builtin_bit_cast(unsigned, b); }
DI float bflo(unsigned u) { return __uint_as_float(u << 16); }
DI float bfhi(unsigned u) { return __uint_as_float(u & 0xffff0000u); }
DI float bf2f(bf16_t h) { return __uint_as_float(((unsigned)h) << 16); }
DI bf16_t f2bf(float x) { return (bf16_t)(pk2(x, x) & 0xffffu); }
DI float sigmoidf_(float x) { return 1.0f / (1.0f + __expf(-x)); }
DI float siluf_(float x) { return x / (1.0f + __expf(-x)); }
template <int CTRL> DI float dpp_f(float x) { return __int_as_float(__builtin_amdgcn_update_dpp(0, __float_as_int(x), CTRL, 0xF, 0xF, true)); }
DI float row16_sum(float x) { x += dpp_f<0xB1>(x); x += dpp_f<0x4E>(x); x += dpp_f<0x141>(x); x += dpp_f<0x140>(x); return x; }
DI float row16_max(float x) { x = fmaxf(x, dpp_f<0xB1>(x)); x = fmaxf(x, dpp_f<0x4E>(x)); x = fmaxf(x, dpp_f<0x141>(x)); x = fmaxf(x, dpp_f<0x140>(x)); return x; }
DI float wave_sum(float x) { x = row16_sum(x); x += __shfl_xor(x, 16); x += __shfl_xor(x, 32); return x; }
DI float wave_max(float x) { x = row16_max(x); x = fmaxf(x, __shfl_xor(x, 16)); x = fmaxf(x, __shfl_xor(x, 32)); return x; }
DI void unpack8(u32x4 v, float (&f)[8]) { f[0] = bflo(v.x); f[1] = bfhi(v.x); f[2] = bflo(v.y); f[3] = bfhi(v.y); f[4] = bflo(v.z); f[5] = bfhi(v.z); f[6] = bflo(v.w); f[7] = bfhi(v.w); }
DI void unpack4(u32x2 v, float (&f)[4]) { f[0] = bflo(v.x); f[1] = bfhi(v.x); f[2] = bflo(v.y); f[3] = bfhi(v.y); }
DI u32x2 pack4(float a, float b, float c, float d) { u32x2 r; r.x = pk2(a, b); r.y = pk2(c, d); return r; }

#define MFMA16(a, b, c) __builtin_amdgcn_mfma_f32_16x16x32_bf16((a), (b), (c), 0, 0, 0)
#define MFMA32(a, b, c) __builtin_amdgcn_mfma_f32_32x32x16_bf16((a), (b), (c), 0, 0, 0)

constexpr int LDK = 72;
constexpr int GEMM_LDS = 2 * 128 * LDK * 2;

template <bool NMODE>
DI void gemm_mainloop(f32x4 (&acc)[4][4], const bf16_t* X, size_t ldx, const bf16_t* W, size_t ldw, int K, char* lds) {
    bf16_t* sx = (bf16_t*)lds;
    bf16_t* sw = sx + 128 * LDK;
    const int tid = threadIdx.x, lane = tid & 63, wid = tid >> 6, wm = wid >> 1, wn = wid & 1;
    const int srow = tid >> 3, sc8 = (tid & 7) * 8;
    const bf16_t* gx = X + (size_t)srow * ldx + sc8;
    const bf16_t* gw = W + (size_t)srow * ldw + sc8;
    u32x4 rx[4], rw[4];
#pragma unroll
    for (int i = 0; i < 4; ++i) { rx[i] = *(const u32x4*)(gx + (size_t)(32 * i) * ldx); rw[i] = *(const u32x4*)(gw + (size_t)(32 * i) * ldw); }
    const int nk = K >> 6;
    const int fr = lane & 15, fq = lane >> 4;
    for (int kt = 0; kt < nk; ++kt) {
        __syncthreads();
#pragma unroll
        for (int i = 0; i < 4; ++i) { *(u32x4*)(sx + (srow + 32 * i) * LDK + sc8) = rx[i]; *(u32x4*)(sw + (srow + 32 * i) * LDK + sc8) = rw[i]; }
        __syncthreads();
        if (kt + 1 < nk) {
            const int ko = (kt + 1) * 64;
#pragma unroll
            for (int i = 0; i < 4; ++i) { rx[i] = *(const u32x4*)(gx + (size_t)(32 * i) * ldx + ko); rw[i] = *(const u32x4*)(gw + (size_t)(32 * i) * ldw + ko); }
        }
#pragma unroll
        for (int ks = 0; ks < 2; ++ks) {
            bf16x8 xf[4], wf[4];
#pragma unroll
            for (int i = 0; i < 4; ++i) {
                xf[i] = *(const bf16x8*)(sx + (wm * 64 + i * 16 + fr) * LDK + ks * 32 + fq * 8);
                wf[i] = *(const bf16x8*)(sw + (wn * 64 + i * 16 + fr) * LDK + ks * 32 + fq * 8);
            }
#pragma unroll
            for (int ti = 0; ti < 4; ++ti)
#pragma unroll
                for (int ni = 0; ni < 4; ++ni)
                    acc[ti][ni] = NMODE ? MFMA16(xf[ti], wf[ni], acc[ti][ni]) : MFMA16(wf[ni], xf[ti], acc[ti][ni]);
        }
    }
}
DI void zero_acc(f32x4 (&acc)[4][4]) {
#pragma unroll
    for (int i = 0; i < 4; ++i)
#pragma unroll
        for (int j = 0; j < 4; ++j) acc[i][j] = (f32x4){0.f, 0.f, 0.f, 0.f};
}
DI void tile_coords(int tile, int nN, int& mt, int& nt) { const int per = 16 * nN; const int g = tile / per, r = tile % per; nt = r >> 4; mt = g * 16 + (r & 15); }

DI void ada_item(const Params& p, int item, char* lds) {
    const int l = item / 96, cgp = item % 96, tid = threadIdx.x, lane = tid & 63, wid = tid >> 6;
    const float* c = (const float*)p.in[I_C];
    const float* w = (const float*)p.in[I_WADA] + (size_t)l * 1024 * 6144 + cgp * 64 + lane;
    float a0 = 0.f, a1 = 0.f;
    const int k0 = wid * 256;
#pragma unroll 8
    for (int k = k0; k < k0 + 256; ++k) {
        const float wv = w[(size_t)k * 6144];
        a0 += siluf_(c[k]) * wv; a1 += siluf_(c[1024 + k]) * wv;
    }
    float* red = (float*)lds;
    __syncthreads();
    red[(wid * 2 + 0) * 64 + lane] = a0; red[(wid * 2 + 1) * 64 + lane] = a1;
    __syncthreads();
    if (tid < 128) {
        const int b = tid >> 6, n = cgp * 64 + (tid & 63);
        float s = ((const float*)p.in[I_BADA])[l * 6144 + n];
        for (int w4 = 0; w4 < 4; ++w4) s += red[(w4 * 2 + b) * 64 + (tid & 63)];
        ((float*)(p.ws + OFF_CTRL + CT_ADA))[(l * 2 + b) * 6144 + n] = s;
    }
}
DI void lam_item(const Params& p) {
    if (threadIdx.x < 64) {
        const int lane = threadIdx.x;
        for (int l = 0; l < DEPTH; ++l) {
            float s1 = ((const float*)p.in[I_LQ1])[l * 64 + lane] * ((const float*)p.in[I_LK1])[l * 64 + lane];
            float s2 = ((const float*)p.in[I_LQ2])[l * 64 + lane] * ((const float*)p.in[I_LK2])[l * 64 + lane];
            s1 = wave_sum(s1); s2 = wave_sum(s2);
            const float lam_init = 0.8f - 0.6f * expf(-0.3f * (float)l);
            if (lane == 0) ((float*)(p.ws + OFF_CTRL + CT_LAM))[l] = expf(s1) - expf(s2) + lam_init;
        }
    }
}
DI void rope_item(const Params& p, int item) {
    const int* pos = (const int*)p.in[I_POS];
    float* rc = (float*)(p.ws + OFF_ROPE);
    float* rs = rc + (size_t)NT * 32;
#pragma unroll
    for (int e = 0; e < 8; ++e) {
        const int idx = item * 2048 + e * 256 + threadIdx.x;
        const int t = idx >> 5, i = idx & 31;
        const float inv = powf(10000.0f, -(float)i / 32.0f);
        const float ang = (float)pos[t] * inv;
        float sn, cs; sincosf(ang, &sn, &cs);
        rc[idx] = cs; rs[idx] = sn;
    }
}
DI int win_srcmap(int n) {
    if (n < 3072 || n >= 5120) return n;
    const int q = n - 3072, j = q >> 6, r = q & 63;
    return r < 32 ? 3072 + 32 * j + r : 3072 + 1024 + 32 * j + (r - 32);
}
DI void transpose_tile(const float* src, int N, bf16_t* dst, int k0, int n0, bool perm, char* lds) {
    float* t = (float*)lds;
    const int tid = threadIdx.x;
    const int r = tid >> 4, c4 = (tid & 15) * 4;
    int ns = n0 + c4; if (perm) ns = win_srcmap(ns);
    __syncthreads();
#pragma unroll
    for (int i = 0; i < 4; ++i) {
        const int kl = r + 16 * i;
        const f32x4 v = *(const f32x4*)(src + (size_t)(k0 + kl) * N + ns);
        t[(c4 + 0) * 65 + kl] = v[0]; t[(c4 + 1) * 65 + kl] = v[1]; t[(c4 + 2) * 65 + kl] = v[2]; t[(c4 + 3) * 65 + kl] = v[3];
    }
    __syncthreads();
    const int nl = tid >> 2, kq = (tid & 3) * 16;
    u32x4 o0, o1;
    const float* tr = t + nl * 65 + kq;
    o0.x = pk2(tr[0], tr[1]); o0.y = pk2(tr[2], tr[3]); o0.z = pk2(tr[4], tr[5]); o0.w = pk2(tr[6], tr[7]);
    o1.x = pk2(tr[8], tr[9]); o1.y = pk2(tr[10], tr[11]); o1.z = pk2(tr[12], tr[13]); o1.w = pk2(tr[14], tr[15]);
    bf16_t* d = dst + (size_t)(n0 + nl) * 1024 + k0 + kq;
    *(u32x4*)d = o0; *(u32x4*)(d + 8) = o1;
}
constexpr int NCONV_ITEMS = 2880 + 1024 + 512 + 2;
DI void convert_item(const Params& p, int l, int item, char* lds) {
    char* wb = p.ws + OFF_W;
    if (item < 2880) { const int kt = item % 16, nt = item / 16; transpose_tile((const float*)p.in[I_WIN] + (size_t)l * 1024 * CIN, CIN, (bf16_t*)(wb + W_IN), kt * 64, nt * 64, true, lds); return; }
    item -= 2880;
    if (item < 1024) {
        const int which = item >> 8, it = item & 255, kt = it & 15, nt = it >> 4;
        const int idx = which == 0 ? I_WATTO : which == 1 ? I_WCONVO : which == 2 ? I_WRWKVO : I_WOUT;
        const size_t off = which == 0 ? W_ATTO : which == 1 ? W_CONVO : which == 2 ? W_RWKVO : W_OUT;
        transpose_tile((const float*)p.in[idx] + (size_t)l * 1024 * 1024, 1024, (bf16_t*)(wb + off), kt * 64, nt * 64, false, lds); return;
    }
    item -= 1024;
    if (item < 512) { const int kt = item & 15, nt = item >> 4; transpose_tile((const float*)p.in[I_WQ] + (size_t)l * 1024 * 2048, 2048, (bf16_t*)(wb + W_QP), kt * 64, nt * 64, false, lds); return; }
    item -= 512;
    {
        const float* src = (const float*)p.in[item == 0 ? I_KEY1 : I_KEY2] + (size_t)l * 16384;
        bf16_t* dst = (bf16_t*)(wb + (item == 0 ? W_KEY1 : W_KEY2));
        for (int i = threadIdx.x * 4; i < 16384; i += 1024) { const f32x4 v = *(const f32x4*)(src + i); *(u32x2*)(dst + i) = pack4(v[0], v[1], v[2], v[3]); }
    }
}
DI void convert_uv_item(const Params& p, int l, int item) {
    const int arr = item >> 10, chunk = item & 1023;
    const float* src = (const float*)p.in[arr == 0 ? I_PU : I_PV] + (size_t)l * 16384 * 1024 + (size_t)chunk * 16384;
    bf16_t* dst = (bf16_t*)(p.ws + (arr == 0 ? OFF_PU : OFF_PV)) + (size_t)chunk * 16384;
#pragma unroll
    for (int it = 0; it < 8; ++it) {
        const int i = it * 2048 + threadIdx.x * 8;
        const f32x4 a = *(const f32x4*)(src + i), b = *(const f32x4*)(src + i + 4);
        u32x4 o; o.x = pk2(a[0], a[1]); o.y = pk2(a[2], a[3]); o.z = pk2(b[0], b[1]); o.w = pk2(b[2], b[3]);
        *(u32x4*)(dst + i) = o;
    }
}

DI void norm_rows(const Params& p, const float* xin, const float* gain, const float* shv, const float* scv, bf16_t* out) {
    const int lane = threadIdx.x & 63;
    const int gw = blockIdx.x * 4 + (threadIdx.x >> 6), nw = gridDim.x * 4;
    for (int t = gw; t < NT; t += nw) {
        const int b = t >> 13;
        f32x4 v[4]; float ss = 0.f;
#pragma unroll
        for (int i = 0; i < 4; ++i) { v[i] = *(const f32x4*)(xin + (size_t)t * 1024 + i * 256 + lane * 4); ss += v[i][0] * v[i][0] + v[i][1] * v[i][1] + v[i][2] * v[i][2] + v[i][3] * v[i][3]; }
        ss = wave_sum(ss);
        const float rstd = rsqrtf(ss * (1.0f / 1024.0f) + 1e-6f);
#pragma unroll
        for (int i = 0; i < 4; ++i) {
            const int n = i * 256 + lane * 4;
            const f32x4 g = *(const f32x4*)(gain + n), sc = *(const f32x4*)(scv + b * 6144 + n), sh = *(const f32x4*)(shv + b * 6144 + n);
            float o[4];
#pragma unroll
            for (int e = 0; e < 4; ++e) o[e] = v[i][e] * rstd * g[e] * (1.0f + sc[e]) + sh[e];
            *(u32x2*)(out + (size_t)t * 1024 + n) = pack4(o[0], o[1], o[2], o[3]);
        }
    }
}

DI void phaseB_tile(const Params& p, int mt, int nt, char* lds) {
    const int tid = threadIdx.x, lane = tid & 63, wid = tid >> 6, wm = wid >> 1, wn = wid & 1;
    const int fr = lane & 15, fq = lane >> 4;
    const bf16_t* X = (const bf16_t*)(p.ws + OFF_H) + (size_t)mt * 128 * 1024;
    const bf16_t* W = (const bf16_t*)(p.ws + OFF_W + W_IN) + (size_t)nt * 128 * 1024;
    const int n0 = nt * 128, nb = n0 + wn * 64;
    const int m0 = mt * 128 + wm * 64;
    f32x4 acc[4][4]; zero_acc(acc);
    if (n0 >= 2048 && n0 < 3072) {
        gemm_mainloop<true>(acc, X, 1024, W, 1024, 1024, lds);
        bf16_t* VT = (bf16_t*)(p.ws + OFF_VT);
#pragma unroll
        for (int ni = 0; ni < 4; ++ni) {
            const int col = nb - 2048 + ni * 16 + fr, hh = col >> 7, dv = col & 127, d = dv >> 5, rr = dv & 31;
#pragma unroll
            for (int ti = 0; ti < 4; ++ti) {
                const int tok = m0 + ti * 16 + fq * 4;
                const int b = tok >> 13, s = tok & 8191, kt = s >> 6, kl = s & 63, kb = kl >> 5, x = kl & 31;
                const int s_ = (x >> 4) & 1, jhi = (x >> 3) & 1, h_ = (x >> 2) & 1;
                const size_t base = ((size_t)((b * 8 + hh) * 128 + kt)) * 8192 + (size_t)(((((d * 2 + kb) * 2 + s_) * 2 + h_) * 32 + rr) * 8 + jhi * 4);
                *(u32x2*)(VT + base) = pack4(acc[ti][ni][0], acc[ti][ni][1], acc[ti][ni][2], acc[ti][ni][3]);
            }
        }
        return;
    }
    gemm_mainloop<false>(acc, X, 1024, W, 1024, 1024, lds);
    if (n0 < 2048) {
        const bool isK = n0 >= 1024;
        const int nn = nb - (isK ? 1024 : 0), hh = nn >> 7, c = (nn >> 6) & 1;
        const float scl = isK ? 1.0f : 0.125f * 1.4426950408889634f;
        bf16_t* dst = (bf16_t*)(p.ws + (isK ? OFF_K : OFF_Q));
        const float* rc = (const float*)(p.ws + OFF_ROPE);
        const float* rs = rc + (size_t)NT * 32;
#pragma unroll
        for (int ti = 0; ti < 4; ++ti) {
            const int tok = m0 + ti * 16 + fr, b = tok >> 13, s = tok & 8191;
            bf16_t* row = dst + ((size_t)(((b * 8 + hh) * 2 + c)) * SEQ + s) * 64;
#pragma unroll
            for (int ni = 0; ni < 2; ++ni) {
                const int i0 = ni * 16 + fq * 4;
                const f32x4 cs = *(const f32x4*)(rc + (size_t)tok * 32 + i0), sn = *(const f32x4*)(rs + (size_t)tok * 32 + i0);
                float o1[4], o2[4];
#pragma unroll
                for (int r = 0; r < 4; ++r) {
                    const float t1 = acc[ti][ni][r], t2 = acc[ti][ni + 2][r];
                    o1[r] = (t1 * cs[r] - t2 * sn[r]) * scl; o2[r] = (t2 * cs[r] + t1 * sn[r]) * scl;
                }
                *(u32x2*)(row + i0) = pack4(o1[0], o1[1], o1[2], o1[3]);
                *(u32x2*)(row + 32 + i0) = pack4(o2[0], o2[1], o2[2], o2[3]);
            }
        }
    } else if (n0 < 5120) {
        const int j = (nb - 3072) >> 6;
        bf16_t* UC = (bf16_t*)(p.ws + OFF_UC);
#pragma unroll
        for (int ti = 0; ti < 4; ++ti) {
            const int tok = m0 + ti * 16 + fr;
#pragma unroll
            for (int ni = 0; ni < 2; ++ni) {
                const int ch = 32 * j + ni * 16 + fq * 4;
                float o[4];
#pragma unroll
                for (int r = 0; r < 4; ++r) o[r] = acc[ti][ni][r] * sigmoidf_(acc[ti][ni + 2][r]);
                *(u32x2*)(UC + (size_t)tok * 1024 + ch) = pack4(o[0], o[1], o[2], o[3]);
            }
        }
    } else if (n0 < 8448) {
        bf16_t* ZR = (bf16_t*)(p.ws + OFF_ZR);
#pragma unroll
        for (int ti = 0; ti < 4; ++ti) {
            const int tok = m0 + ti * 16 + fr;
#pragma unroll
            for (int ni = 0; ni < 4; ++ni) {
                const int col = nb - 5120 + ni * 16 + fq * 4;
                *(u32x2*)(ZR + (size_t)tok * RWKV_LD + col) = pack4(acc[ti][ni][0], acc[ti][ni][1], acc[ti][ni][2], acc[ti][ni][3]);
            }
        }
    } else {
        bf16_t* ZG = (bf16_t*)(p.ws + OFF_ZG);
#pragma unroll
        for (int ti = 0; ti < 4; ++ti) {
            const int tok = m0 + ti * 16 + fr;
#pragma unroll
            for (int ni = 0; ni < 4; ++ni) {
                const int col = nb - 8448 + ni * 16 + fq * 4;
                *(u32x2*)(ZG + (size_t)tok * ZG_LD + col) = pack4(sigmoidf_(acc[ti][ni][0]), sigmoidf_(acc[ti][ni][1]), sigmoidf_(acc[ti][ni][2]), sigmoidf_(acc[ti][ni][3]));
            }
        }
    }
}

DI void zr_shift8(const bf16_t* ZR, const float* mu, int tok, int col, float (&z)[8]) {
    const u32x4 cv = *(const u32x4*)(ZR + (size_t)tok * RWKV_LD + col);
    u32x4 pv = (u32x4){0u, 0u, 0u, 0u};
    if ((tok & 8191) != 0) pv = *(const u32x4*)(ZR + (size_t)(tok - 1) * RWKV_LD + col);
    float c[8], q[8]; unpack8(cv, c); unpack8(pv, q);
    const f32x4 m0 = *(const f32x4*)(mu + col), m1 = *(const f32x4*)(mu + col + 4);
#pragma unroll
    for (int e = 0; e < 4; ++e) { z[e] = c[e] + m0[e] * (q[e] - c[e]); z[4 + e] = c[4 + e] + m1[e] * (q[4 + e] - c[4 + e]); }
}
DI void zr_shift4(const bf16_t* ZR, const float* mu, int tok, int col, float (&z)[4]) {
    const u32x2 cv = *(const u32x2*)(ZR + (size_t)tok * RWKV_LD + col);
    u32x2 pv = (u32x2){0u, 0u};
    if ((tok & 8191) != 0) pv = *(const u32x2*)(ZR + (size_t)(tok - 1) * RWKV_LD + col);
    float c[4], q[4]; unpack4(cv, c); unpack4(pv, q);
    const f32x4 m0 = *(const f32x4*)(mu + col);
#pragma unroll
    for (int e = 0; e < 4; ++e) z[e] = c[e] + m0[e] * (q[e] - c[e]);
}

DI void rwkv_prep_tile(const Params& p, int l, int tile, char* lds) {
    const int tid = threadIdx.x, t0 = tile * 16;
    const bf16_t* ZR = (const bf16_t*)(p.ws + OFF_ZR);
    const float* mu = (const float*)p.in[I_MU] + (size_t)l * RWKV_LD;
    float* tw = (float*)lds;
    float* za = tw + 16 * 64;
    __syncthreads();
    {
        const int tk = tid >> 4, c8 = (tid & 15) * 8;
        float z[8]; zr_shift8(ZR, mu, t0 + tk, 3072 + c8, z);
        if (c8 < 64) { for (int e = 0; e < 8; ++e) tw[tk * 64 + c8 + e] = tanhf(z[e]); }
        else { for (int e = 0; e < 8; ++e) za[tk * 64 + c8 - 64 + e] = z[e]; }
    }
    __syncthreads();
    const int n4 = tid * 4;
#pragma unroll 1
    for (int which = 0; which < 2; ++which) {
        const float* act = which == 0 ? tw : za;
        const float* wl = (const float*)p.in[which == 0 ? I_W2 : I_A2] + (size_t)l * 64 * 1024 + n4;
        const float* bias = (const float*)p.in[which == 0 ? I_W0 : I_A0] + (size_t)l * 1024 + n4;
        f32x4 acc[16];
        const f32x4 bv = *(const f32x4*)bias;
#pragma unroll
        for (int t = 0; t < 16; ++t) acc[t] = bv;
#pragma unroll 2
        for (int k = 0; k < 64; k += 4) {
            const f32x4 w0 = *(const f32x4*)(wl + (size_t)(k + 0) * 1024), w1 = *(const f32x4*)(wl + (size_t)(k + 1) * 1024),
                        w2 = *(const f32x4*)(wl + (size_t)(k + 2) * 1024), w3 = *(const f32x4*)(wl + (size_t)(k + 3) * 1024);
#pragma unroll
            for (int t = 0; t < 16; ++t) {
                const f32x4 a = *(const f32x4*)(act + t * 64 + k);
                acc[t] += a[0] * w0 + a[1] * w1 + a[2] * w2 + a[3] * w3;
            }
        }
        bf16_t* dst = (bf16_t*)(p.ws + (which == 0 ? OFF_LW : OFF_A));
#pragma unroll
        for (int t = 0; t < 16; ++t) {
            float o[4];
#pragma unroll
            for (int e = 0; e < 4; ++e) { const float sg = sigmoidf_(acc[t][e]); o[e] = which == 0 ? -0.6065306597126334f * sg : sg; }
            *(u32x2*)(dst + (size_t)(t0 + t) * 1024 + n4) = pack4(o[0], o[1], o[2], o[3]);
        }
    }
}

DI void conv_tile(const Params& p, int l, int tile, char* lds) {
    const int tid = threadIdx.x, lane = tid & 63, wid = tid >> 6, t0 = tile * 16, s0 = t0 & 8191;
    const bf16_t* UC = (const bf16_t*)(p.ws + OFF_UC);
    bf16_t* out = (bf16_t*)(p.ws + OFF_CONVP);
    float* su = (float*)lds;
    float* red = su + 46 * 256;
    float s1[16], s2[16];
#pragma unroll
    for (int t = 0; t < 16; ++t) { s1[t] = 0.f; s2[t] = 0.f; }
#pragma unroll 1
    for (int ps = 0; ps < 4; ++ps) {
        const int cbase = ps * 256;
        __syncthreads();
        for (int ch = tid; ch < 46 * 32; ch += 256) {
            const int row = ch >> 5, c8 = (ch & 31) * 8;
            u32x4 v = (u32x4){0u, 0u, 0u, 0u};
            if (s0 - 30 + row >= 0) v = *(const u32x4*)(UC + (size_t)(t0 - 30 + row) * 1024 + cbase + c8);
            float f[8]; unpack8(v, f);
            *(f32x4*)(su + row * 256 + c8) = (f32x4){f[0], f[1], f[2], f[3]};
            *(f32x4*)(su + row * 256 + c8 + 4) = (f32x4){f[4], f[5], f[6], f[7]};
        }
        __syncthreads();
        const int c = cbase + tid;
        float w[31];
#pragma unroll
        for (int j = 0; j < 31; ++j) w[j] = ((const float*)p.in[I_CONVW])[(size_t)l * 31 * 1024 + j * 1024 + c];
        const float bias = ((const float*)p.in[I_CONVB])[l * 1024 + c];
        float acc[16];
#pragma unroll
        for (int t = 0; t < 16; ++t) acc[t] = bias;
#pragma unroll
        for (int rr = 0; rr < 46; ++rr) {
            const float uval = su[rr * 256 + tid];
#pragma unroll
            for (int t = 0; t < 16; ++t) if (rr - t >= 0 && rr - t <= 30) acc[t] += w[rr - t] * uval;
        }
#pragma unroll
        for (int t = 0; t < 16; ++t) {
            const bf16_t hb = f2bf(acc[t]); const float yr = bf2f(hb);
            s1[t] += yr; s2[t] += yr * yr;
            out[(size_t)(t0 + t) * 1024 + c] = hb;
        }
    }
    __syncthreads();
#pragma unroll
    for (int t = 0; t < 16; ++t) {
        const float a = wave_sum(s1[t]), b2 = wave_sum(s2[t]);
        if (lane == 0) { red[(wid * 16 + t) * 2] = a; red[(wid * 16 + t) * 2 + 1] = b2; }
    }
    __syncthreads();
#pragma unroll 1
    for (int ps = 0; ps < 4; ++ps) {
        const int c = ps * 256 + tid;
        const float g = ((const float*)p.in[I_CLNG])[l * 1024 + c], bb = ((const float*)p.in[I_CLNB])[l * 1024 + c];
#pragma unroll
        for (int t = 0; t < 16; ++t) {
            const float a = red[t * 2] + red[(16 + t) * 2] + red[(32 + t) * 2] + red[(48 + t) * 2];
            const float b2 = red[t * 2 + 1] + red[(16 + t) * 2 + 1] + red[(32 + t) * 2 + 1] + red[(48 + t) * 2 + 1];
            const float mean = a * (1.0f / 1024.0f), var = fmaxf(b2 * (1.0f / 1024.0f) - mean * mean, 0.f);
            const float y = bf2f(out[(size_t)(t0 + t) * 1024 + c]);
            const float yn = (y - mean) * rsqrtf(var + 1e-5f) * g + bb;
            out[(size_t)(t0 + t) * 1024 + c] = f2bf(siluf_(yn));
        }
    }
}

constexpr int SCAN_BUF = 5 * 1024 + 256;
DI void scan_block(const Params& p, int l, int sb, char* lds) {
    const int tid = threadIdx.x, b = sb >> 6, hh = (sb >> 2) & 15, rg = sb & 3;
    const int il = tid >> 4, cgp = tid & 15;
    const int ts = tid >> 4, jg = tid & 15;
    float* bufs = (float*)lds;
    float* ybuf = bufs + 2 * SCAN_BUF;
    const bf16_t* ZR = (const bf16_t*)(p.ws + OFF_ZR);
    const bf16_t* Ab = (const bf16_t*)(p.ws + OFF_A);
    const bf16_t* Lb = (const bf16_t*)(p.ws + OFF_LW);
    bf16_t* YS = (bf16_t*)(p.ws + OFF_YS);
    const float* mu = (const float*)p.in[I_MU] + (size_t)l * RWKV_LD;
    const int ncol = hh * 64 + jg * 4;
    const f32x4 kkv = *(const f32x4*)((const float*)p.in[I_KK] + l * 1024 + ncol);
    const f32x4 kav = *(const f32x4*)((const float*)p.in[I_KA] + l * 1024 + ncol);
    const int tokb = b * SEQ;
    float rr[4], kk[4], vv[4]; u32x2 av, lv;
    auto stage_load = [&](int c) {
        const int tok = tokb + c * 16 + ts;
        zr_shift4(ZR, mu, tok, ncol, rr); zr_shift4(ZR, mu, tok, 1024 + ncol, kk); zr_shift4(ZR, mu, tok, 2048 + ncol, vv);
        av = *(const u32x2*)(Ab + (size_t)tok * 1024 + ncol); lv = *(const u32x2*)(Lb + (size_t)tok * 1024 + ncol);
    };
    auto stage_write = [&](float* buf) {
        float a[4], lw[4]; unpack4(av, a); unpack4(lv, lw);
        float kq[4], ss = 0.f;
#pragma unroll
        for (int e = 0; e < 4; ++e) { kq[e] = kk[e] * kkv[e]; ss += kq[e] * kq[e]; }
        ss = row16_sum(ss);
        const float inv = 1.0f / fmaxf(sqrtf(ss), 1e-12f);
        f32x4 W4, K4, A4, B4, R4;
#pragma unroll
        for (int e = 0; e < 4; ++e) {
            const float kf = kq[e] * inv;
            W4[e] = __expf(lw[e]); K4[e] = kk[e] * (1.0f + (a[e] - 1.0f) * kav[e]); A4[e] = -kf; B4[e] = kf * a[e]; R4[e] = rr[e];
        }
        float* bp = buf + ts * 64 + jg * 4;
        *(f32x4*)(bp) = W4; *(f32x4*)(bp + 1024) = K4; *(f32x4*)(bp + 2048) = A4; *(f32x4*)(bp + 3072) = B4; *(f32x4*)(bp + 4096) = R4;
        if ((jg >> 2) == rg) *(f32x4*)(buf + 5120 + ts * 16 + (jg & 3) * 4) = (f32x4){vv[0], vv[1], vv[2], vv[3]};
    };
    float S0 = 0.f, S1 = 0.f, S2 = 0.f, S3 = 0.f;
    __syncthreads();
    stage_load(0); stage_write(bufs);
    __syncthreads();
    for (int c = 0; c < SEQ / 16; ++c) {
        const float* buf = bufs + (c & 1) * SCAN_BUF;
        float* yb = ybuf + (c & 1) * 256;
        if (c > 0) {
            const float* yp = ybuf + ((c - 1) & 1) * 256;
            YS[(size_t)(tokb + (c - 1) * 16 + (tid >> 4)) * 1024 + hh * 64 + rg * 16 + (tid & 15)] = f2bf(yp[tid]);
        }
        if (c + 1 < SEQ / 16) stage_load(c + 1);
#pragma unroll
        for (int t = 0; t < 16; ++t) {
            const float* bp = buf + t * 64 + cgp * 4;
            const f32x4 w4 = *(const f32x4*)(bp), k4 = *(const f32x4*)(bp + 1024), a4 = *(const f32x4*)(bp + 2048), b4 = *(const f32x4*)(bp + 3072), r4 = *(const f32x4*)(bp + 4096);
            const float v = buf[5120 + t * 16 + il];
            float sa = (S0 * a4[0] + S1 * a4[1]) + (S2 * a4[2] + S3 * a4[3]);
            sa = row16_sum(sa);
            S0 = S0 * w4[0] + v * k4[0] + sa * b4[0];
            S1 = S1 * w4[1] + v * k4[1] + sa * b4[1];
            S2 = S2 * w4[2] + v * k4[2] + sa * b4[2];
            S3 = S3 * w4[3] + v * k4[3] + sa * b4[3];
            float y = (S0 * r4[0] + S1 * r4[1]) + (S2 * r4[2] + S3 * r4[3]);
            y = row16_sum(y);
            if (cgp == 0) yb[t * 16 + il] = y;
        }
        if (c + 1 < SEQ / 16) stage_write(bufs + ((c + 1) & 1) * SCAN_BUF);
        __syncthreads();
    }
    {
        const int c = SEQ / 16;
        const float* yp = ybuf + ((c - 1) & 1) * 256;
        YS[(size_t)(tokb + (c - 1) * 16 + (tid >> 4)) * 1024 + hh * 64 + rg * 16 + (tid & 15)] = f2bf(yp[tid]);
    }
}

constexpr int ATT_LDK = 72;
DI void attn_unit(const Params& p, int l, int unit, char* lds) {
    const int tid = threadIdx.x, lane = tid & 63, wid = tid >> 6, c = wid >> 1, qs = wid & 1, r32 = lane & 31, h = lane >> 5;
    const int qb = 127 - (unit >> 4), bh = unit & 15, hh = bh & 7, b = bh >> 3;
    bf16_t* sK = (bf16_t*)lds;
    bf16_t* sVT = (bf16_t*)(lds + 2 * 64 * ATT_LDK * 2);
    const bf16_t* Qg = (const bf16_t*)(p.ws + OFF_Q);
    const bf16_t* Kg = (const bf16_t*)(p.ws + OFF_K);
    const bf16_t* VTg = (const bf16_t*)(p.ws + OFF_VT) + (size_t)bh * 128 * 8192;
    const int query = qb * 64 + qs * 32 + r32;
    bf16x8 qf[4];
#pragma unroll
    for (int ks = 0; ks < 4; ++ks) qf[ks] = *(const bf16x8*)(Qg + ((size_t)(bh * 2 + c) * SEQ + query) * 64 + ks * 16 + h * 8);
    u32x4 rk[4], rv[4];
    auto stage_load = [&](int kt) {
#pragma unroll
        for (int i = 0; i < 4; ++i) {
            const int id = tid + 256 * i, cm = id >> 9, row = (id >> 3) & 63, c8 = id & 7;
            rk[i] = *(const u32x4*)(Kg + ((size_t)(bh * 2 + cm) * SEQ + kt * 64 + row) * 64 + c8 * 8);
            rv[i] = *(const u32x4*)(VTg + (size_t)kt * 8192 + id * 8);
        }
    };
    auto stage_write = [&]() {
#pragma unroll
        for (int i = 0; i < 4; ++i) {
            const int id = tid + 256 * i, cm = id >> 9, row = (id >> 3) & 63, c8 = id & 7;
            *(u32x4*)(sK + (cm * 64 + row) * ATT_LDK + c8 * 8) = rk[i];
            *(u32x4*)(sVT + id * 8) = rv[i];
        }
    };
    f32x16 O[4];
#pragma unroll
    for (int d = 0; d < 4; ++d)
#pragma unroll
        for (int e = 0; e < 16; ++e) O[d][e] = 0.f;
    float m_run = -INFINITY, lsum = 0.f;
    stage_load(0);
    for (int kt = 0; kt <= qb; ++kt) {
        __syncthreads();
        stage_write();
        __syncthreads();
        if (kt < qb) stage_load(kt + 1);
        f32x16 st[2];
#pragma unroll
        for (int kb = 0; kb < 2; ++kb) {
#pragma unroll
            for (int e = 0; e < 16; ++e) st[kb][e] = 0.f;
#pragma unroll
            for (int ks = 0; ks < 4; ++ks) {
                const bf16x8 kf = *(const bf16x8*)(sK + (c * 64 + kb * 32 + r32) * ATT_LDK + ks * 16 + h * 8);
                st[kb] = MFMA32(kf, qf[ks], st[kb]);
            }
        }
        if (kt == qb) {
            const int ql = qs * 32 + r32;
#pragma unroll
            for (int kb = 0; kb < 2; ++kb)
#pragma unroll
                for (int e = 0; e < 16; ++e) { const int keyl = kb * 32 + (e & 3) + 8 * (e >> 2) + 4 * h; if (keyl > ql) st[kb][e] = -INFINITY; }
        }
        float mx = st[0][0];
#pragma unroll
        for (int kb = 0; kb < 2; ++kb)
#pragma unroll
            for (int e = 0; e < 16; ++e) mx = fmaxf(mx, st[kb][e]);
        mx = fmaxf(mx, __shfl_xor(mx, 32));
        const float mnew = fmaxf(m_run, mx);
        const float alpha = __builtin_amdgcn_exp2f(m_run - mnew);
        m_run = mnew;
        float ps = 0.f;
#pragma unroll
        for (int kb = 0; kb < 2; ++kb)
#pragma unroll
            for (int e = 0; e < 16; ++e) { st[kb][e] = __builtin_amdgcn_exp2f(st[kb][e] - mnew); ps += st[kb][e]; }
        lsum = lsum * alpha + ps;
#pragma unroll
        for (int d = 0; d < 4; ++d)
#pragma unroll
            for (int e = 0; e < 16; ++e) O[d][e] *= alpha;
        bf16x8 pf[2][2];
#pragma unroll
        for (int kb = 0; kb < 2; ++kb)
#pragma unroll
            for (int s = 0; s < 2; ++s) {
                u32x4 pk;
                pk.x = pk2(st[kb][8 * s + 0], st[kb][8 * s + 1]); pk.y = pk2(st[kb][8 * s + 2], st[kb][8 * s + 3]);
                pk.z = pk2(st[kb][8 * s + 4], st[kb][8 * s + 5]); pk.w = pk2(st[kb][8 * s + 6], st[kb][8 * s + 7]);
                pf[kb][s] = __builtin_bit_cast(bf16x8, pk);
            }
#pragma unroll
        for (int d = 0; d < 4; ++d)
#pragma unroll
            for (int kb = 0; kb < 2; ++kb)
#pragma unroll
                for (int s = 0; s < 2; ++s) {
                    const bf16x8 vf = *(const bf16x8*)(sVT + (((d * 2 + kb) * 2 + s) * 64 + lane) * 8);
                    O[d] = MFMA32(vf, pf[kb][s], O[d]);
                }
    }
    const float ltot = lsum + __shfl_xor(lsum, 32);
    const float inv = 1.0f / ltot;
    float* xo = (float*)lds;
    __syncthreads();
    if (c == 1) {
#pragma unroll
        for (int d = 0; d < 4; ++d)
#pragma unroll
            for (int e = 0; e < 16; ++e) xo[(qs * 64 + d * 16 + e) * 64 + lane] = O[d][e] * inv;
    }
    __syncthreads();
    if (c == 0) {
        const float lam = ((const float*)(p.ws + OFF_CTRL + CT_LAM))[l];
        const float lam_init = 0.8f - 0.6f * expf(-0.3f * (float)l);
        float ss = 0.f;
#pragma unroll
        for (int d = 0; d < 4; ++d)
#pragma unroll
            for (int e = 0; e < 16; ++e) { const float o = O[d][e] * inv - lam * xo[(qs * 64 + d * 16 + e) * 64 + lane]; O[d][e] = o; ss += o * o; }
        ss += __shfl_xor(ss, 32);
        const float rstd = rsqrtf(ss * (1.0f / 128.0f) + 1e-6f) * (1.0f - lam_init);
        bf16_t* outp = (bf16_t*)(p.ws + OFF_ATTP) + (size_t)(b * SEQ + query) * 1024 + hh * 128;
        const float* hg = (const float*)p.in[I_AHG] + (size_t)(l * 8 + hh) * 128;
#pragma unroll
        for (int d = 0; d < 4; ++d)
#pragma unroll
            for (int g4 = 0; g4 < 4; ++g4) {
                const int dv0 = d * 32 + 8 * g4 + 4 * h;
                const f32x4 g = *(const f32x4*)(hg + dv0);
                *(u32x2*)(outp + dv0) = pack4(O[d][g4 * 4 + 0] * rstd * g[0], O[d][g4 * 4 + 1] * rstd * g[1], O[d][g4 * 4 + 2] * rstd * g[2], O[d][g4 * 4 + 3] * rstd * g[3]);
            }
    }
}

DI void rwkv_post_tile(const Params& p, int l, int tile, char* lds) {
    const int tid = threadIdx.x, t0 = tile * 16, n4 = tid * 4;
    const bf16_t* ZR = (const bf16_t*)(p.ws + OFF_ZR);
    const bf16_t* Ab = (const bf16_t*)(p.ws + OFF_A);
    const bf16_t* YS = (const bf16_t*)(p.ws + OFF_YS);
    const float* mu = (const float*)p.in[I_MU] + (size_t)l * RWKV_LD;
    float* sg = (float*)lds;
    __syncthreads();
    {
        const int tk = tid >> 4, c8 = (tid & 15) * 8;
        float z[8]; zr_shift8(ZR, mu, t0 + tk, 3200 + c8, z);
#pragma unroll
        for (int e = 0; e < 8; ++e) sg[tk * 128 + c8 + e] = sigmoidf_(z[e]);
    }
    __syncthreads();
    f32x4 gacc[16];
#pragma unroll
    for (int t = 0; t < 16; ++t) gacc[t] = (f32x4){0.f, 0.f, 0.f, 0.f};
    const float* g2 = (const float*)p.in[I_G2] + (size_t)l * 128 * 1024 + n4;
#pragma unroll 2
    for (int k = 0; k < 128; k += 4) {
        const f32x4 w0 = *(const f32x4*)(g2 + (size_t)(k + 0) * 1024), w1 = *(const f32x4*)(g2 + (size_t)(k + 1) * 1024),
                    w2 = *(const f32x4*)(g2 + (size_t)(k + 2) * 1024), w3 = *(const f32x4*)(g2 + (size_t)(k + 3) * 1024);
#pragma unroll
        for (int t = 0; t < 16; ++t) {
            const f32x4 a = *(const f32x4*)(sg + t * 128 + k);
            gacc[t] += a[0] * w0 + a[1] * w1 + a[2] * w2 + a[3] * w3;
        }
    }
    const f32x4 kav = *(const f32x4*)((const float*)p.in[I_KA] + l * 1024 + n4);
    const f32x4 rkv = *(const f32x4*)((const float*)p.in[I_RK] + l * 1024 + n4);
    const f32x4 gng = *(const f32x4*)((const float*)p.in[I_GNG] + l * 1024 + n4);
    const f32x4 gnb = *(const f32x4*)((const float*)p.in[I_GNB] + l * 1024 + n4);
    bf16_t* out = (bf16_t*)(p.ws + OFF_RWKVP);
#pragma unroll
    for (int t = 0; t < 16; ++t) {
        const int tok = t0 + t;
        float r[4], k[4], v[4], a[4], y[4];
        zr_shift4(ZR, mu, tok, n4, r); zr_shift4(ZR, mu, tok, 1024 + n4, k); zr_shift4(ZR, mu, tok, 2048 + n4, v);
        unpack4(*(const u32x2*)(Ab + (size_t)tok * 1024 + n4), a);
        unpack4(*(const u32x2*)(YS + (size_t)tok * 1024 + n4), y);
        float cf = 0.f, s1 = 0.f, s2 = 0.f;
#pragma unroll
        for (int e = 0; e < 4; ++e) { const float kn = k[e] * (1.0f + (a[e] - 1.0f) * kav[e]); cf += r[e] * kn * rkv[e]; s1 += y[e]; s2 += y[e] * y[e]; }
        cf = row16_sum(cf); s1 = row16_sum(s1); s2 = row16_sum(s2);
        const float mean = s1 * (1.0f / 64.0f), var = fmaxf(s2 * (1.0f / 64.0f) - mean * mean, 0.f), rstd = rsqrtf(var + 64e-5f);
        float o[4];
#pragma unroll
        for (int e = 0; e < 4; ++e) o[e] = ((y[e] - mean) * rstd * gng[e] + gnb[e] + cf * v[e]) * gacc[t][e];
        *(u32x2*)(out + (size_t)tok * 1024 + n4) = pack4(o[0], o[1], o[2], o[3]);
    }
}

DI void phaseF_tile(const Params& p, int mt, int nt, char* lds) {
    const int tid = threadIdx.x, lane = tid & 63, wid = tid >> 6, wm = wid >> 1, wn = wid & 1, fr = lane & 15, fq = lane >> 4;
    const int m0 = mt * 128 + wm * 64, nb = nt * 128 + wn * 64;
    const bf16_t* ZG = (const bf16_t*)(p.ws + OFF_ZG);
    f32x4 sum[4][4]; zero_acc(sum);
#pragma unroll 1
    for (int br = 0; br < 3; ++br) {
        const size_t xoff = br == 0 ? OFF_ATTP : br == 1 ? OFF_CONVP : OFF_RWKVP;
        const size_t woff = br == 0 ? W_ATTO : br == 1 ? W_CONVO : W_RWKVO;
        f32x4 acc[4][4]; zero_acc(acc);
        gemm_mainloop<false>(acc, (const bf16_t*)(p.ws + xoff) + (size_t)mt * 128 * 1024, 1024, (const bf16_t*)(p.ws + OFF_W + woff) + (size_t)nt * 128 * 1024, 1024, 1024, lds);
#pragma unroll
        for (int ti = 0; ti < 4; ++ti) {
            const int tok = m0 + ti * 16 + fr;
#pragma unroll
            for (int ni = 0; ni < 4; ++ni) {
                float g[4]; unpack4(*(const u32x2*)(ZG + (size_t)tok * ZG_LD + br * 1024 + nb + ni * 16 + fq * 4), g);
#pragma unroll
                for (int r = 0; r < 4; ++r) sum[ti][ni][r] += g[r] * acc[ti][ni][r];
            }
        }
    }
    bf16_t* out = (bf16_t*)(p.ws + OFF_MERGED);
#pragma unroll
    for (int ti = 0; ti < 4; ++ti) {
        const int tok = m0 + ti * 16 + fr;
#pragma unroll
        for (int ni = 0; ni < 4; ++ni)
            *(u32x2*)(out + (size_t)tok * 1024 + nb + ni * 16 + fq * 4) = pack4(sum[ti][ni][0], sum[ti][ni][1], sum[ti][ni][2], sum[ti][ni][3]);
    }
}
DI void phaseG_tile(const Params& p, int l, int mt, int nt, char* lds) {
    const int tid = threadIdx.x, lane = tid & 63, wid = tid >> 6, wm = wid >> 1, wn = wid & 1, fr = lane & 15, fq = lane >> 4;
    const int m0 = mt * 128 + wm * 64, nb = nt * 128 + wn * 64;
    f32x4 acc[4][4]; zero_acc(acc);
    gemm_mainloop<false>(acc, (const bf16_t*)(p.ws + OFF_MERGED) + (size_t)mt * 128 * 1024, 1024, (const bf16_t*)(p.ws + OFF_W + W_OUT) + (size_t)nt * 128 * 1024, 1024, 1024, lds);
    const float* xin = l == 0 ? (const float*)p.in[I_X] : p.out;
    const float* ada = (const float*)(p.ws + OFF_CTRL + CT_ADA) + (size_t)l * 2 * 6144;
#pragma unroll
    for (int ti = 0; ti < 4; ++ti) {
        const int tok = m0 + ti * 16 + fr, b = tok >> 13;
#pragma unroll
        for (int ni = 0; ni < 4; ++ni) {
            const int n = nb + ni * 16 + fq * 4;
            const f32x4 xv = *(const f32x4*)(xin + (size_t)tok * 1024 + n), gt = *(const f32x4*)(ada + b * 6144 + 2 * 1024 + n);
            *(f32x4*)(p.out + (size_t)tok * 1024 + n) = xv + (1.0f + gt) * acc[ti][ni];
        }
    }
}
DI void phaseI_tile(const Params& p, int mt, int nt, char* lds) {
    const int tid = threadIdx.x, lane = tid & 63, wid = tid >> 6, wm = wid >> 1, wn = wid & 1, fr = lane & 15, fq = lane >> 4;
    const int m0 = mt * 128 + wm * 64, nb = nt * 128 + wn * 64;
    f32x4 acc[4][4]; zero_acc(acc);
    gemm_mainloop<false>(acc, (const bf16_t*)(p.ws + OFF_H) + (size_t)mt * 128 * 1024, 1024, (const bf16_t*)(p.ws + OFF_W + W_QP) + (size_t)nt * 128 * 1024, 1024, 1024, lds);
    bf16_t* out = (bf16_t*)(p.ws + OFF_QP);
#pragma unroll
    for (int ti = 0; ti < 4; ++ti) {
        const int tok = m0 + ti * 16 + fr;
#pragma unroll
        for (int ni = 0; ni < 4; ++ni)
            *(u32x2*)(out + (size_t)tok * 2048 + nb + ni * 16 + fq * 4) = pack4(acc[ti][ni][0], acc[ti][ni][1], acc[ti][ni][2], acc[ti][ni][3]);
    }
}
DI void phaseJ_tile(const Params& p, int mt, int g, char* lds) {
    const int tid = threadIdx.x, lane = tid & 63, wid = tid >> 6, wm = wid >> 1, wn = wid & 1, fr = lane & 15, fq = lane >> 4;
    const int m0 = mt * 128 + wm * 64, nb = wn * 64;
    f32x4 acc[4][4]; zero_acc(acc);
    gemm_mainloop<false>(acc, (const bf16_t*)(p.ws + OFF_QP) + (size_t)mt * 128 * 2048 + g * 128, 2048, (const bf16_t*)(p.ws + OFF_W + ((g & 1) ? W_KEY2 : W_KEY1)), 128, 128, lds);
    float* out = (float*)(p.ws + OFF_SCORES);
#pragma unroll
    for (int ti = 0; ti < 4; ++ti) {
        const int tok = m0 + ti * 16 + fr;
#pragma unroll
        for (int ni = 0; ni < 4; ++ni) *(f32x4*)(out + (size_t)tok * 2048 + g * 128 + nb + ni * 16 + fq * 4) = acc[ti][ni];
    }
}

DI void topk_task(const Params& p, int task) {
    const int lane = threadIdx.x & 63, t = task >> 3, hd = task & 7;
    const float* sc = (const float*)(p.ws + OFF_SCORES) + (size_t)t * 2048 + hd * 256;
    float va = sc[lane], vb = sc[64 + lane], wa = sc[128 + lane], wb = sc[192 + lane];
    float my_v1 = 0.f; int my_i1 = 0; float my_v2[4] = {0.f, 0.f, 0.f, 0.f}; int my_i2[4] = {0, 0, 0, 0};
#pragma unroll
    for (int r = 0; r < 16; ++r) {
        {
            const bool pa = va >= vb; const float best = pa ? va : vb; const int bi = pa ? lane : lane + 64;
            const float m = wave_max(best);
            const unsigned long long ball = __ballot(best == m);
            const int src = __ffsll((long long)ball) - 1;
            const int idx = __shfl(bi, src);
            if (lane == src) { if (pa) va = -INFINITY; else vb = -INFINITY; }
            if ((lane >> 2) == r) { my_v1 = m; my_i1 = idx; }
        }
        {
            const bool pa = wa >= wb; const float best = pa ? wa : wb; const int bi = pa ? lane : lane + 64;
            const float m = wave_max(best);
            const unsigned long long ball = __ballot(best == m);
            const int src = __ffsll((long long)ball) - 1;
            const int idx = __shfl(bi, src);
            if (lane == src) { if (pa) wa = -INFINITY; else wb = -INFINITY; }
            if ((lane & 3) == (r >> 2)) { my_v2[r & 3] = m; my_i2[r & 3] = idx; }
        }
    }
    float cand[4];
#pragma unroll
    for (int q = 0; q < 4; ++q) cand[q] = my_v1 + my_v2[q];
    float out_v = 0.f; int out_e = 0;
#pragma unroll
    for (int r = 0; r < 16; ++r) {
        float best = cand[0]; int bq = 0;
#pragma unroll
        for (int q = 1; q < 4; ++q) if (cand[q] > best) { best = cand[q]; bq = q; }
        const float m = wave_max(best);
        const unsigned long long ball = __ballot(best == m);
        const int src = __ffsll((long long)ball) - 1;
        int e = my_i1 * 128 + (bq == 0 ? my_i2[0] : bq == 1 ? my_i2[1] : bq == 2 ? my_i2[2] : my_i2[3]);
        e = __shfl(e, src);
        if (lane == src) {
#pragma unroll
            for (int q = 0; q < 4; ++q) if (q == bq) cand[q] = -INFINITY;
        }
        if (lane == r) { out_v = m; out_e = e; }
    }
    const float mx = __shfl(out_v, 0);
    float pr = lane < 16 ? __expf(out_v - mx) : 0.f;
    const float sm = row16_sum(pr);
    if (lane < 16) {
        ((int*)(p.ws + OFF_EID))[(size_t)t * 128 + hd * 16 + lane] = out_e;
        ((float*)(p.ws + OFF_GATE))[(size_t)t * 128 + hd * 16 + lane] = pr / sm;
    }
}

DI void peer_token(const Params& p, int l, int t) {
    const int lane = threadIdx.x & 63, b = t >> 13;
    const bf16_t* U = (const bf16_t*)(p.ws + OFF_PU);
    const bf16_t* V = (const bf16_t*)(p.ws + OFF_PV);
    bf16_t* H = (bf16_t*)(p.ws + OFF_H);
    float hv[16];
    { float f[8]; unpack8(*(const u32x4*)(H + (size_t)t * 1024 + lane * 8), f); for (int e = 0; e < 8; ++e) hv[e] = f[e];
      unpack8(*(const u32x4*)(H + (size_t)t * 1024 + 512 + lane * 8), f); for (int e = 0; e < 8; ++e) hv[8 + e] = f[e]; }
    const int* eidp = (const int*)(p.ws + OFF_EID) + (size_t)t * 128;
    const float* gatep = (const float*)(p.ws + OFF_GATE) + (size_t)t * 128;
    const int id0 = eidp[lane], id1 = eidp[64 + lane];
    const float g0 = gatep[lane], g1 = gatep[64 + lane];
    float acc[16];
#pragma unroll
    for (int e = 0; e < 16; ++e) acc[e] = 0.f;
#pragma unroll 1
    for (int half = 0; half < 2; ++half) {
        const int idr = half ? id1 : id0; const float gr = half ? g1 : g0;
#pragma unroll 4
        for (int j = 0; j < 64; ++j) {
            const int id = __shfl(idr, j); const float gate = __shfl(gr, j);
            const bf16_t* ur = U + (size_t)id * 1024; const bf16_t* vr = V + (size_t)id * 1024;
            const u32x4 u0 = *(const u32x4*)(ur + lane * 8), u1 = *(const u32x4*)(ur + 512 + lane * 8);
            const u32x4 v0 = *(const u32x4*)(vr + lane * 8), v1 = *(const u32x4*)(vr + 512 + lane * 8);
            float uf[8], dot = 0.f;
            unpack8(u0, uf);
#pragma unroll
            for (int e = 0; e < 8; ++e) dot += hv[e] * uf[e];
            unpack8(u1, uf);
#pragma unroll
            for (int e = 0; e < 8; ++e) dot += hv[8 + e] * uf[e];
            dot = wave_sum(dot);
            const float act = 0.5f * dot * (1.0f + erff(dot * 0.7071067811865476f)) * gate;
            float vf[8];
            unpack8(v0, vf);
#pragma unroll
            for (int e = 0; e < 8; ++e) acc[e] += act * vf[e];
            unpack8(v1, vf);
#pragma unroll
            for (int e = 0; e < 8; ++e) acc[8 + e] += act * vf[e];
        }
    }
    const float* ada = (const float*)(p.ws + OFF_CTRL + CT_ADA) + (size_t)(l * 2 + b) * 6144;
    float xv[16], ss = 0.f;
#pragma unroll
    for (int hseg = 0; hseg < 2; ++hseg)
#pragma unroll
        for (int q = 0; q < 2; ++q) {
            const int n = hseg * 512 + lane * 8 + q * 4;
            const f32x4 x1 = *(const f32x4*)(p.out + (size_t)t * 1024 + n), gt = *(const f32x4*)(ada + 5 * 1024 + n);
#pragma unroll
            for (int e = 0; e < 4; ++e) { const float x2 = x1[e] + (1.0f + gt[e]) * acc[hseg * 8 + q * 4 + e]; xv[hseg * 8 + q * 4 + e] = x2; ss += x2 * x2; }
        }
    ss = wave_sum(ss);
    const float rstd = rsqrtf(ss * (1.0f / 1024.0f) + 1e-6f);
    if (l + 1 < DEPTH) {
        const float* ada2 = (const float*)(p.ws + OFF_CTRL + CT_ADA) + (size_t)((l + 1) * 2 + b) * 6144;
        const float* g1n = (const float*)p.in[I_N1G] + (size_t)(l + 1) * 1024;
#pragma unroll
        for (int hseg = 0; hseg < 2; ++hseg) {
            const int n = hseg * 512 + lane * 8;
            float o[8];
#pragma unroll
            for (int q = 0; q < 2; ++q) {
                const f32x4 g = *(const f32x4*)(g1n + n + q * 4), sh = *(const f32x4*)(ada2 + n + q * 4), sc = *(const f32x4*)(ada2 + 1024 + n + q * 4);
                *(f32x4*)(p.out + (size_t)t * 1024 + n + q * 4) = (f32x4){xv[hseg * 8 + q * 4], xv[hseg * 8 + q * 4 + 1], xv[hseg * 8 + q * 4 + 2], xv[hseg * 8 + q * 4 + 3]};
#pragma unroll
                for (int e = 0; e < 4; ++e) o[q * 4 + e] = xv[hseg * 8 + q * 4 + e] * rstd * g[e] * (1.0f + sc[e]) + sh[e];
            }
            u32x4 w; w.x = pk2(o[0], o[1]); w.y = pk2(o[2], o[3]); w.z = pk2(o[4], o[5]); w.w = pk2(o[6], o[7]);
            *(u32x4*)(H + (size_t)t * 1024 + n) = w;
        }
    } else {
        const float* fg = (const float*)p.in[I_FG];
#pragma unroll
        for (int hseg = 0; hseg < 2; ++hseg)
#pragma unroll
            for (int q = 0; q < 2; ++q) {
                const int n = hseg * 512 + lane * 8 + q * 4;
                const f32x4 g = *(const f32x4*)(fg + n);
                f32x4 o;
#pragma unroll
                for (int e = 0; e < 4; ++e) o[e] = xv[hseg * 8 + q * 4 + e] * rstd * g[e];
                *(f32x4*)(p.out + (size_t)t * 1024 + n) = o;
            }
    }
}

constexpr int LDS_BYTES = 49152;
constexpr int N_PHASES = 2 + 11 * DEPTH;
#ifndef MULTI_LAUNCH
#define MULTI_LAUNCH 1
#endif

template <int ph> DI void run_phase(const Params& p, char* lds) {
    const int bid = blockIdx.x, nblk = gridDim.x, tid = threadIdx.x;
    const int gw = bid * 4 + (tid >> 6), nw = nblk * 4;
    float* ada = (float*)(p.ws + OFF_CTRL + CT_ADA);
    if (ph == 0) {
        const int total = 192 + 1 + 256 + NCONV_ITEMS;
        for (int it = bid; it < total; it += nblk) {
            if (it < 192) ada_item(p, it, lds);
            else if (it == 192) lam_item(p);
            else if (it < 449) rope_item(p, it - 193);
            else convert_item(p, 0, it - 449, lds);
        }
        return;
    }
    if (ph == 1) { norm_rows(p, (const float*)p.in[I_X], (const float*)p.in[I_N1G], ada, ada + 1024, (bf16_t*)(p.ws + OFF_H)); return; }
    constexpr int l = (ph - 2) / 11, sub = (ph - 2) % 11;
    switch (sub) {
    case 0:
        for (int tile = bid; tile < 128 * 90; tile += nblk) { int mt, nt; tile_coords(tile, 90, mt, nt); phaseB_tile(p, mt, nt, lds); }
        break;
    case 1:
        for (int it = bid; it < 2048; it += nblk) { if (it < 1024) rwkv_prep_tile(p, l, it, lds); else conv_tile(p, l, it - 1024, lds); }
        break;
    case 2: {
        if (bid < 128) scan_block(p, l, bid, lds);
        unsigned* cnt = (unsigned*)(p.ws + OFF_CTRL + CT_CNT) + l;
        int* s_unit = (int*)(lds + LDS_BYTES - 16);
        for (;;) {
            __syncthreads();
            if (tid == 0) *s_unit = (int)atomicAdd(cnt, 1u);
            __syncthreads();
            const int unit = *s_unit;
            if (unit >= 2048) break;
            attn_unit(p, l, unit, lds);
        }
        break; }
    case 3:
        for (int it = bid; it < 1024; it += nblk) rwkv_post_tile(p, l, it, lds);
        break;
    case 4:
        for (int tile = bid; tile < 128 * 8; tile += nblk) { int mt, nt; tile_coords(tile, 8, mt, nt); phaseF_tile(p, mt, nt, lds); }
        break;
    case 5:
        for (int it = bid; it < 1024 + 2048; it += nblk) {
            if (it < 1024) { int mt, nt; tile_coords(it, 8, mt, nt); phaseG_tile(p, l, mt, nt, lds); }
            else convert_uv_item(p, l, it - 1024);
        }
        break;
    case 6:
        norm_rows(p, p.out, (const float*)p.in[I_N2G] + (size_t)l * 1024, ada + (size_t)l * 2 * 6144 + 3 * 1024, ada + (size_t)l * 2 * 6144 + 4 * 1024, (bf16_t*)(p.ws + OFF_H));
        break;
    case 7:
        for (int tile = bid; tile < 128 * 16; tile += nblk) { int mt, nt; tile_coords(tile, 16, mt, nt); phaseI_tile(p, mt, nt, lds); }
        break;
    case 8:
        for (int tile = bid; tile < 128 * 16; tile += nblk) { int mt, nt; tile_coords(tile, 16, mt, nt); phaseJ_tile(p, mt, nt, lds); }
        break;
    case 9:
        for (int task = gw; task < NT * 8; task += nw) topk_task(p, task);
        if (l + 1 < DEPTH) for (int it = bid; it < NCONV_ITEMS; it += nblk) convert_item(p, l + 1, it, lds);
        break;
    case 10:
        for (int t = gw; t < NT; t += nw) peer_token(p, l, t);
        break;
    }
}

#define PHASE(N) if (p.ph_begin <= N && N < p.ph_end) { run_phase<N>(p, lds); if (N + 1 < p.ph_end) cg::this_grid().sync(); }
__global__ void __launch_bounds__(NTHREADS, 2) mega_kernel(Params p) {
    __shared__ __attribute__((aligned(16))) char lds[LDS_BYTES];
    PHASE(0) PHASE(1) PHASE(2) PHASE(3) PHASE(4) PHASE(5) PHASE(6) PHASE(7) PHASE(8) PHASE(9) PHASE(10) PHASE(11) PHASE(12)
    PHASE(13) PHASE(14) PHASE(15) PHASE(16) PHASE(17) PHASE(18) PHASE(19) PHASE(20) PHASE(21) PHASE(22) PHASE(23)
    static_assert(N_PHASES == 24, "phase list");
}

extern "C" void kernel_launch(void* const* d_in, const int* in_sizes, int n_in, void* d_out, int out_size, void* d_ws, size_t ws_size, hipStream_t stream) {
    static int grid_blocks = 0;
    if (!grid_blocks) {
        int dev = 0, cus = 0, per_cu = 0;
        hipGetDevice(&dev);
        hipDeviceGetAttribute(&cus, hipDeviceAttributeMultiprocessorCount, dev);
        hipOccupancyMaxActiveBlocksPerMultiprocessor(&per_cu, mega_kernel, NTHREADS, 0);
        if (per_cu > 2) per_cu = 2;
        if (per_cu < 1) per_cu = 1;
        grid_blocks = cus * per_cu;
        if (ws_size < WS_END) fprintf(stderr, "workspace too small: %zu < %zu\n", ws_size, (size_t)WS_END);
    }
    Params p{};
    for (int i = 0; i < N_IN; ++i) p.in[i] = d_in[i];
    p.out = (float*)d_out; p.ws = (char*)d_ws;
    hipMemsetAsync(d_ws, 0, 4096, stream);
#if MULTI_LAUNCH
    for (int ph = 0; ph < N_PHASES; ++ph) {
        p.ph_begin = ph; p.ph_end = ph + 1;
        hipLaunchKernelGGL(mega_kernel, dim3(grid_blocks), dim3(NTHREADS), 0, stream, p);
    }
#else
    p.ph_begin = 0; p.ph_end = N_PHASES;
    void* args[] = {&p};
    hipError_t e = hipLaunchCooperativeKernel((void*)mega_kernel, dim3(grid_blocks), dim3(NTHREADS), args, 0, stream);
    if (e != hipSuccess) fprintf(stderr, "cooperative launch failed: %s (grid %d)\n", hipGetErrorString(e), grid_blocks);
#endif
}
```

```cpp
#include <hip/hip_runtime.h>
#include <hip/hip_cooperative_groups.h>
#include <cstdio>
#include <cstdint>
namespace cg = cooperative_groups;

#define DI __device__ __forceinline__
typedef unsigned short bf16_t;
typedef short bf16x8 __attribute__((ext_vector_type(8)));
typedef float f32x2 __attribute__((ext_vector_type(2)));
typedef float f32x4 __attribute__((ext_vector_type(4)));
typedef float f32x16 __attribute__((ext_vector_type(16)));
typedef unsigned u32x2 __attribute__((ext_vector_type(2)));
typedef unsigned u32x4 __attribute__((ext_vector_type(4)));
typedef __bf16 nbf16x2 __attribute__((ext_vector_type(2)));

constexpr int NB = 2, SEQ = 8192, NT = NB * SEQ, DM = 1024, CIN = 11520, DEPTH = 2;
constexpr int NTHREADS = 256;
constexpr size_t MiB = (size_t)1 << 20;
constexpr size_t OFF_CTRL = 0, OFF_ROPE = 1 * MiB, OFF_W = 5 * MiB, OFF_H = 41 * MiB, OFF_Q = 73 * MiB, OFF_K = 105 * MiB,
                 OFF_VT = 137 * MiB, OFF_UC = 169 * MiB, OFF_ZR = 201 * MiB, OFF_ZG = 305 * MiB, OFF_A = 401 * MiB,
                 OFF_LW = 433 * MiB, OFF_YS = 465 * MiB, WS_END = 497 * MiB;
constexpr size_t OFF_CONVP = OFF_H, OFF_ATTP = OFF_UC, OFF_RWKVP = OFF_Q, OFF_MERGED = OFF_K, OFF_PU = OFF_ZR,
                 OFF_PV = OFF_ZR + 32 * MiB, OFF_QP = OFF_ZG, OFF_SCORES = OFF_Q, OFF_EID = OFF_A, OFF_GATE = OFF_A + 8 * MiB;
constexpr size_t W_IN = 0, W_ATTO = (size_t)CIN * 1024 * 2, W_CONVO = W_ATTO + 2 * MiB, W_RWKVO = W_CONVO + 2 * MiB,
                 W_OUT = W_RWKVO + 2 * MiB, W_QP = W_OUT + 2 * MiB, W_KEY1 = W_QP + 4 * MiB, W_KEY2 = W_KEY1 + 32768;
static_assert(W_KEY2 + 32768 <= 36 * MiB, "W region overflow");
constexpr size_t CT_CNT = 0, CT_LAM = 1024, CT_ADA = 65536;
constexpr int RWKV_LD = 3328, ZG_LD = 3072;

enum { I_X = 0, I_C, I_POS, I_WADA, I_BADA, I_N1G, I_WIN, I_LQ1, I_LK1, I_LQ2, I_LK2, I_AHG, I_WATTO, I_CONVW, I_CONVB, I_CLNG, I_CLNB,
       I_WCONVO, I_MU, I_W0, I_W2, I_A0, I_A2, I_G2, I_KK, I_KA, I_RK, I_GNG, I_GNB, I_WRWKVO, I_WOUT, I_N2G, I_WQ, I_KEY1, I_KEY2,
       I_PU, I_PV, I_FG, N_IN };

struct Params {
    const void* in[N_IN];
    float* out;
    char* ws;
    int ph_begin, ph_end;
};

DI unsigned pk2(float lo, float hi) { f32x2 v = {lo, hi}; nbf16x2 b = __builtin_convertvector(v, nbf16x2); return __builtin_bit_cast(unsigned, b); }
DI float bflo(unsigned u) { return __uint_as_float(u << 16); }
DI float bfhi(unsigned u) { return __uint_as_float(u & 0xffff0000u); }
DI float bf2f(bf16_t h) { return __uint_as_float(((unsigned)h) << 16); }
DI bf16_t f2bf(float x) { return (bf16_t)(pk2(x, x) & 0xffffu); }
DI float sigmoidf_(float x) { return 1.0f / (1.0f + __expf(-x)); }
DI float siluf_(float x) { return x / (1.0f + __expf(-x)); }
template <int CTRL> DI float dpp_f(float x) { return __int_as_float(__builtin_amdgcn_update_dpp(0, __float_as_int(x), CTRL, 0xF, 0xF, true)); }
DI float row16_sum(float x) { x += dpp_f<0xB1>(x); x += dpp_f<0x4E>(x); x += dpp_f<0x141>(x); x += dpp_f<0x140>(x); return x; }
DI float row16_max(float x) { x = fmaxf(x, dpp_f<0xB1>(x)); x = fmaxf(x, dpp_f<0x4E>(x)); x = fmaxf(x, dpp_f<0x141>(x)); x = fmaxf(x, dpp_f<0x140>(x)); return x; }
DI float wave_sum(float x) { x = row16_sum(x); x += __shfl_xor(x, 16); x += __shfl_xor(x, 32); return x; }
DI float wave_max(float x) { x = row16_max(x); x = fmaxf(x, __shfl_xor(x, 16)); x = fmaxf(x, __shfl_xor(x, 32)); return x; }
DI void unpack8(u32x4 v, float (&f)[8]) { f[0] = bflo(v.x); f[1] = bfhi(v.x); f[2] = bflo(v.y); f[3] = bfhi(v.y); f[4] = bflo(v.z); f[5] = bfhi(v.z); f[6] = bflo(v.w); f[7] = bfhi(v.w); }
DI void unpack4(u32x2 v, float (&f)[4]) { f[0] = bflo(v.x); f[1] = bfhi(v.x); f[2] = bflo(v.y); f[3] = bfhi(v.y); }
DI u32x2 pack4(float a, float b, float c, float d) { u32x2 r; r.x = pk2(a, b); r.y = pk2(c, d); return r; }

#define MFMA16(a, b, c) __builtin_amdgcn_mfma_f32_16x16x32_bf16((a), (b), (c), 0, 0, 0)
#define MFMA32(a, b, c) __builtin_amdgcn_mfma_f32_32x32x16_bf16((a), (b), (c), 0, 0, 0)

constexpr int LDK = 72;
constexpr int GEMM_LDS = 2 * 128 * LDK * 2;

template <bool NMODE>
DI void gemm_mainloop(f32x4 (&acc)[4][4], const bf16_t* X, size_t ldx, const bf16_t* W, size_t ldw, int K, char* lds) {
    bf16_t* sx = (bf16_t*)lds;
    bf16_t* sw = sx + 128 * LDK;
    const int tid = threadIdx.x, lane = tid & 63, wid = tid >> 6, wm = wid >> 1, wn = wid & 1;
    const int srow = tid >> 3, sc8 = (tid & 7) * 8;
    const bf16_t* gx = X + (size_t)srow * ldx + sc8;
    const bf16_t* gw = W + (size_t)srow * ldw + sc8;
    u32x4 rx[4], rw[4];
#pragma unroll
    for (int i = 0; i < 4; ++i) { rx[i] = *(const u32x4*)(gx + (size_t)(32 * i) * ldx); rw[i] = *(const u32x4*)(gw + (size_t)(32 * i) * ldw); }
    const int nk = K >> 6;
    const int fr = lane & 15, fq = lane >> 4;
    for (int kt = 0; kt < nk; ++kt) {
        __syncthreads();
#pragma unroll
        for (int i = 0; i < 4; ++i) { *(u32x4*)(sx + (srow + 32 * i) * LDK + sc8) = rx[i]; *(u32x4*)(sw + (srow + 32 * i) * LDK + sc8) = rw[i]; }
        __syncthreads();
        if (kt + 1 < nk) {
            const int ko = (kt + 1) * 64;
#pragma unroll
            for (int i = 0; i < 4; ++i) { rx[i] = *(const u32x4*)(gx + (size_t)(32 * i) * ldx + ko); rw[i] = *(const u32x4*)(gw + (size_t)(32 * i) * ldw + ko); }
        }
#pragma unroll
        for (int ks = 0; ks < 2; ++ks) {
            bf16x8 xf[4], wf[4];
#pragma unroll
            for (int i = 0; i < 4; ++i) {
                xf[i] = *(const bf16x8*)(sx + (wm * 64 + i * 16 + fr) * LDK + ks * 32 + fq * 8);
                wf[i] = *(const bf16x8*)(sw + (wn * 64 + i * 16 + fr) * LDK + ks * 32 + fq * 8);
            }
#pragma unroll
            for (int ti = 0; ti < 4; ++ti)
#pragma unroll
                for (int ni = 0; ni < 4; ++ni)
                    acc[ti][ni] = NMODE ? MFMA16(xf[ti], wf[ni], acc[ti][ni]) : MFMA16(wf[ni], xf[ti], acc[ti][ni]);
        }
    }
}
DI void zero_acc(f32x4 (&acc)[4][4]) {
#pragma unroll
    for (int i = 0; i < 4; ++i)
#pragma unroll
        for (int j = 0; j < 4; ++j) acc[i][j] = (f32x4){0.f, 0.f, 0.f, 0.f};
}
DI void tile_coords(int tile, int nN, int& mt, int& nt) { const int per = 16 * nN; const int g = tile / per, r = tile % per; nt = r >> 4; mt = g * 16 + (r & 15); }

DI void ada_item(const Params& p, int item, char* lds) {
    const int l = item / 96, cgp = item % 96, tid = threadIdx.x, lane = tid & 63, wid = tid >> 6;
    const float* c = (const float*)p.in[I_C];
    const float* w = (const float*)p.in[I_WADA] + (size_t)l * 1024 * 6144 + cgp * 64 + lane;
    float a0 = 0.f, a1 = 0.f;
    const int k0 = wid * 256;
#pragma unroll 8
    for (int k = k0; k < k0 + 256; ++k) {
        const float wv = w[(size_t)k * 6144];
        a0 += siluf_(c[k]) * wv; a1 += siluf_(c[1024 + k]) * wv;
    }
    float* red = (float*)lds;
    __syncthreads();
    red[(wid * 2 + 0) * 64 + lane] = a0; red[(wid * 2 + 1) * 64 + lane] = a1;
    __syncthreads();
    if (tid < 128) {
        const int b = tid >> 6, n = cgp * 64 + (tid & 63);
        float s = ((const float*)p.in[I_BADA])[l * 6144 + n];
        for (int w4 = 0; w4 < 4; ++w4) s += red[(w4 * 2 + b) * 64 + (tid & 63)];
        ((float*)(p.ws + OFF_CTRL + CT_ADA))[(l * 2 + b) * 6144 + n] = s;
    }
}
DI void lam_item(const Params& p) {
    if (threadIdx.x < 64) {
        const int lane = threadIdx.x;
        for (int l = 0; l < DEPTH; ++l) {
            float s1 = ((const float*)p.in[I_LQ1])[l * 64 + lane] * ((const float*)p.in[I_LK1])[l * 64 + lane];
            float s2 = ((const float*)p.in[I_LQ2])[l * 64 + lane] * ((const float*)p.in[I_LK2])[l * 64 + lane];
            s1 = wave_sum(s1); s2 = wave_sum(s2);
            const float lam_init = 0.8f - 0.6f * expf(-0.3f * (float)l);
            if (lane == 0) ((float*)(p.ws + OFF_CTRL + CT_LAM))[l] = expf(s1) - expf(s2) + lam_init;
        }
    }
}
DI void rope_item(const Params& p, int item) {
    const int* pos = (const int*)p.in[I_POS];
    float* rc = (float*)(p.ws + OFF_ROPE);
    float* rs = rc + (size_t)NT * 32;
#pragma unroll
    for (int e = 0; e < 8; ++e) {
        const int idx = item * 2048 + e * 256 + threadIdx.x;
        const int t = idx >> 5, i = idx & 31;
        const float inv = powf(10000.0f, -(float)i / 32.0f);
        const float ang = (float)pos[t] * inv;
        float sn, cs; sincosf(ang, &sn, &cs);
        rc[idx] = cs; rs[idx] = sn;
    }
}
DI int win_srcmap(int n) {
    if (n < 3072 || n >= 5120) return n;
    const int q = n - 3072, j = q >> 6, r = q & 63;
    return r < 32 ? 3072 + 32 * j + r : 3072 + 1024 + 32 * j + (r - 32);
}
DI void transpose_tile(const float* src, int N, bf16_t* dst, int k0, int n0, bool perm, char* lds) {
    float* t = (float*)lds;
    const int tid = threadIdx.x;
    const int r = tid >> 4, c4 = (tid & 15) * 4;
    int ns = n0 + c4; if (perm) ns = win_srcmap(ns);
    __syncthreads();
#pragma unroll
    for (int i = 0; i < 4; ++i) {
        const int kl = r + 16 * i;
        const f32x4 v = *(const f32x4*)(src + (size_t)(k0 + kl) * N + ns);
        t[(c4 + 0) * 65 + kl] = v[0]; t[(c4 + 1) * 65 + kl] = v[1]; t[(c4 + 2) * 65 + kl] = v[2]; t[(c4 + 3) * 65 + kl] = v[3];
    }
    __syncthreads();
    const int nl = tid >> 2, kq = (tid & 3) * 16;
    u32x4 o0, o1;
    const float* tr = t + nl * 65 + kq;
    o0.x = pk2(tr[0], tr[1]); o0.y = pk2(tr[2], tr[3]); o0.z = pk2(tr[4], tr[5]); o0.w = pk2(tr[6], tr[7]);
    o1.x = pk2(tr[8], tr[9]); o1.y = pk2(tr[10], tr[11]); o1.z = pk2(tr[12], tr[13]); o1.w = pk2(tr[14], tr[15]);
    bf16_t* d = dst + (size_t)(n0 + nl) * 1024 + k0 + kq;
    *(u32x4*)d = o0; *(u32x4*)(d + 8) = o1;
}
constexpr int NCONV_ITEMS = 2880 + 1024 + 512 + 2;
DI void convert_item(const Params& p, int l, int item, char* lds) {
    char* wb = p.ws + OFF_W;
    if (item < 2880) { const int kt = item % 16, nt = item / 16; transpose_tile((const float*)p.in[I_WIN] + (size_t)l * 1024 * CIN, CIN, (bf16_t*)(wb + W_IN), kt * 64, nt * 64, true, lds); return; }
    item -= 2880;
    if (item < 1024) {
        const int which = item >> 8, it = item & 255, kt = it & 15, nt = it >> 4;
        const int idx = which == 0 ? I_WATTO : which == 1 ? I_WCONVO : which == 2 ? I_WRWKVO : I_WOUT;
        const size_t off = which == 0 ? W_ATTO : which == 1 ? W_CONVO : which == 2 ? W_RWKVO : W_OUT;
        transpose_tile((const float*)p.in[idx] + (size_t)l * 1024 * 1024, 1024, (bf16_t*)(wb + off), kt * 64, nt * 64, false, lds); return;
    }
    item -= 1024;
    if (item < 512) { const int kt = item & 15, nt = item >> 4; transpose_tile((const float*)p.in[I_WQ] + (size_t)l * 1024 * 2048, 2048, (bf16_t*)(wb + W_QP), kt * 64, nt * 64, false, lds); return; }
    item -= 512;
    {
        const float* src = (const float*)p.in[item == 0 ? I_KEY1 : I_KEY2] + (size_t)l * 16384;
        bf16_t* dst = (bf16_t*)(wb + (item == 0 ? W_KEY1 : W_KEY2));
        for (int i = threadIdx.x * 4; i < 16384; i += 1024) { const f32x4 v = *(const f32x4*)(src + i); *(u32x2*)(dst + i) = pack4(v[0], v[1], v[2], v[3]); }
    }
}
DI void convert_uv_item(const Params& p, int l, int item) {
    const int arr = item >> 10, chunk = item & 1023;
    const float* src = (const float*)p.in[arr == 0 ? I_PU : I_PV] + (size_t)l * 16384 * 1024 + (size_t)chunk * 16384;
    bf16_t* dst = (bf16_t*)(p.ws + (arr == 0 ? OFF_PU : OFF_PV)) + (size_t)chunk * 16384;
#pragma unroll
    for (int it = 0; it < 8; ++it) {
        const int i = it * 2048 + threadIdx.x * 8;
        const f32x4 a = *(const f32x4*)(src + i), b = *(const f32x4*)(src + i + 4);
        u32x4 o; o.x = pk2(a[0], a[1]); o.y = pk2(a[2], a[3]); o.z = pk2(b[0], b[1]); o.w = pk2(b[2], b[3]);
        *(u32x4*)(dst + i) = o;
    }
}

DI void norm_rows(const Params& p, const float* xin, const float* gain, const float* shv, const float* scv, bf16_t* out) {
    const int lane = threadIdx.x & 63;
    const int gw = blockIdx.x * 4 + (threadIdx.x >> 6), nw = gridDim.x * 4;
    for (int t = gw; t < NT; t += nw) {
        const int b = t >> 13;
        f32x4 v[4]; float ss = 0.f;
#pragma unroll
        for (int i = 0; i < 4; ++i) { v[i] = *(const f32x4*)(xin + (size_t)t * 1024 + i * 256 + lane * 4); ss += v[i][0] * v[i][0] + v[i][1] * v[i][1] + v[i][2] * v[i][2] + v[i][3] * v[i][3]; }
        ss = wave_sum(ss);
        const float rstd = rsqrtf(ss * (1.0f / 1024.0f) + 1e-6f);
#pragma unroll
        for (int i = 0; i < 4; ++i) {
            const int n = i * 256 + lane * 4;
            const f32x4 g = *(const f32x4*)(gain + n), sc = *(const f32x4*)(scv + b * 6144 + n), sh = *(const f32x4*)(shv + b * 6144 + n);
            float o[4];
#pragma unroll
            for (int e = 0; e < 4; ++e) o[e] = v[i][e] * rstd * g[e] * (1.0f + sc[e]) + sh[e];
            *(u32x2*)(out + (size_t)t * 1024 + n) = pack4(o[0], o[1], o[2], o[3]);
        }
    }
}

DI void phaseB_tile(const Params& p, int mt, int nt, char* lds) {
    const int tid = threadIdx.x, lane = tid & 63, wid = tid >> 6, wm = wid >> 1, wn = wid & 1;
    const int fr = lane & 15, fq = lane >> 4;
    const bf16_t* X = (const bf16_t*)(p.ws + OFF_H) + (size_t)mt * 128 * 1024;
    const bf16_t* W = (const bf16_t*)(p.ws + OFF_W + W_IN) + (size_t)nt * 128 * 1024;
    const int n0 = nt * 128, nb = n0 + wn * 64;
    const int m0 = mt * 128 + wm * 64;
    f32x4 acc[4][4]; zero_acc(acc);
    if (n0 >= 2048 && n0 < 3072) {
        gemm_mainloop<true>(acc, X, 1024, W, 1024, 1024, lds);
        bf16_t* VT = (bf16_t*)(p.ws + OFF_VT);
#pragma unroll
        for (int ni = 0; ni < 4; ++ni) {
            const int col = nb - 2048 + ni * 16 + fr, hh = col >> 7, dv = col & 127, d = dv >> 5, rr = dv & 31;
#pragma unroll
            for (int ti = 0; ti < 4; ++ti) {
                const int tok = m0 + ti * 16 + fq * 4;
                const int b = tok >> 13, s = tok & 8191, kt = s >> 6, kl = s & 63, kb = kl >> 5, x = kl & 31;
                const int s_ = (x >> 4) & 1, jhi = (x >> 3) & 1, h_ = (x >> 2) & 1;
                const size_t base = ((size_t)((b * 8 + hh) * 128 + kt)) * 8192 + (size_t)(((((d * 2 + kb) * 2 + s_) * 2 + h_) * 32 + rr) * 8 + jhi * 4);
                *(u32x2*)(VT + base) = pack4(acc[ti][ni][0], acc[ti][ni][1], acc[ti][ni][2], acc[ti][ni][3]);
            }
        }
        return;
    }
    gemm_mainloop<false>(acc, X, 1024, W, 1024, 1024, lds);
    if (n0 < 2048) {
        const bool isK = n0 >= 1024;
        const int nn = nb - (isK ? 1024 : 0), hh = nn >> 7, c = (nn >> 6) & 1;
        const float scl = isK ? 1.0f : 0.125f * 1.4426950408889634f;
        bf16_t* dst = (bf16_t*)(p.ws + (isK ? OFF_K : OFF_Q));
        const float* rc = (const float*)(p.ws + OFF_ROPE);
        const float* rs = rc + (size_t)NT * 32;
#pragma unroll
        for (int ti = 0; ti < 4; ++ti) {
            const int tok = m0 + ti * 16 + fr, b = tok >> 13, s = tok & 8191;
            bf16_t* row = dst + ((size_t)(((b * 8 + hh) * 2 + c)) * SEQ + s) * 64;
#pragma unroll
            for (int ni = 0; ni < 2; ++ni) {
                const int i0 = ni * 16 + fq * 4;
                const f32x4 cs = *(const f32x4*)(rc + (size_t)tok * 32 + i0), sn = *(const f32x4*)(rs + (size_t)tok * 32 + i0);
                float o1[4], o2[4];
#pragma unroll
                for (int r = 0; r < 4; ++r) {
                    const float t1 = acc[ti][ni][r], t2 = acc[ti][ni + 2][r];
                    o1[r] = (t1 * cs[r] - t2 * sn[r]) * scl; o2[r] = (t2 * cs[r] + t1 * sn[r]) * scl;
                }
                *(u32x2*)(row + i0) = pack4(o1[0], o1[1], o1[2], o1[3]);
                *(u32x2*)(row + 32 + i0) = pack4(o2[0], o2[1], o2[2], o2[3]);
            }
        }
    } else if (n0 < 5120) {
        const int j = (nb - 3072) >> 6;
        bf16_t* UC = (bf16_t*)(p.ws + OFF_UC);
#pragma unroll
        for (int ti = 0; ti < 4; ++ti) {
            const int tok = m0 + ti * 16 + fr;
#pragma unroll
            for (int ni = 0; ni < 2; ++ni) {
                const int ch = 32 * j + ni * 16 + fq * 4;
                float o[4];
#pragma unroll
                for (int r = 0; r < 4; ++r) o[r] = acc[ti][ni][r] * sigmoidf_(acc[ti][ni + 2][r]);
                *(u32x2*)(UC + (size_t)tok * 1024 + ch) = pack4(o[0], o[1], o[2], o[3]);
            }
        }
    } else if (n0 < 8448) {
        bf16_t* ZR = (bf16_t*)(p.ws + OFF_ZR);
#pragma unroll
        for (int ti = 0; ti < 4; ++ti) {
            const int tok = m0 + ti * 16 + fr;
#pragma unroll
            for (int ni = 0; ni < 4; ++ni) {
                const int col = nb - 5120 + ni * 16 + fq * 4;
                *(u32x2*)(ZR + (size_t)tok * RWKV_LD + col) = pack4(acc[ti][ni][0], acc[ti][ni][1], acc[ti][ni][2], acc[ti][ni][3]);
            }
        }
    } else {
        bf16_t* ZG = (bf16_t*)(p.ws + OFF_ZG);
#pragma unroll
        for (int ti = 0; ti < 4; ++ti) {
            const int tok = m0 + ti * 16 + fr;
#pragma unroll
            for (int ni = 0; ni < 4; ++ni) {
                const int col = nb - 8448 + ni * 16 + fq * 4;
                *(u32x2*)(ZG + (size_t)tok * ZG_LD + col) = pack4(sigmoidf_(acc[ti][ni][0]), sigmoidf_(acc[ti][ni][1]), sigmoidf_(acc[ti][ni][2]), sigmoidf_(acc[ti][ni][3]));
            }
        }
    }
}

DI void zr_shift8(const bf16_t* ZR, const float* mu, int tok, int col, float (&z)[8]) {
    const u32x4 cv = *(const u32x4*)(ZR + (size_t)tok * RWKV_LD + col);
    u32x4 pv = (u32x4){0u, 0u, 0u, 0u};
    if ((tok & 8191) != 0) pv = *(const u32x4*)(ZR + (size_t)(tok - 1) * RWKV_LD + col);
    float c[8], q[8]; unpack8(cv, c); unpack8(pv, q);
    const f32x4 m0 = *(const f32x4*)(mu + col), m1 = *(const f32x4*)(mu + col + 4);
#pragma unroll
    for (int e = 0; e < 4; ++e) { z[e] = c[e] + m0[e] * (q[e] - c[e]); z[4 + e] = c[4 + e] + m1[e] * (q[4 + e] - c[4 + e]); }
}
DI void zr_shift4(const bf16_t* ZR, const float* mu, int tok, int col, float (&z)[4]) {
    const u32x2 cv = *(const u32x2*)(ZR + (size_t)tok * RWKV_LD + col);
    u32x2 pv = (u32x2){0u, 0u};
    if ((tok & 8191) != 0) pv = *(const u32x2*)(ZR + (size_t)(tok - 1) * RWKV_LD + col);
    float c[4], q[4]; unpack4(cv, c); unpack4(pv, q);
    const f32x4 m0 = *(const f32x4*)(mu + col);
#pragma unroll
    for (int e = 0; e < 4; ++e) z[e] = c[e] + m0[e] * (q[e] - c[e]);
}

DI void rwkv_prep_tile(const Params& p, int l, int tile, char* lds) {
    const int tid = threadIdx.x, t0 = tile * 16;
    const bf16_t* ZR = (const bf16_t*)(p.ws + OFF_ZR);
    const float* mu = (const float*)p.in[I_MU] + (size_t)l * RWKV_LD;
    float* tw = (float*)lds;
    float* za = tw + 16 * 64;
    __syncthreads();
    {
        const int tk = tid >> 4, c8 = (tid & 15) * 8;
        float z[8]; zr_shift8(ZR, mu, t0 + tk, 3072 + c8, z);
        if (c8 < 64) { for (int e = 0; e < 8; ++e) tw[tk * 64 + c8 + e] = tanhf(z[e]); }
        else { for (int e = 0; e < 8; ++e) za[tk * 64 + c8 - 64 + e] = z[e]; }
    }
    __syncthreads();
    const int n4 = tid * 4;
#pragma unroll 1
    for (int which = 0; which < 2; ++which) {
        const float* act = which == 0 ? tw : za;
        const float* wl = (const float*)p.in[which == 0 ? I_W2 : I_A2] + (size_t)l * 64 * 1024 + n4;
        const float* bias = (const float*)p.in[which == 0 ? I_W0 : I_A0] + (size_t)l * 1024 + n4;
        f32x4 acc[16];
        const f32x4 bv = *(const f32x4*)bias;
#pragma unroll
        for (int t = 0; t < 16; ++t) acc[t] = bv;
#pragma unroll 2
        for (int k = 0; k < 64; k += 4) {
            const f32x4 w0 = *(const f32x4*)(wl + (size_t)(k + 0) * 1024), w1 = *(const f32x4*)(wl + (size_t)(k + 1) * 1024),
                        w2 = *(const f32x4*)(wl + (size_t)(k + 2) * 1024), w3 = *(const f32x4*)(wl + (size_t)(k + 3) * 1024);
#pragma unroll
            for (int t = 0; t < 16; ++t) {
                const f32x4 a = *(const f32x4*)(act + t * 64 + k);
                acc[t] += a[0] * w0 + a[1] * w1 + a[2] * w2 + a[3] * w3;
            }
        }
        bf16_t* dst = (bf16_t*)(p.ws + (which == 0 ? OFF_LW : OFF_A));
#pragma unroll
        for (int t = 0; t < 16; ++t) {
            float o[4];
#pragma unroll
            for (int e = 0; e < 4; ++e) { const float sg = sigmoidf_(acc[t][e]); o[e] = which == 0 ? -0.6065306597126334f * sg : sg; }
            *(u32x2*)(dst + (size_t)(t0 + t) * 1024 + n4) = pack4(o[0], o[1], o[2], o[3]);
        }
    }
}

DI void conv_tile(const Params& p, int l, int tile, char* lds) {
    const int tid = threadIdx.x, lane = tid & 63, wid = tid >> 6, t0 = tile * 16, s0 = t0 & 8191;
    const bf16_t* UC = (const bf16_t*)(p.ws + OFF_UC);
    bf16_t* out = (bf16_t*)(p.ws + OFF_CONVP);
    float* su = (float*)lds;
    float* red = su + 46 * 256;
    float s1[16], s2[16];
#pragma unroll
    for (int t = 0; t < 16; ++t) { s1[t] = 0.f; s2[t] = 0.f; }
#pragma unroll 1
    for (int ps = 0; ps < 4; ++ps) {
        const int cbase = ps * 256;
        __syncthreads();
        for (int ch = tid; ch < 46 * 32; ch += 256) {
            const int row = ch >> 5, c8 = (ch & 31) * 8;
            u32x4 v = (u32x4){0u, 0u, 0u, 0u};
            if (s0 - 30 + row >= 0) v = *(const u32x4*)(UC + (size_t)(t0 - 30 + row) * 1024 + cbase + c8);
            float f[8]; unpack8(v, f);
            *(f32x4*)(su + row * 256 + c8) = (f32x4){f[0], f[1], f[2], f[3]};
            *(f32x4*)(su + row * 256 + c8 + 4) = (f32x4){f[4], f[5], f[6], f[7]};
        }
        __syncthreads();
        const int c = cbase + tid;
        float w[31];
#pragma unroll
        for (int j = 0; j < 31; ++j) w[j] = ((const float*)p.in[I_CONVW])[(size_t)l * 31 * 1024 + j * 1024 + c];
        const float bias = ((const float*)p.in[I_CONVB])[l * 1024 + c];
        float acc[16];
#pragma unroll
        for (int t = 0; t < 16; ++t) acc[t] = bias;
#pragma unroll
        for (int rr = 0; rr < 46; ++rr) {
            const float uval = su[rr * 256 + tid];
#pragma unroll
            for (int t = 0; t < 16; ++t) if (rr - t >= 0 && rr - t <= 30) acc[t] += w[rr - t] * uval;
        }
#pragma unroll
        for (int t = 0; t < 16; ++t) {
            const bf16_t hb = f2bf(acc[t]); const float yr = bf2f(hb);
            s1[t] += yr; s2[t] += yr * yr;
            out[(size_t)(t0 + t) * 1024 + c] = hb;
        }
    }
    __syncthreads();
#pragma unroll
    for (int t = 0; t < 16; ++t) {
        const float a = wave_sum(s1[t]), b2 = wave_sum(s2[t]);
        if (lane == 0) { red[(wid * 16 + t) * 2] = a; red[(wid * 16 + t) * 2 + 1] = b2; }
    }
    __syncthreads();
#pragma unroll 1
    for (int ps = 0; ps < 4; ++ps) {
        const int c = ps * 256 + tid;
        const float g = ((const float*)p.in[I_CLNG])[l * 1024 + c], bb = ((const float*)p.in[I_CLNB])[l * 1024 + c];
#pragma unroll
        for (int t = 0; t < 16; ++t) {
            const float a = red[t * 2] + red[(16 + t) * 2] + red[(32 + t) * 2] + red[(48 + t) * 2];
            const float b2 = red[t * 2 + 1] + red[(16 + t) * 2 + 1] + red[(32 + t) * 2 + 1] + red[(48 + t) * 2 + 1];
            const float mean = a * (1.0f / 1024.0f), var = fmaxf(b2 * (1.0f / 1024.0f) - mean * mean, 0.f);
            const float y = bf2f(out[(size_t)(t0 + t) * 1024 + c]);
            const float yn = (y - mean) * rsqrtf(var + 1e-5f) * g + bb;
            out[(size_t)(t0 + t) * 1024 + c] = f2bf(siluf_(yn));
        }
    }
}

constexpr int SCAN_BUF = 5 * 1024 + 256;
DI void scan_block(const Params& p, int l, int sb, char* lds) {
    const int tid = threadIdx.x, b = sb >> 6, hh = (sb >> 2) & 15, rg = sb & 3;
    const int il = tid >> 4, cgp = tid & 15;
    const int ts = tid >> 4, jg = tid & 15;
    float* bufs = (float*)lds;
    float* ybuf = bufs + 2 * SCAN_BUF;
    const bf16_t* ZR = (const bf16_t*)(p.ws + OFF_ZR);
    const bf16_t* Ab = (const bf16_t*)(p.ws + OFF_A);
    const bf16_t* Lb = (const bf16_t*)(p.ws + OFF_LW);
    bf16_t* YS = (bf16_t*)(p.ws + OFF_YS);
    const float* mu = (const float*)p.in[I_MU] + (size_t)l * RWKV_LD;
    const int ncol = hh * 64 + jg * 4;
    const f32x4 kkv = *(const f32x4*)((const float*)p.in[I_KK] + l * 1024 + ncol);
    const f32x4 kav = *(const f32x4*)((const float*)p.in[I_KA] + l * 1024 + ncol);
    const int tokb = b * SEQ;
    float rr[4], kk[4], vv[4]; u32x2 av, lv;
    auto stage_load = [&](int c) {
        const int tok = tokb + c * 16 + ts;
        zr_shift4(ZR, mu, tok, ncol, rr); zr_shift4(ZR, mu, tok, 1024 + ncol, kk); zr_shift4(ZR, mu, tok, 2048 + ncol, vv);
        av = *(const u32x2*)(Ab + (size_t)tok * 1024 + ncol); lv = *(const u32x2*)(Lb + (size_t)tok * 1024 + ncol);
    };
    auto stage_write = [&](float* buf) {
        float a[4], lw[4]; unpack4(av, a); unpack4(lv, lw);
        float kq[4], ss = 0.f;
#pragma unroll
        for (int e = 0; e < 4; ++e) { kq[e] = kk[e] * kkv[e]; ss += kq[e] * kq[e]; }
        ss = row16_sum(ss);
        const float inv = 1.0f / fmaxf(sqrtf(ss), 1e-12f);
        f32x4 W4, K4, A4, B4, R4;
#pragma unroll
        for (int e = 0; e < 4; ++e) {
            const float kf = kq[e] * inv;
            W4[e] = __expf(lw[e]); K4[e] = kk[e] * (1.0f + (a[e] - 1.0f) * kav[e]); A4[e] = -kf; B4[e] = kf * a[e]; R4[e] = rr[e];
        }
        float* bp = buf + ts * 64 + jg * 4;
        *(f32x4*)(bp) = W4; *(f32x4*)(bp + 1024) = K4; *(f32x4*)(bp + 2048) = A4; *(f32x4*)(bp + 3072) = B4; *(f32x4*)(bp + 4096) = R4;
        if ((jg >> 2) == rg) *(f32x4*)(buf + 5120 + ts * 16 + (jg & 3) * 4) = (f32x4){vv[0], vv[1], vv[2], vv[3]};
    };
    float S0 = 0.f, S1 = 0.f, S2 = 0.f, S3 = 0.f;
    __syncthreads();
    stage_load(0); stage_write(bufs);
    __syncthreads();
    for (int c = 0; c < SEQ / 16; ++c) {
        const float* buf = bufs + (c & 1) * SCAN_BUF;
        float* yb = ybuf + (c & 1) * 256;
        if (c > 0) {
            const float* yp = ybuf + ((c - 1) & 1) * 256;
            YS[(size_t)(tokb + (c - 1) * 16 + (tid >> 4)) * 1024 + hh * 64 + rg * 16 + (tid & 15)] = f2bf(yp[tid]);
        }
        if (c + 1 < SEQ / 16) stage_load(c + 1);
#pragma unroll
        for (int t = 0; t < 16; ++t) {
            const float* bp = buf + t * 64 + cgp * 4;
            const f32x4 w4 = *(const f32x4*)(bp), k4 = *(const f32x4*)(bp + 1024), a4 = *(const f32x4*)(bp + 2048), b4 = *(const f32x4*)(bp + 3072), r4 = *(const f32x4*)(bp + 4096);
            const float v = buf[5120 + t * 16 + il];
            float sa = (S0 * a4[0] + S1 * a4[1]) + (S2 * a4[2] + S3 * a4[3]);
            sa = row16_sum(sa);
            S0 = S0 * w4[0] + v * k4[0] + sa * b4[0];
            S1 = S1 * w4[1] + v * k4[1] + sa * b4[1];
            S2 = S2 * w4[2] + v * k4[2] + sa * b4[2];
            S3 = S3 * w4[3] + v * k4[3] + sa * b4[3];
            float y = (S0 * r4[0] + S1 * r4[1]) + (S2 * r4[2] + S3 * r4[3]);
            y = row16_sum(y);
            if (cgp == 0) yb[t * 16 + il] = y;
        }
        if (c + 1 < SEQ / 16) stage_write(bufs + ((c + 1) & 1) * SCAN_BUF);
        __syncthreads();
    }
    {
        const int c = SEQ / 16;
        const float* yp = ybuf + ((c - 1) & 1) * 256;
        YS[(size_t)(tokb + (c - 1) * 16 + (tid >> 4)) * 1024 + hh * 64 + rg * 16 + (tid & 15)] = f2bf(yp[tid]);
    }
}

constexpr int ATT_LDK = 72;
DI void attn_unit(const Params& p, int l, int unit, char* lds) {
    const int tid = threadIdx.x, lane = tid & 63, wid = tid >> 6, c = wid >> 1, qs = wid & 1, r32 = lane & 31, h = lane >> 5;
    const int qb = 127 - (unit >> 4), bh = unit & 15, hh = bh & 7, b = bh >> 3;
    bf16_t* sK = (bf16_t*)lds;
    bf16_t* sVT = (bf16_t*)(lds + 2 * 64 * ATT_LDK * 2);
    const bf16_t* Qg = (const bf16_t*)(p.ws + OFF_Q);
    const bf16_t* Kg = (const bf16_t*)(p.ws + OFF_K);
    const bf16_t* VTg = (const bf16_t*)(p.ws + OFF_VT) + (size_t)bh * 128 * 8192;
    const int query = qb * 64 + qs * 32 + r32;
    bf16x8 qf[4];
#pragma unroll
    for (int ks = 0; ks < 4; ++ks) qf[ks] = *(const bf16x8*)(Qg + ((size_t)(bh * 2 + c) * SEQ + query) * 64 + ks * 16 + h * 8);
    u32x4 rk[4], rv[4];
    auto stage_load = [&](int kt) {
#pragma unroll
        for (int i = 0; i < 4; ++i) {
            const int id = tid + 256 * i, cm = id >> 9, row = (id >> 3) & 63, c8 = id & 7;
            rk[i] = *(const u32x4*)(Kg + ((size_t)(bh * 2 + cm) * SEQ + kt * 64 + row) * 64 + c8 * 8);
            rv[i] = *(const u32x4*)(VTg + (size_t)kt * 8192 + id * 8);
        }
    };
    auto stage_write = [&]() {
#pragma unroll
        for (int i = 0; i < 4; ++i) {
            const int id = tid + 256 * i, cm = id >> 9, row = (id >> 3) & 63, c8 = id & 7;
            *(u32x4*)(sK + (cm * 64 + row) * ATT_LDK + c8 * 8) = rk[i];
            *(u32x4*)(sVT + id * 8) = rv[i];
        }
    };
    f32x16 O[4];
#pragma unroll
    for (int d = 0; d < 4; ++d)
#pragma unroll
        for (int e = 0; e < 16; ++e) O[d][e] = 0.f;
    float m_run = -INFINITY, lsum = 0.f;
    stage_load(0);
    for (int kt = 0; kt <= qb; ++kt) {
        __syncthreads();
        stage_write();
        __syncthreads();
        if (kt < qb) stage_load(kt + 1);
        f32x16 st[2];
#pragma unroll
        for (int kb = 0; kb < 2; ++kb) {
#pragma unroll
            for (int e = 0; e < 16; ++e) st[kb][e] = 0.f;
#pragma unroll
            for (int ks = 0; ks < 4; ++ks) {
                const bf16x8 kf = *(const bf16x8*)(sK + (c * 64 + kb * 32 + r32) * ATT_LDK + ks * 16 + h * 8);
                st[kb] = MFMA32(kf, qf[ks], st[kb]);
            }
        }
        if (kt == qb) {
            const int ql = qs * 32 + r32;
#pragma unroll
            for (int kb = 0; kb < 2; ++kb)
#pragma unroll
                for (int e = 0; e < 16; ++e) { const int keyl = kb * 32 + (e & 3) + 8 * (e >> 2) + 4 * h; if (keyl > ql) st[kb][e] = -INFINITY; }
        }
        float mx = st[0][0];
#pragma unroll
        for (int kb = 0; kb < 2; ++kb)
#pragma unroll
            for (int e = 0; e < 16; ++e) mx = fmaxf(mx, st[kb][e]);
        mx = fmaxf(mx, __shfl_xor(mx, 32));
        const float mnew = fmaxf(m_run, mx);
        const float alpha = __builtin_amdgcn_exp2f(m_run - mnew);
        m_run = mnew;
        float ps = 0.f;
#pragma unroll
        for (int kb = 0; kb < 2; ++kb)
#pragma unroll
            for (int e = 0; e < 16; ++e) { st[kb][e] = __builtin_amdgcn_exp2f(st[kb][e] - mnew); ps += st[kb][e]; }
        lsum = lsum * alpha + ps;
#pragma unroll
        for (int d = 0; d < 4; ++d)
#pragma unroll
            for (int e = 0; e < 16; ++e) O[d][e] *= alpha;
        bf16x8 pf[2][2];
#pragma unroll
        for (int kb = 0; kb < 2; ++kb)
#pragma unroll
            for (int s = 0; s < 2; ++s) {
                u32x4 pk;
                pk.x = pk2(st[kb][8 * s + 0], st[kb][8 * s + 1]); pk.y = pk2(st[kb][8 * s + 2], st[kb][8 * s + 3]);
                pk.z = pk2(st[kb][8 * s + 4], st[kb][8 * s + 5]); pk.w = pk2(st[kb][8 * s + 6], st[kb][8 * s + 7]);
                pf[kb][s] = __builtin_bit_cast(bf16x8, pk);
            }
#pragma unroll
        for (int d = 0; d < 4; ++d)
#pragma unroll
            for (int kb = 0; kb < 2; ++kb)
#pragma unroll
                for (int s = 0; s < 2; ++s) {
                    const bf16x8 vf = *(const bf16x8*)(sVT + (((d * 2 + kb) * 2 + s) * 64 + lane) * 8);
                    O[d] = MFMA32(vf, pf[kb][s], O[d]);
                }
    }
    const float ltot = lsum + __shfl_xor(lsum, 32);
    const float inv = 1.0f / ltot;
    float* xo = (float*)lds;
    __syncthreads();
    if (c == 1) {
#pragma unroll
        for (int d = 0; d < 4; ++d)
#pragma unroll
            for (int e = 0; e < 16; ++e) xo[(qs * 64 + d * 16 + e) * 64 + lane] = O[d][e] * inv;
    }
    __syncthreads();
    if (c == 0) {
        const float lam = ((const float*)(p.ws + OFF_CTRL + CT_LAM))[l];
        const float lam_init = 0.8f - 0.6f * expf(-0.3f * (float)l);
        float ss = 0.f;
#pragma unroll
        for (int d = 0; d < 4; ++d)
#pragma unroll
            for (int e = 0; e < 16; ++e) { const float o = O[d][e] * inv - lam * xo[(qs * 64 + d * 16 + e) * 64 + lane]; O[d][e] = o; ss += o * o; }
        ss += __shfl_xor(ss, 32);
        const float rstd = rsqrtf(ss * (1.0f / 128.0f) + 1e-6f) * (1.0f - lam_init);
        bf16_t* outp = (bf16_t*)(p.ws + OFF_ATTP) + (size_t)(b * SEQ + query) * 1024 + hh * 128;
        const float* hg = (const float*)p.in[I_AHG] + (size_t)(l * 8 + hh) * 128;
#pragma unroll
        for (int d = 0; d < 4; ++d)
#pragma unroll
            for (int g4 = 0; g4 < 4; ++g4) {
                const int dv0 = d * 32 + 8 * g4 + 4 * h;
                const f32x4 g = *(const f32x4*)(hg + dv0);
                *(u32x2*)(outp + dv0) = pack4(O[d][g4 * 4 + 0] * rstd * g[0], O[d][g4 * 4 + 1] * rstd * g[1], O[d][g4 * 4 + 2] * rstd * g[2], O[d][g4 * 4 + 3] * rstd * g[3]);
            }
    }
}

DI void rwkv_post_tile(const Params& p, int l, int tile, char* lds) {
    const int tid = threadIdx.x, t0 = tile * 16, n4 = tid * 4;
    const bf16_t* ZR = (const bf16_t*)(p.ws + OFF_ZR);
    const bf16_t* Ab = (const bf16_t*)(p.ws + OFF_A);
    const bf16_t* YS = (const bf16_t*)(p.ws + OFF_YS);
    const float* mu = (const float*)p.in[I_MU] + (size_t)l * RWKV_LD;
    float* sg = (float*)lds;
    __syncthreads();
    {
        const int tk = tid >> 4, c8 = (tid & 15) * 8;
        float z[8]; zr_shift8(ZR, mu, t0 + tk, 3200 + c8, z);
#pragma unroll
        for (int e = 0; e < 8; ++e) sg[tk * 128 + c8 + e] = sigmoidf_(z[e]);
    }
    __syncthreads();
    f32x4 gacc[16];
#pragma unroll
    for (int t = 0; t < 16; ++t) gacc[t] = (f32x4){0.f, 0.f, 0.f, 0.f};
    const float* g2 = (const float*)p.in[I_G2] + (size_t)l * 128 * 1024 + n4;
#pragma unroll 2
    for (int k = 0; k < 128; k += 4) {
        const f32x4 w0 = *(const f32x4*)(g2 + (size_t)(k + 0) * 1024), w1 = *(const f32x4*)(g2 + (size_t)(k + 1) * 1024),
                    w2 = *(const f32x4*)(g2 + (size_t)(k + 2) * 1024), w3 = *(const f32x4*)(g2 + (size_t)(k + 3) * 1024);
#pragma unroll
        for (int t = 0; t < 16; ++t) {
            const f32x4 a = *(const f32x4*)(sg + t * 128 + k);
            gacc[t] += a[0] * w0 + a[1] * w1 + a[2] * w2 + a[3] * w3;
        }
    }
    const f32x4 kav = *(const f32x4*)((const float*)p.in[I_KA] + l * 1024 + n4);
    const f32x4 rkv = *(const f32x4*)((const float*)p.in[I_RK] + l * 1024 + n4);
    const f32x4 gng = *(const f32x4*)((const float*)p.in[I_GNG] + l * 1024 + n4);
    const f32x4 gnb = *(const f32x4*)((const float*)p.in[I_GNB] + l * 1024 + n4);
    bf16_t* out = (bf16_t*)(p.ws + OFF_RWKVP);
#pragma unroll
    for (int t = 0; t < 16; ++t) {
        const int tok = t0 + t;
        float r[4], k[4], v[4], a[4], y[4];
        zr_shift4(ZR, mu, tok, n4, r); zr_shift4(ZR, mu, tok, 1024 + n4, k); zr_shift4(ZR, mu, tok, 2048 + n4, v);
        unpack4(*(const u32x2*)(Ab + (size_t)tok * 1024 + n4), a);
        unpack4(*(const u32x2*)(YS + (size_t)tok * 1024 + n4), y);
        float cf = 0.f, s1 = 0.f, s2 = 0.f;
#pragma unroll
        for (int e = 0; e < 4; ++e) { const float kn = k[e] * (1.0f + (a[e] - 1.0f) * kav[e]); cf += r[e] * kn * rkv[e]; s1 += y[e]; s2 += y[e] * y[e]; }
        cf = row16_sum(cf); s1 = row16_sum(s1); s2 = row16_sum(s2);
        const float mean = s1 * (1.0f / 64.0f), var = fmaxf(s2 * (1.0f / 64.0f) - mean * mean, 0.f), rstd = rsqrtf(var + 64e-5f);
        float o[4];
#pragma unroll
        for (int e = 0; e < 4; ++e) o[e] = ((y[e] - mean) * rstd * gng[e] + gnb[e] + cf * v[e]) * gacc[t][e];
        *(u32x2*)(out + (size_t)tok * 1024 + n4) = pack4(o[0], o[1], o[2], o[3]);
    }
}

DI void phaseF_tile(const Params& p, int mt, int nt, char* lds) {
    const int tid = threadIdx.x, lane = tid & 63, wid = tid >> 6, wm = wid >> 1, wn = wid & 1, fr = lane & 15, fq = lane >> 4;
    const int m0 = mt * 128 + wm * 64, nb = nt * 128 + wn * 64;
    const bf16_t* ZG = (const bf16_t*)(p.ws + OFF_ZG);
    f32x4 sum[4][4]; zero_acc(sum);
#pragma unroll 1
    for (int br = 0; br < 3; ++br) {
        const size_t xoff = br == 0 ? OFF_ATTP : br == 1 ? OFF_CONVP : OFF_RWKVP;
        const size_t woff = br == 0 ? W_ATTO : br == 1 ? W_CONVO : W_RWKVO;
        f32x4 acc[4][4]; zero_acc(acc);
        gemm_mainloop<false>(acc, (const bf16_t*)(p.ws + xoff) + (size_t)mt * 128 * 1024, 1024, (const bf16_t*)(p.ws + OFF_W + woff) + (size_t)nt * 128 * 1024, 1024, 1024, lds);
#pragma unroll
        for (int ti = 0; ti < 4; ++ti) {
            const int tok = m0 + ti * 16 + fr;
#pragma unroll
            for (int ni = 0; ni < 4; ++ni) {
                float g[4]; unpack4(*(const u32x2*)(ZG + (size_t)tok * ZG_LD + br * 1024 + nb + ni * 16 + fq * 4), g);
#pragma unroll
                for (int r = 0; r < 4; ++r) sum[ti][ni][r] += g[r] * acc[ti][ni][r];
            }
        }
    }
    bf16_t* out = (bf16_t*)(p.ws + OFF_MERGED);
#pragma unroll
    for (int ti = 0; ti < 4; ++ti) {
        const int tok = m0 + ti * 16 + fr;
#pragma unroll
        for (int ni = 0; ni < 4; ++ni)
            *(u32x2*)(out + (size_t)tok * 1024 + nb + ni * 16 + fq * 4) = pack4(sum[ti][ni][0], sum[ti][ni][1], sum[ti][ni][2], sum[ti][ni][3]);
    }
}
DI void phaseG_tile(const Params& p, int l, int mt, int nt, char* lds) {
    const int tid = threadIdx.x, lane = tid & 63, wid = tid >> 6, wm = wid >> 1, wn = wid & 1, fr = lane & 15, fq = lane >> 4;
    const int m0 = mt * 128 + wm * 64, nb = nt * 128 + wn * 64;
    f32x4 acc[4][4]; zero_acc(acc);
    gemm_mainloop<false>(acc, (const bf16_t*)(p.ws + OFF_MERGED) + (size_t)mt * 128 * 1024, 1024, (const bf16_t*)(p.ws + OFF_W + W_OUT) + (size_t)nt * 128 * 1024, 1024, 1024, lds);
    const float* xin = l == 0 ? (const float*)p.in[I_X] : p.out;
    const float* ada = (const float*)(p.ws + OFF_CTRL + CT_ADA) + (size_t)l * 2 * 6144;
#pragma unroll
    for (int ti = 0; ti < 4; ++ti) {
        const int tok = m0 + ti * 16 + fr, b = tok >> 13;
#pragma unroll
        for (int ni = 0; ni < 4; ++ni) {
            const int n = nb + ni * 16 + fq * 4;
            const f32x4 xv = *(const f32x4*)(xin + (size_t)tok * 1024 + n), gt = *(const f32x4*)(ada + b * 6144 + 2 * 1024 + n);
            *(f32x4*)(p.out + (size_t)tok * 1024 + n) = xv + (1.0f + gt) * acc[ti][ni];
        }
    }
}
DI void phaseI_tile(const Params& p, int mt, int nt, char* lds) {
    const int tid = threadIdx.x, lane = tid & 63, wid = tid >> 6, wm = wid >> 1, wn = wid & 1, fr = lane & 15, fq = lane >> 4;
    const int m0 = mt * 128 + wm * 64, nb = nt * 128 + wn * 64;
    f32x4 acc[4][4]; zero_acc(acc);
    gemm_mainloop<false>(acc, (const bf16_t*)(p.ws + OFF_H) + (size_t)mt * 128 * 1024, 1024, (const bf16_t*)(p.ws + OFF_W + W_QP) + (size_t)nt * 128 * 1024, 1024, 1024, lds);
    bf16_t* out = (bf16_t*)(p.ws + OFF_QP);
#pragma unroll
    for (int ti = 0; ti < 4; ++ti) {
        const int tok = m0 + ti * 16 + fr;
#pragma unroll
        for (int ni = 0; ni < 4; ++ni)
            *(u32x2*)(out + (size_t)tok * 2048 + nb + ni * 16 + fq * 4) = pack4(acc[ti][ni][0], acc[ti][ni][1], acc[ti][ni][2], acc[ti][ni][3]);
    }
}
DI void phaseJ_tile(const Params& p, int mt, int g, char* lds) {
    const int tid = threadIdx.x, lane = tid & 63, wid = tid >> 6, wm = wid >> 1, wn = wid & 1, fr = lane & 15, fq = lane >> 4;
    const int m0 = mt * 128 + wm * 64, nb = wn * 64;
    f32x4 acc[4][4]; zero_acc(acc);
    gemm_mainloop<false>(acc, (const bf16_t*)(p.ws + OFF_QP) + (size_t)mt * 128 * 2048 + g * 128, 2048, (const bf16_t*)(p.ws + OFF_W + ((g & 1) ? W_KEY2 : W_KEY1)), 128, 128, lds);
    float* out = (float*)(p.ws + OFF_SCORES);
#pragma unroll
    for (int ti = 0; ti < 4; ++ti) {
        const int tok = m0 + ti * 16 + fr;
#pragma unroll
        for (int ni = 0; ni < 4; ++ni) *(f32x4*)(out + (size_t)tok * 2048 + g * 128 + nb + ni * 16 + fq * 4) = acc[ti][ni];
    }
}

DI void topk_task(const Params& p, int task) {
    const int lane = threadIdx.x & 63, t = task >> 3, hd = task & 7;
    const float* sc = (const float*)(p.ws + OFF_SCORES) + (size_t)t * 2048 + hd * 256;
    float va = sc[lane], vb = sc[64 + lane], wa = sc[128 + lane], wb = sc[192 + lane];
    float my_v1 = 0.f; int my_i1 = 0; float my_v2[4] = {0.f, 0.f, 0.f, 0.f}; int my_i2[4] = {0, 0, 0, 0};
#pragma unroll
    for (int r = 0; r < 16; ++r) {
        {
            const bool pa = va >= vb; const float best = pa ? va : vb; const int bi = pa ? lane : lane + 64;
            const float m = wave_max(best);
            const unsigned long long ball = __ballot(best == m);
            const int src = __ffsll((long long)ball) - 1;
            const int idx = __shfl(bi, src);
            if (lane == src) { if (pa) va = -INFINITY; else vb = -INFINITY; }
            if ((lane >> 2) == r) { my_v1 = m; my_i1 = idx; }
        }
        {
            const bool pa = wa >= wb; const float best = pa ? wa : wb; const int bi = pa ? lane : lane + 64;
            const float m = wave_max(best);
            const unsigned long long ball = __ballot(best == m);
            const int src = __ffsll((long long)ball) - 1;
            const int idx = __shfl(bi, src);
            if (lane == src) { if (pa) wa = -INFINITY; else wb = -INFINITY; }
            if ((lane & 3) == (r >> 2)) { my_v2[r & 3] = m; my_i2[r & 3] = idx; }
        }
    }
    float cand[4];
#pragma unroll
    for (int q = 0; q < 4; ++q) cand[q] = my_v1 + my_v2[q];
    float out_v = 0.f; int out_e = 0;
#pragma unroll
    for (int r = 0; r < 16; ++r) {
        float best = cand[0]; int bq = 0;
#pragma unroll
        for (int q = 1; q < 4; ++q) if (cand[q] > best) { best = cand[q]; bq = q; }
        const float m = wave_max(best);
        const unsigned long long ball = __ballot(best == m);
        const int src = __ffsll((long long)ball) - 1;
        int e = my_i1 * 128 + (bq == 0 ? my_i2[0] : bq == 1 ? my_i2[1] : bq == 2 ? my_i2[2] : my_i2[3]);
        e = __shfl(e, src);
        if (lane == src) {
#pragma unroll
            for (int q = 0; q < 4; ++q) if (q == bq) cand[q] = -INFINITY;
        }
        if (lane == r) { out_v = m; out_e = e; }
    }
    const float mx = __shfl(out_v, 0);
    float pr = lane < 16 ? __expf(out_v - mx) : 0.f;
    const float sm = row16_sum(pr);
    if (lane < 16) {
        ((int*)(p.ws + OFF_EID))[(size_t)t * 128 + hd * 16 + lane] = out_e;
        ((float*)(p.ws + OFF_GATE))[(size_t)t * 128 + hd * 16 + lane] = pr / sm;
    }
}

DI void peer_token(const Params& p, int l, int t) {
    const int lane = threadIdx.x & 63, b = t >> 13;
    const bf16_t* U = (const bf16_t*)(p.ws + OFF_PU);
    const bf16_t* V = (const bf16_t*)(p.ws + OFF_PV);
    bf16_t* H = (bf16_t*)(p.ws + OFF_H);
    float hv[16];
    { float f[8]; unpack8(*(const u32x4*)(H + (size_t)t * 1024 + lane * 8), f); for (int e = 0; e < 8; ++e) hv[e] = f[e];
      unpack8(*(const u32x4*)(H + (size_t)t * 1024 + 512 + lane * 8), f); for (int e = 0; e < 8; ++e) hv[8 + e] = f[e]; }
    const int* eidp = (const int*)(p.ws + OFF_EID) + (size_t)t * 128;
    const float* gatep = (const float*)(p.ws + OFF_GATE) + (size_t)t * 128;
    const int id0 = eidp[lane], id1 = eidp[64 + lane];
    const float g0 = gatep[lane], g1 = gatep[64 + lane];
    float acc[16];
#pragma unroll
    for (int e = 0; e < 16; ++e) acc[e] = 0.f;
#pragma unroll 1
    for (int half = 0; half < 2; ++half) {
        const int idr = half ? id1 : id0; const float gr = half ? g1 : g0;
#pragma unroll 4
        for (int j = 0; j < 64; ++j) {
            const int id = __shfl(idr, j); const float gate = __shfl(gr, j);
            const bf16_t* ur = U + (size_t)id * 1024; const bf16_t* vr = V + (size_t)id * 1024;
            const u32x4 u0 = *(const u32x4*)(ur + lane * 8), u1 = *(const u32x4*)(ur + 512 + lane * 8);
            const u32x4 v0 = *(const u32x4*)(vr + lane * 8), v1 = *(const u32x4*)(vr + 512 + lane * 8);
            float uf[8], dot = 0.f;
            unpack8(u0, uf);
#pragma unroll
            for (int e = 0; e < 8; ++e) dot += hv[e] * uf[e];
            unpack8(u1, uf);
#pragma unroll
            for (int e = 0; e < 8; ++e) dot += hv[8 + e] * uf[e];
            dot = wave_sum(dot);
            const float act = 0.5f * dot * (1.0f + erff(dot * 0.7071067811865476f)) * gate;
            float vf[8];
            unpack8(v0, vf);
#pragma unroll
            for (int e = 0; e < 8; ++e) acc[e] += act * vf[e];
            unpack8(v1, vf);
#pragma unroll
            for (int e = 0; e < 8; ++e) acc[8 + e] += act * vf[e];
        }
    }
    const float* ada = (const float*)(p.ws + OFF_CTRL + CT_ADA) + (size_t)(l * 2 + b) * 6144;
    float xv[16], ss = 0.f;
#pragma unroll
    for (int hseg = 0; hseg < 2; ++hseg)
#pragma unroll
        for (int q = 0; q < 2; ++q) {
            const int n = hseg * 512 + lane * 8 + q * 4;
            const f32x4 x1 = *(const f32x4*)(p.out + (size_t)t * 1024 + n), gt = *(const f32x4*)(ada + 5 * 1024 + n);
#pragma unroll
            for (int e = 0; e < 4; ++e) { const float x2 = x1[e] + (1.0f + gt[e]) * acc[hseg * 8 + q * 4 + e]; xv[hseg * 8 + q * 4 + e] = x2; ss += x2 * x2; }
        }
    ss = wave_sum(ss);
    const float rstd = rsqrtf(ss * (1.0f / 1024.0f) + 1e-6f);
    if (l + 1 < DEPTH) {
        const float* ada2 = (const float*)(p.ws + OFF_CTRL + CT_ADA) + (size_t)((l + 1) * 2 + b) * 6144;
        const float* g1n = (const float*)p.in[I_N1G] + (size_t)(l + 1) * 1024;
#pragma unroll
        for (int hseg = 0; hseg < 2; ++hseg) {
            const int n = hseg * 512 + lane * 8;
            float o[8];
#pragma unroll
            for (int q = 0; q < 2; ++q) {
                const f32x4 g = *(const f32x4*)(g1n + n + q * 4), sh = *(const f32x4*)(ada2 + n + q * 4), sc = *(const f32x4*)(ada2 + 1024 + n + q * 4);
                *(f32x4*)(p.out + (size_t)t * 1024 + n + q * 4) = (f32x4){xv[hseg * 8 + q * 4], xv[hseg * 8 + q * 4 + 1], xv[hseg * 8 + q * 4 + 2], xv[hseg * 8 + q * 4 + 3]};
#pragma unroll
                for (int e = 0; e < 4; ++e) o[q * 4 + e] = xv[hseg * 8 + q * 4 + e] * rstd * g[e] * (1.0f + sc[e]) + sh[e];
            }
            u32x4 w; w.x = pk2(o[0], o[1]); w.y = pk2(o[2], o[3]); w.z = pk2(o[4], o[5]); w.w = pk2(o[6], o[7]);
            *(u32x4*)(H + (size_t)t * 1024 + n) = w;
        }
    } else {
        const float* fg = (const float*)p.in[I_FG];
#pragma unroll
        for (int hseg = 0; hseg < 2; ++hseg)
#pragma unroll
            for (int q = 0; q < 2; ++q) {
                const int n = hseg * 512 + lane * 8 + q * 4;
                const f32x4 g = *(const f32x4*)(fg + n);
                f32x4 o;
#pragma unroll
                for (int e = 0; e < 4; ++e) o[e] = xv[hseg * 8 + q * 4 + e] * rstd * g[e];
                *(f32x4*)(p.out + (size_t)t * 1024 + n) = o;
            }
    }
}

constexpr int LDS_BYTES = 49152;
constexpr int N_PHASES = 2 + 11 * DEPTH;
#ifndef MULTI_LAUNCH
#define MULTI_LAUNCH 0
#endif

template <int ph> DI void run_phase(const Params& p, char* lds) {
    const int bid = blockIdx.x, nblk = gridDim.x, tid = threadIdx.x;
    const int gw = bid * 4 + (tid >> 6), nw = nblk * 4;
    float* ada = (float*)(p.ws + OFF_CTRL + CT_ADA);
    if (ph == 0) {
        const int total = 192 + 1 + 256 + NCONV_ITEMS;
        for (int it = bid; it < total; it += nblk) {
            if (it < 192) ada_item(p, it, lds);
            else if (it == 192) lam_item(p);
            else if (it < 449) rope_item(p, it - 193);
            else convert_item(p, 0, it - 449, lds);
        }
        return;
    }
    if (ph == 1) { norm_rows(p, (const float*)p.in[I_X], (const float*)p.in[I_N1G], ada, ada + 1024, (bf16_t*)(p.ws + OFF_H)); return; }
    constexpr int l = (ph - 2) / 11, sub = (ph - 2) % 11;
    switch (sub) {
    case 0:
        for (int tile = bid; tile < 128 * 90; tile += nblk) { int mt, nt; tile_coords(tile, 90, mt, nt); phaseB_tile(p, mt, nt, lds); }
        break;
    case 1:
        for (int it = bid; it < 2048; it += nblk) { if (it < 1024) rwkv_prep_tile(p, l, it, lds); else conv_tile(p, l, it - 1024, lds); }
        break;
    case 2: {
        if (bid < 128) scan_block(p, l, bid, lds);
        unsigned* cnt = (unsigned*)(p.ws + OFF_CTRL + CT_CNT) + l;
        int* s_unit = (int*)(lds + LDS_BYTES - 16);
        for (;;) {
            __syncthreads();
            if (tid == 0) *s_unit = (int)atomicAdd(cnt, 1u);
            __syncthreads();
            const int unit = *s_unit;
            if (unit >= 2048) break;
            attn_unit(p, l, unit, lds);
        }
        break; }
    case 3:
        for (int it = bid; it < 1024; it += nblk) rwkv_post_tile(p, l, it, lds);
        break;
    case 4:
        for (int tile = bid; tile < 128 * 8; tile += nblk) { int mt, nt; tile_coords(tile, 8, mt, nt); phaseF_tile(p, mt, nt, lds); }
        break;
    case 5:
        for (int it = bid; it < 1024 + 2048; it += nblk) {
            if (it < 1024) { int mt, nt; tile_coords(it, 8, mt, nt); phaseG_tile(p, l, mt, nt, lds); }
            else convert_uv_item(p, l, it - 1024);
        }
        break;
    case 6:
        norm_rows(p, p.out, (const float*)p.in[I_N2G] + (size_t)l * 1024, ada + (size_t)l * 2 * 6144 + 3 * 1024, ada + (size_t)l * 2 * 6144 + 4 * 1024, (bf16_t*)(p.ws + OFF_H));
        break;
    case 7:
        for (int tile = bid; tile < 128 * 16; tile += nblk) { int mt, nt; tile_coords(tile, 16, mt, nt); phaseI_tile(p, mt, nt, lds); }
        break;
    case 8:
        for (int tile = bid; tile < 128 * 16; tile += nblk) { int mt, nt; tile_coords(tile, 16, mt, nt); phaseJ_tile(p, mt, nt, lds); }
        break;
    case 9:
        for (int task = gw; task < NT * 8; task += nw) topk_task(p, task);
        if (l + 1 < DEPTH) for (int it = bid; it < NCONV_ITEMS; it += nblk) convert_item(p, l + 1, it, lds);
        break;
    case 10:
        for (int t = gw; t < NT; t += nw) peer_token(p, l, t);
        break;
    }
}

#define PHASE(N) if (p.ph_begin <= N && N < p.ph_end) { run_phase<N>(p, lds); if (N + 1 < p.ph_end) cg::this_grid().sync(); }
__global__ void __launch_bounds__(NTHREADS, 2) mega_kernel(Params p) {
    __shared__ __attribute__((aligned(16))) char lds[LDS_BYTES];
    PHASE(0) PHASE(1) PHASE(2) PHASE(3) PHASE(4) PHASE(5) PHASE(6) PHASE(7) PHASE(8) PHASE(9) PHASE(10) PHASE(11) PHASE(12)
    PHASE(13) PHASE(14) PHASE(15) PHASE(16) PHASE(17) PHASE(18) PHASE(19) PHASE(20) PHASE(21) PHASE(22) PHASE(23)
    static_assert(N_PHASES == 24, "phase list");
}

extern "C" void kernel_launch(void* const* d_in, const int* in_sizes, int n_in, void* d_out, int out_size, void* d_ws, size_t ws_size, hipStream_t stream) {
    static int grid_blocks = 0;
    if (!grid_blocks) {
        int dev = 0, cus = 0, per_cu = 0;
        hipGetDevice(&dev);
        hipDeviceGetAttribute(&cus, hipDeviceAttributeMultiprocessorCount, dev);
        hipOccupancyMaxActiveBlocksPerMultiprocessor(&per_cu, mega_kernel, NTHREADS, 0);
        if (per_cu > 2) per_cu = 2;
        if (per_cu < 1) per_cu = 1;
        grid_blocks = cus * per_cu;
        if (ws_size < WS_END) fprintf(stderr, "workspace too small: %zu < %zu\n", ws_size, (size_t)WS_END);
    }
    Params p{};
    for (int i = 0; i < N_IN; ++i) p.in[i] = d_in[i];
    p.out = (float*)d_out; p.ws = (char*)d_ws;
    hipMemsetAsync(d_ws, 0, 4096, stream);
#if MULTI_LAUNCH
    for (int ph = 0; ph < N_PHASES; ++ph) {
        p.ph_begin = ph; p.ph_end = ph + 1;
        hipLaunchKernelGGL(mega_kernel, dim3(grid_blocks), dim3(NTHREADS), 0, stream, p);
    }
#else
    p.ph_begin = 0; p.ph_end = N_PHASES;
    void* args[] = {&p};
    hipError_t e = hipLaunchCooperativeKernel((void*)mega_kernel, dim3(grid_blocks), dim3(NTHREADS), args, 0, stream);
    if (e != hipSuccess) fprintf(stderr, "cooperative launch failed: %s (grid %d)\n", hipGetErrorString(e), grid_blocks);
#endif
}
```

```cpp
#include <hip/hip_runtime.h>
#include <hip/hip_cooperative_groups.h>
#include <cstdio>
#include <cstdint>
namespace cg = cooperative_groups;

#define DI __device__ __forceinline__
typedef unsigned short bf16_t;
typedef short bf16x8 __attribute__((ext_vector_type(8)));
typedef float f32x2 __attribute__((ext_vector_type(2)));
typedef float f32x4 __attribute__((ext_vector_type(4)));
typedef float f32x16 __attribute__((ext_vector_type(16)));
typedef unsigned u32x2 __attribute__((ext_vector_type(2)));
typedef unsigned u32x4 __attribute__((ext_vector_type(4)));
typedef __bf16 nbf16x2 __attribute__((ext_vector_type(2)));

constexpr int NB = 2, SEQ = 8192, NT = NB * SEQ, DM = 1024, CIN = 11520, DEPTH = 2;
constexpr int NTHREADS = 256;
constexpr size_t MiB = (size_t)1 << 20;
constexpr size_t OFF_CTRL = 0, OFF_ROPE = 1 * MiB, OFF_W = 5 * MiB, OFF_H = 41 * MiB, OFF_Q = 73 * MiB, OFF_K = 105 * MiB,
                 OFF_VT = 137 * MiB, OFF_UC = 169 * MiB, OFF_ZR = 201 * MiB, OFF_ZG = 305 * MiB, OFF_A = 401 * MiB,
                 OFF_LW = 433 * MiB, OFF_YS = 465 * MiB, WS_END = 497 * MiB;
constexpr size_t OFF_CONVP = OFF_H, OFF_ATTP = OFF_UC, OFF_RWKVP = OFF_Q, OFF_MERGED = OFF_K, OFF_PU = OFF_ZR,
                 OFF_PV = OFF_ZR + 32 * MiB, OFF_QP = OFF_ZG, OFF_SCORES = OFF_Q, OFF_EID = OFF_A, OFF_GATE = OFF_A + 8 * MiB;
constexpr size_t W_IN = 0, W_ATTO = (size_t)CIN * 1024 * 2, W_CONVO = W_ATTO + 2 * MiB, W_RWKVO = W_CONVO + 2 * MiB,
                 W_OUT = W_RWKVO + 2 * MiB, W_QP = W_OUT + 2 * MiB, W_KEY1 = W_QP + 4 * MiB, W_KEY2 = W_KEY1 + 32768,
                 W_W2T = W_KEY2 + 32768, W_A2T = W_W2T + 131072, W_G2T = W_A2T + 131072;
static_assert(W_G2T + 262144 <= 36 * MiB, "W region overflow");
constexpr size_t CT_CNT = 0, CT_LAM = 1024, CT_ADA = 65536;
constexpr int RWKV_LD = 3328, ZG_LD = 3072;

enum { I_X = 0, I_C, I_POS, I_WADA, I_BADA, I_N1G, I_WIN, I_LQ1, I_LK1, I_LQ2, I_LK2, I_AHG, I_WATTO, I_CONVW, I_CONVB, I_CLNG, I_CLNB,
       I_WCONVO, I_MU, I_W0, I_W2, I_A0, I_A2, I_G2, I_KK, I_KA, I_RK, I_GNG, I_GNB, I_WRWKVO, I_WOUT, I_N2G, I_WQ, I_KEY1, I_KEY2,
       I_PU, I_PV, I_FG, N_IN };

struct Params {
    const void* in[N_IN];
    float* out;
    char* ws;
    int ph_begin, ph_end;
};

DI unsigned pk2(float lo, float hi) { f32x2 v = {lo, hi}; nbf16x2 b = __builtin_convertvector(v, nbf16x2); return __builtin_bit_cast(unsigned, b); }
DI float bflo(unsigned u) { return __uint_as_float(u << 16); }
DI float bfhi(unsigned u) { return __uint_as_float(u & 0xffff0000u); }
DI float bf2f(bf16_t h) { return __uint_as_float(((unsigned)h) << 16); }
DI bf16_t f2bf(float x) { return (bf16_t)(pk2(x, x) & 0xffffu); }
DI float sigmoidf_(float x) { return 1.0f / (1.0f + __expf(-x)); }
DI float siluf_(float x) { return x / (1.0f + __expf(-x)); }
template <int CTRL> DI float dpp_f(float x) { return __int_as_float(__builtin_amdgcn_update_dpp(0, __float_as_int(x), CTRL, 0xF, 0xF, true)); }
DI float row16_sum(float x) { x += dpp_f<0xB1>(x); x += dpp_f<0x4E>(x); x += dpp_f<0x141>(x); x += dpp_f<0x140>(x); return x; }
DI float row16_max(float x) { x = fmaxf(x, dpp_f<0xB1>(x)); x = fmaxf(x, dpp_f<0x4E>(x)); x = fmaxf(x, dpp_f<0x141>(x)); x = fmaxf(x, dpp_f<0x140>(x)); return x; }
DI float wave_sum(float x) { x = row16_sum(x); x += __shfl_xor(x, 16); x += __shfl_xor(x, 32); return x; }
DI float wave_max(float x) { x = row16_max(x); x = fmaxf(x, __shfl_xor(x, 16)); x = fmaxf(x, __shfl_xor(x, 32)); return x; }
DI void unpack8(u32x4 v, float (&f)[8]) { f[0] = bflo(v.x); f[1] = bfhi(v.x); f[2] = bflo(v.y); f[3] = bfhi(v.y); f[4] = bflo(v.z); f[5] = bfhi(v.z); f[6] = bflo(v.w); f[7] = bfhi(v.w); }
DI void unpack4(u32x2 v, float (&f)[4]) { f[0] = bflo(v.x); f[1] = bfhi(v.x); f[2] = bflo(v.y); f[3] = bfhi(v.y); }
DI u32x2 pack4(float a, float b, float c, float d) { u32x2 r; r.x = pk2(a, b); r.y = pk2(c, d); return r; }

#define MFMA16(a, b, c) __builtin_amdgcn_mfma_f32_16x16x32_bf16((a), (b), (c), 0, 0, 0)
#define MFMA32(a, b, c) __builtin_amdgcn_mfma_f32_32x32x16_bf16((a), (b), (c), 0, 0, 0)

constexpr int GEMM_STAGE = 32768;
#define LDSP __attribute__((address_space(3)))
template <bool NMODE>
DI void gemm_mainloop(f32x4 (&acc)[4][4], const bf16_t* X, size_t ldx, const bf16_t* W, size_t ldw, int K, char* lds) {
    const int tid = threadIdx.x, lane = tid & 63, wid = tid >> 6, wm = wid >> 1, wn = wid & 1;
    const int fr = lane & 15, fq = lane >> 4;
    const int srow = tid >> 3, skc = (tid & 7) ^ ((tid >> 4) & 7);
    const bf16_t* gx = X + (size_t)srow * ldx + skc * 8;
    const bf16_t* gw = W + (size_t)srow * ldw + skc * 8;
    const int nk = K >> 6;
    auto issue = [&](int kt) {
        char* st = lds + (kt & 1) * GEMM_STAGE + tid * 16;
        const int ko = kt * 64;
#pragma unroll
        for (int i = 0; i < 4; ++i) {
            __builtin_amdgcn_global_load_lds((const unsigned*)(gx + (size_t)(32 * i) * ldx + ko), (LDSP unsigned*)(st + i * 4096), 16, 0, 0);
            __builtin_amdgcn_global_load_lds((const unsigned*)(gw + (size_t)(32 * i) * ldw + ko), (LDSP unsigned*)(st + 16384 + i * 4096), 16, 0, 0);
        }
    };
    const int swz = (fr >> 1) & 7;
    asm volatile("s_waitcnt vmcnt(0) lgkmcnt(0)" ::: "memory");
    __syncthreads();
    issue(0);
    for (int kt = 0; kt < nk; ++kt) {
        asm volatile("s_waitcnt vmcnt(0)" ::: "memory");
        __syncthreads();
        if (kt + 1 < nk) issue(kt + 1);
        const char* sx = lds + (kt & 1) * GEMM_STAGE;
        const char* sw = sx + 16384;
#pragma unroll
        for (int ks = 0; ks < 2; ++ks) {
            const int cb = ((ks * 4 + fq) ^ swz) << 4;
            bf16x8 xf[4], wf[4];
#pragma unroll
            for (int i = 0; i < 4; ++i) {
                xf[i] = *(const bf16x8*)(sx + (wm * 64 + i * 16 + fr) * 128 + cb);
                wf[i] = *(const bf16x8*)(sw + (wn * 64 + i * 16 + fr) * 128 + cb);
            }
#pragma unroll
            for (int ti = 0; ti < 4; ++ti)
#pragma unroll
                for (int ni = 0; ni < 4; ++ni)
                    acc[ti][ni] = NMODE ? MFMA16(xf[ti], wf[ni], acc[ti][ni]) : MFMA16(wf[ni], xf[ti], acc[ti][ni]);
        }
    }
    asm volatile("" ::: "memory");
    __builtin_amdgcn_sched_barrier(0);
}
DI void zero_acc(f32x4 (&acc)[4][4]) {
#pragma unroll
    for (int i = 0; i < 4; ++i)
#pragma unroll
        for (int j = 0; j < 4; ++j) acc[i][j] = (f32x4){0.f, 0.f, 0.f, 0.f};
}
DI void tile_coords(int tile, int nN, int& mt, int& nt) { const int per = 16 * nN; const int g = tile / per, r = tile % per; nt = r >> 4; mt = g * 16 + (r & 15); }

DI void ada_item(const Params& p, int item, char* lds) {
    const int l = item / 96, cgp = item % 96, tid = threadIdx.x, lane = tid & 63, wid = tid >> 6;
    const float* c = (const float*)p.in[I_C];
    const float* w = (const float*)p.in[I_WADA] + (size_t)l * 1024 * 6144 + cgp * 64 + lane;
    float a0 = 0.f, a1 = 0.f;
    const int k0 = wid * 256;
#pragma unroll 8
    for (int k = k0; k < k0 + 256; ++k) {
        const float wv = w[(size_t)k * 6144];
        a0 += siluf_(c[k]) * wv; a1 += siluf_(c[1024 + k]) * wv;
    }
    float* red = (float*)lds;
    __syncthreads();
    red[(wid * 2 + 0) * 64 + lane] = a0; red[(wid * 2 + 1) * 64 + lane] = a1;
    __syncthreads();
    if (tid < 128) {
        const int b = tid >> 6, n = cgp * 64 + (tid & 63);
        float s = ((const float*)p.in[I_BADA])[l * 6144 + n];
        for (int w4 = 0; w4 < 4; ++w4) s += red[(w4 * 2 + b) * 64 + (tid & 63)];
        ((float*)(p.ws + OFF_CTRL + CT_ADA))[(l * 2 + b) * 6144 + n] = s;
    }
}
DI void lam_item(const Params& p) {
    if (threadIdx.x < 64) {
        const int lane = threadIdx.x;
        for (int l = 0; l < DEPTH; ++l) {
            float s1 = ((const float*)p.in[I_LQ1])[l * 64 + lane] * ((const float*)p.in[I_LK1])[l * 64 + lane];
            float s2 = ((const float*)p.in[I_LQ2])[l * 64 + lane] * ((const float*)p.in[I_LK2])[l * 64 + lane];
            s1 = wave_sum(s1); s2 = wave_sum(s2);
            const float lam_init = 0.8f - 0.6f * expf(-0.3f * (float)l);
            if (lane == 0) ((float*)(p.ws + OFF_CTRL + CT_LAM))[l] = expf(s1) - expf(s2) + lam_init;
        }
    }
}
DI void rope_item(const Params& p, int item) {
    const int* pos = (const int*)p.in[I_POS];
    float* rc = (float*)(p.ws + OFF_ROPE);
    float* rs = rc + (size_t)NT * 32;
#pragma unroll
    for (int e = 0; e < 8; ++e) {
        const int idx = item * 2048 + e * 256 + threadIdx.x;
        const int t = idx >> 5, i = idx & 31;
        const float inv = powf(10000.0f, -(float)i / 32.0f);
        const float ang = (float)pos[t] * inv;
        float sn, cs; sincosf(ang, &sn, &cs);
        rc[idx] = cs; rs[idx] = sn;
    }
}
DI int win_srcmap(int n) {
    if (n < 3072 || n >= 5120) return n;
    const int q = n - 3072, j = q >> 6, r = q & 63;
    return r < 32 ? 3072 + 32 * j + r : 3072 + 1024 + 32 * j + (r - 32);
}
DI void transpose_tile(const float* src, int N, bf16_t* dst, int k0, int n0, bool perm, char* lds, int dld = 1024) {
    float* t = (float*)lds;
    const int tid = threadIdx.x;
    const int r = tid >> 4, c4 = (tid & 15) * 4;
    int ns = n0 + c4; if (perm) ns = win_srcmap(ns);
    __syncthreads();
#pragma unroll
    for (int i = 0; i < 4; ++i) {
        const int kl = r + 16 * i;
        const f32x4 v = *(const f32x4*)(src + (size_t)(k0 + kl) * N + ns);
        t[(c4 + 0) * 65 + kl] = v[0]; t[(c4 + 1) * 65 + kl] = v[1]; t[(c4 + 2) * 65 + kl] = v[2]; t[(c4 + 3) * 65 + kl] = v[3];
    }
    __syncthreads();
    const int nl = tid >> 2, kq = (tid & 3) * 16;
    u32x4 o0, o1;
    const float* tr = t + nl * 65 + kq;
    o0.x = pk2(tr[0], tr[1]); o0.y = pk2(tr[2], tr[3]); o0.z = pk2(tr[4], tr[5]); o0.w = pk2(tr[6], tr[7]);
    o1.x = pk2(tr[8], tr[9]); o1.y = pk2(tr[10], tr[11]); o1.z = pk2(tr[12], tr[13]); o1.w = pk2(tr[14], tr[15]);
    bf16_t* d = dst + (size_t)(n0 + nl) * dld + k0 + kq;
    *(u32x4*)d = o0; *(u32x4*)(d + 8) = o1;
}
constexpr int NCONV_ITEMS = 2880 + 1024 + 512 + 2 + 32;
DI void convert_item(const Params& p, int l, int item, char* lds) {
    char* wb = p.ws + OFF_W;
    if (item < 2880) { const int kt = item % 16, nt = item / 16; transpose_tile((const float*)p.in[I_WIN] + (size_t)l * 1024 * CIN, CIN, (bf16_t*)(wb + W_IN), kt * 64, nt * 64, true, lds); return; }
    item -= 2880;
    if (item < 1024) {
        const int which = item >> 8, it = item & 255, kt = it & 15, nt = it >> 4;
        const int idx = which == 0 ? I_WATTO : which == 1 ? I_WCONVO : which == 2 ? I_WRWKVO : I_WOUT;
        const size_t off = which == 0 ? W_ATTO : which == 1 ? W_CONVO : which == 2 ? W_RWKVO : W_OUT;
        transpose_tile((const float*)p.in[idx] + (size_t)l * 1024 * 1024, 1024, (bf16_t*)(wb + off), kt * 64, nt * 64, false, lds); return;
    }
    item -= 1024;
    if (item < 512) { const int kt = item & 15, nt = item >> 4; transpose_tile((const float*)p.in[I_WQ] + (size_t)l * 1024 * 2048, 2048, (bf16_t*)(wb + W_QP), kt * 64, nt * 64, false, lds); return; }
    item -= 512;
    if (item >= 2) {
        item -= 2;
        if (item < 16) { transpose_tile((const float*)p.in[I_W2] + (size_t)l * 64 * 1024, 1024, (bf16_t*)(wb + W_W2T), 0, item * 64, false, lds, 64); return; }
        item -= 16;
        if (item < 16) { transpose_tile((const float*)p.in[I_A2] + (size_t)l * 64 * 1024, 1024, (bf16_t*)(wb + W_A2T), 0, item * 64, false, lds, 64); return; }
        return;
    }
    {
        const float* src = (const float*)p.in[item == 0 ? I_KEY1 : I_KEY2] + (size_t)l * 16384;
        bf16_t* dst = (bf16_t*)(wb + (item == 0 ? W_KEY1 : W_KEY2));
        for (int i = threadIdx.x * 4; i < 16384; i += 1024) { const f32x4 v = *(const f32x4*)(src + i); *(u32x2*)(dst + i) = pack4(v[0], v[1], v[2], v[3]); }
    }
}
constexpr size_t OFF_PU8 = OFF_ZR, OFF_PV8 = OFF_ZR + 16 * MiB, OFF_PSU = OFF_ZR + 32 * MiB, OFF_PSV = OFF_PSU + 65536;
DI void convert_uv_item(const Params& p, int l, int item) {
    const int lane = threadIdx.x & 63, rowi = item * 4 + (threadIdx.x >> 6);
    const int arr = rowi >> 14, row = rowi & 16383;
    const float* src = (const float*)p.in[arr == 0 ? I_PU : I_PV] + ((size_t)l * 16384 + row) * 1024;
    unsigned* dst = (unsigned*)(p.ws + (arr == 0 ? OFF_PU8 : OFF_PV8) + (size_t)row * 1024);
    f32x4 v[4]; float am = 0.f;
#pragma unroll
    for (int i = 0; i < 4; ++i) { v[i] = *(const f32x4*)(src + i * 256 + lane * 4); am = fmaxf(am, fmaxf(fmaxf(fabsf(v[i][0]), fabsf(v[i][1])), fmaxf(fabsf(v[i][2]), fabsf(v[i][3])))); }
    am = wave_max(am);
    const float sc = am > 0.f ? am * (1.0f / 127.0f) : 1.0f, isc = am > 0.f ? 127.0f / am : 0.f;
#pragma unroll
    for (int i = 0; i < 4; ++i) {
        unsigned w = 0;
#pragma unroll
        for (int e = 0; e < 4; ++e) { const int q = (int)rintf(v[i][e] * isc) + (arr == 0 ? 0 : 128); w |= ((unsigned)q & 255u) << (8 * e); }
        dst[i * 64 + lane] = w;
    }
    if (lane == 0) ((float*)(p.ws + (arr == 0 ? OFF_PSU : OFF_PSV)))[row] = sc;
}

DI void norm_rows(const Params& p, const float* xin, const float* gain, const float* shv, const float* scv, bf16_t* out) {
    const int lane = threadIdx.x & 63;
    const int gw = blockIdx.x * 4 + (threadIdx.x >> 6), nw = gridDim.x * 4;
    for (int t = gw; t < NT; t += nw) {
        const int b = t >> 13;
        f32x4 v[4]; float ss = 0.f;
#pragma unroll
        for (int i = 0; i < 4; ++i) { v[i] = *(const f32x4*)(xin + (size_t)t * 1024 + i * 256 + lane * 4); ss += v[i][0] * v[i][0] + v[i][1] * v[i][1] + v[i][2] * v[i][2] + v[i][3] * v[i][3]; }
        ss = wave_sum(ss);
        const float rstd = rsqrtf(ss * (1.0f / 1024.0f) + 1e-6f);
#pragma unroll
        for (int i = 0; i < 4; ++i) {
            const int n = i * 256 + lane * 4;
            const f32x4 g = *(const f32x4*)(gain + n), sc = *(const f32x4*)(scv + b * 6144 + n), sh = *(const f32x4*)(shv + b * 6144 + n);
            float o[4];
#pragma unroll
            for (int e = 0; e < 4; ++e) o[e] = v[i][e] * rstd * g[e] * (1.0f + sc[e]) + sh[e];
            *(u32x2*)(out + (size_t)t * 1024 + n) = pack4(o[0], o[1], o[2], o[3]);
        }
    }
}

DI void phaseB_tile(const Params& p, int mt, int nt, char* lds) {
    const int tid = threadIdx.x, lane = tid & 63, wid = tid >> 6, wm = wid >> 1, wn = wid & 1;
    const int fr = lane & 15, fq = lane >> 4;
    const bf16_t* X = (const bf16_t*)(p.ws + OFF_H) + (size_t)mt * 128 * 1024;
    const bf16_t* W = (const bf16_t*)(p.ws + OFF_W + W_IN) + (size_t)nt * 128 * 1024;
    const int n0 = nt * 128, nb = n0 + wn * 64;
    const int m0 = mt * 128 + wm * 64;
    f32x4 acc[4][4]; zero_acc(acc);
    if (n0 >= 2048 && n0 < 3072) {
        gemm_mainloop<true>(acc, X, 1024, W, 1024, 1024, lds);
        bf16_t* VT = (bf16_t*)(p.ws + OFF_VT);
#pragma unroll
        for (int ni = 0; ni < 4; ++ni) {
            const int col = nb - 2048 + ni * 16 + fr, hh = col >> 7, dv = col & 127, d = dv >> 5, rr = dv & 31;
#pragma unroll
            for (int ti = 0; ti < 4; ++ti) {
                const int tok = m0 + ti * 16 + fq * 4;
                const int b = tok >> 13, s = tok & 8191, kt = s >> 6, kl = s & 63, kb = kl >> 5, x = kl & 31;
                const int s_ = (x >> 4) & 1, jhi = (x >> 3) & 1, h_ = (x >> 2) & 1;
                const size_t base = ((size_t)((b * 8 + hh) * 128 + kt)) * 8192 + (size_t)(((((d * 2 + kb) * 2 + s_) * 2 + h_) * 32 + rr) * 8 + jhi * 4);
                *(u32x2*)(VT + base) = pack4(acc[ti][ni][0], acc[ti][ni][1], acc[ti][ni][2], acc[ti][ni][3]);
            }
        }
        return;
    }
    gemm_mainloop<false>(acc, X, 1024, W, 1024, 1024, lds);
    if (n0 < 2048) {
        const bool isK = n0 >= 1024;
        const int nn = nb - (isK ? 1024 : 0), hh = nn >> 7, c = (nn >> 6) & 1;
        const float scl = isK ? 1.0f : 0.125f * 1.4426950408889634f;
        bf16_t* dst = (bf16_t*)(p.ws + (isK ? OFF_K : OFF_Q));
        const float* rc = (const float*)(p.ws + OFF_ROPE);
        const float* rs = rc + (size_t)NT * 32;
#pragma unroll
        for (int ti = 0; ti < 4; ++ti) {
            const int tok = m0 + ti * 16 + fr, b = tok >> 13, s = tok & 8191;
            bf16_t* row = dst + ((size_t)(((b * 8 + hh) * 2 + c)) * SEQ + s) * 64;
#pragma unroll
            for (int ni = 0; ni < 2; ++ni) {
                const int i0 = ni * 16 + fq * 4;
                const f32x4 cs = *(const f32x4*)(rc + (size_t)tok * 32 + i0), sn = *(const f32x4*)(rs + (size_t)tok * 32 + i0);
                float o1[4], o2[4];
#pragma unroll
                for (int r = 0; r < 4; ++r) {
                    const float t1 = acc[ti][ni][r], t2 = acc[ti][ni + 2][r];
                    o1[r] = (t1 * cs[r] - t2 * sn[r]) * scl; o2[r] = (t2 * cs[r] + t1 * sn[r]) * scl;
                }
                *(u32x2*)(row + i0) = pack4(o1[0], o1[1], o1[2], o1[3]);
                *(u32x2*)(row + 32 + i0) = pack4(o2[0], o2[1], o2[2], o2[3]);
            }
        }
    } else if (n0 < 5120) {
        const int j = (nb - 3072) >> 6;
        bf16_t* UC = (bf16_t*)(p.ws + OFF_UC);
#pragma unroll
        for (int ti = 0; ti < 4; ++ti) {
            const int tok = m0 + ti * 16 + fr;
#pragma unroll
            for (int ni = 0; ni < 2; ++ni) {
                const int ch = 32 * j + ni * 16 + fq * 4;
                float o[4];
#pragma unroll
                for (int r = 0; r < 4; ++r) o[r] = acc[ti][ni][r] * sigmoidf_(acc[ti][ni + 2][r]);
                *(u32x2*)(UC + (size_t)tok * 1024 + ch) = pack4(o[0], o[1], o[2], o[3]);
            }
        }
    } else if (n0 < 8448) {
        bf16_t* ZR = (bf16_t*)(p.ws + OFF_ZR);
#pragma unroll
        for (int ti = 0; ti < 4; ++ti) {
            const int tok = m0 + ti * 16 + fr;
#pragma unroll
            for (int ni = 0; ni < 4; ++ni) {
                const int col = nb - 5120 + ni * 16 + fq * 4;
                *(u32x2*)(ZR + (size_t)tok * RWKV_LD + col) = pack4(acc[ti][ni][0], acc[ti][ni][1], acc[ti][ni][2], acc[ti][ni][3]);
            }
        }
    } else {
        bf16_t* ZG = (bf16_t*)(p.ws + OFF_ZG);
#pragma unroll
        for (int ti = 0; ti < 4; ++ti) {
            const int tok = m0 + ti * 16 + fr;
#pragma unroll
            for (int ni = 0; ni < 4; ++ni) {
                const int col = nb - 8448 + ni * 16 + fq * 4;
                *(u32x2*)(ZG + (size_t)tok * ZG_LD + col) = pack4(sigmoidf_(acc[ti][ni][0]), sigmoidf_(acc[ti][ni][1]), sigmoidf_(acc[ti][ni][2]), sigmoidf_(acc[ti][ni][3]));
            }
        }
    }
}

DI void zr_shift8(const bf16_t* ZR, const float* mu, int tok, int col, float (&z)[8]) {
    const u32x4 cv = *(const u32x4*)(ZR + (size_t)tok * RWKV_LD + col);
    u32x4 pv = (u32x4){0u, 0u, 0u, 0u};
    if ((tok & 8191) != 0) pv = *(const u32x4*)(ZR + (size_t)(tok - 1) * RWKV_LD + col);
    float c[8], q[8]; unpack8(cv, c); unpack8(pv, q);
    const f32x4 m0 = *(const f32x4*)(mu + col), m1 = *(const f32x4*)(mu + col + 4);
#pragma unroll
    for (int e = 0; e < 4; ++e) { z[e] = c[e] + m0[e] * (q[e] - c[e]); z[4 + e] = c[4 + e] + m1[e] * (q[4 + e] - c[4 + e]); }
}
DI void zr_shift4(const bf16_t* ZR, const float* mu, int tok, int col, float (&z)[4]) {
    const u32x2 cv = *(const u32x2*)(ZR + (size_t)tok * RWKV_LD + col);
    u32x2 pv = (u32x2){0u, 0u};
    if ((tok & 8191) != 0) pv = *(const u32x2*)(ZR + (size_t)(tok - 1) * RWKV_LD + col);
    float c[4], q[4]; unpack4(cv, c); unpack4(pv, q);
    const f32x4 m0 = *(const f32x4*)(mu + col);
#pragma unroll
    for (int e = 0; e < 4; ++e) z[e] = c[e] + m0[e] * (q[e] - c[e]);
}

constexpr size_t OFF_LORA = 501 * MiB;
constexpr size_t OFF_CF = 509 * MiB;
DI void lora_in_tile(const Params& p, int l, int tile) {
    const int tid = threadIdx.x, tok = tile * 16 + (tid >> 4), c8 = (tid & 15) * 8;
    const bf16_t* ZR = (const bf16_t*)(p.ws + OFF_ZR);
    const float* mu = (const float*)p.in[I_MU] + (size_t)l * RWKV_LD;
    bf16_t* out = (bf16_t*)(p.ws + OFF_LORA) + (size_t)tok * 256;
    float z[8], y[8];
    zr_shift8(ZR, mu, tok, 3072 + c8, z);
#pragma unroll
    for (int e = 0; e < 8; ++e) y[e] = c8 < 64 ? tanhf(z[e]) : z[e];
    { u32x4 w; w.x = pk2(y[0], y[1]); w.y = pk2(y[2], y[3]); w.z = pk2(y[4], y[5]); w.w = pk2(y[6], y[7]); *(u32x4*)(out + c8) = w; }
}
DI void lora_wa_tile(const Params& p, int l, int which, int mt, int nt, char* lds) {
    const int tid = threadIdx.x, lane = tid & 63, wid = tid >> 6, wm = wid >> 1, wn = wid & 1, fr = lane & 15, fq = lane >> 4;
    const int m0 = mt * 128 + wm * 64, nb = nt * 128 + wn * 64;
    f32x4 acc[4][4]; zero_acc(acc);
    gemm_mainloop<false>(acc, (const bf16_t*)(p.ws + OFF_LORA) + (size_t)mt * 128 * 256 + which * 64, 256,
                         (const bf16_t*)(p.ws + OFF_W + (which == 0 ? W_W2T : W_A2T)) + (size_t)nt * 128 * 64, 64, 64, lds);
    const float* bias = (const float*)p.in[which == 0 ? I_W0 : I_A0] + (size_t)l * 1024;
    bf16_t* dst = (bf16_t*)(p.ws + (which == 0 ? OFF_LW : OFF_A));
    const float scl = which == 0 ? -0.6065306597126334f : 1.0f;
#pragma unroll
    for (int ni = 0; ni < 4; ++ni) {
        const int n = nb + ni * 16 + fq * 4;
        const f32x4 bv = *(const f32x4*)(bias + n);
#pragma unroll
        for (int ti = 0; ti < 4; ++ti) {
            const int tok = m0 + ti * 16 + fr;
            float o[4];
#pragma unroll
            for (int r = 0; r < 4; ++r) o[r] = scl * sigmoidf_(acc[ti][ni][r] + bv[r]);
            *(u32x2*)(dst + (size_t)tok * 1024 + n) = pack4(o[0], o[1], o[2], o[3]);
        }
    }
}

DI void conv_tile(const Params& p, int l, int tile, char* lds) {
    const int tid = threadIdx.x, lane = tid & 63, wid = tid >> 6, t0 = tile * 16, s0 = t0 & 8191;
    const bf16_t* UC = (const bf16_t*)(p.ws + OFF_UC);
    bf16_t* out = (bf16_t*)(p.ws + OFF_CONVP);
    float* su = (float*)lds;
    float* red = su + 46 * 256;
    float s1[16], s2[16];
#pragma unroll
    for (int t = 0; t < 16; ++t) { s1[t] = 0.f; s2[t] = 0.f; }
#pragma unroll 1
    for (int ps = 0; ps < 4; ++ps) {
        const int cbase = ps * 256;
        __syncthreads();
        for (int ch = tid; ch < 46 * 32; ch += 256) {
            const int row = ch >> 5, c8 = (ch & 31) * 8;
            u32x4 v = (u32x4){0u, 0u, 0u, 0u};
            if (s0 - 30 + row >= 0) v = *(const u32x4*)(UC + (size_t)(t0 - 30 + row) * 1024 + cbase + c8);
            float f[8]; unpack8(v, f);
            *(f32x4*)(su + row * 256 + c8) = (f32x4){f[0], f[1], f[2], f[3]};
            *(f32x4*)(su + row * 256 + c8 + 4) = (f32x4){f[4], f[5], f[6], f[7]};
        }
        __syncthreads();
        const int c = cbase + tid;
        float w[31];
#pragma unroll
        for (int j = 0; j < 31; ++j) w[j] = ((const float*)p.in[I_CONVW])[(size_t)l * 31 * 1024 + j * 1024 + c];
        const float bias = ((const float*)p.in[I_CONVB])[l * 1024 + c];
        float acc[16];
#pragma unroll
        for (int t = 0; t < 16; ++t) acc[t] = bias;
#pragma unroll
        for (int rr = 0; rr < 46; ++rr) {
            const float uval = su[rr * 256 + tid];
#pragma unroll
            for (int t = 0; t < 16; ++t) if (rr - t >= 0 && rr - t <= 30) acc[t] += w[rr - t] * uval;
        }
#pragma unroll
        for (int t = 0; t < 16; ++t) {
            const bf16_t hb = f2bf(acc[t]); const float yr = bf2f(hb);
            s1[t] += yr; s2[t] += yr * yr;
            out[(size_t)(t0 + t) * 1024 + c] = hb;
        }
    }
    __syncthreads();
#pragma unroll
    for (int t = 0; t < 16; ++t) {
        const float a = wave_sum(s1[t]), b2 = wave_sum(s2[t]);
        if (lane == 0) { red[(wid * 16 + t) * 2] = a; red[(wid * 16 + t) * 2 + 1] = b2; }
    }
    __syncthreads();
#pragma unroll 1
    for (int ps = 0; ps < 4; ++ps) {
        const int c = ps * 256 + tid;
        const float g = ((const float*)p.in[I_CLNG])[l * 1024 + c], bb = ((const float*)p.in[I_CLNB])[l * 1024 + c];
#pragma unroll
        for (int t = 0; t < 16; ++t) {
            const float a = red[t * 2] + red[(16 + t) * 2] + red[(32 + t) * 2] + red[(48 + t) * 2];
            const float b2 = red[t * 2 + 1] + red[(16 + t) * 2 + 1] + red[(32 + t) * 2 + 1] + red[(48 + t) * 2 + 1];
            const float mean = a * (1.0f / 1024.0f), var = fmaxf(b2 * (1.0f / 1024.0f) - mean * mean, 0.f);
            const float y = bf2f(out[(size_t)(t0 + t) * 1024 + c]);
            const float yn = (y - mean) * rsqrtf(var + 1e-5f) * g + bb;
            out[(size_t)(t0 + t) * 1024 + c] = f2bf(siluf_(yn));
        }
    }
}

constexpr int NSEG = 4, SEGLEN = SEQ / NSEG;
constexpr int SCAN_BUF = 5 * 1024 + 512;
constexpr size_t OFF_FS = 497 * MiB;
static_assert((size_t)NB * 16 * NSEG * 2 * 4096 * 4 <= 15 * MiB, "segment state region");
DI float row8_sum(float x) { x += dpp_f<0xB1>(x); x += dpp_f<0x4E>(x); x += dpp_f<0x141>(x); return x; }
enum { SCAN_PASS1 = 0, SCAN_PASS1_DATA = 1, SCAN_FINAL = 2 };
struct StepVec { f32x2 w[4], a[4], b[4], k[4], r[4]; float v; };
DI f32x2 v2lo(f32x4 v) { return __builtin_shufflevector(v, v, 0, 1); }
DI f32x2 v2hi(f32x4 v) { return __builtin_shufflevector(v, v, 2, 3); }
DI void ld4pairs(const float* q, f32x2 (&d)[4]) { const f32x4 x = *(const f32x4*)q, y = *(const f32x4*)(q + 4); d[0] = v2lo(x); d[1] = v2hi(x); d[2] = v2lo(y); d[3] = v2hi(y); }

template <int MODE>
DI void scan_block(const Params& p, int l, int b, int hh, int seg, int half, char* lds) {
    const int tid = threadIdx.x;
    const int il = tid >> 3, cgp = tid & 7;
    const int ts = tid >> 4, jg = tid & 15;
    float* bufs = (float*)lds;
    float* ybuf = bufs + 2 * SCAN_BUF;
    const bf16_t* ZR = (const bf16_t*)(p.ws + OFF_ZR);
    const bf16_t* Ab = (const bf16_t*)(p.ws + OFF_A);
    const bf16_t* Lb = (const bf16_t*)(p.ws + OFF_LW);
    bf16_t* YS = (bf16_t*)(p.ws + OFF_YS);
    float* FS = (float*)(p.ws + OFF_FS) + (size_t)((b * 16 + hh) * NSEG) * 2 * 4096;
    const float* mu = (const float*)p.in[I_MU] + (size_t)l * RWKV_LD;
    const int ncol = hh * 64 + jg * 4;
    const f32x4 kkv = *(const f32x4*)((const float*)p.in[I_KK] + l * 1024 + ncol);
    const f32x4 kav = *(const f32x4*)((const float*)p.in[I_KA] + l * 1024 + ncol);
    const int tokb = b * SEQ + seg * SEGLEN;
    float rr[4], kk[4], vv[4]; u32x2 av, lv;
    auto stage_load = [&](int c) {
        const int tok = tokb + c * 16 + ts;
        if (MODE == SCAN_FINAL) zr_shift4(ZR, mu, tok, ncol, rr);
        zr_shift4(ZR, mu, tok, 1024 + ncol, kk);
        zr_shift4(ZR, mu, tok, 2048 + ncol, vv);
        av = *(const u32x2*)(Ab + (size_t)tok * 1024 + ncol); lv = *(const u32x2*)(Lb + (size_t)tok * 1024 + ncol);
    };
    auto stage_write = [&](float* buf) {
        float a[4], lw[4]; unpack4(av, a); unpack4(lv, lw);
        float kq[4], ss = 0.f;
#pragma unroll
        for (int e = 0; e < 4; ++e) { kq[e] = kk[e] * kkv[e]; ss += kq[e] * kq[e]; }
        ss = row16_sum(ss);
        const float inv = 1.0f / fmaxf(sqrtf(ss), 1e-12f);
        f32x4 W4, K4, A4, B4, R4;
#pragma unroll
        for (int e = 0; e < 4; ++e) {
            const float kf = kq[e] * inv;
            W4[e] = __expf(lw[e]); K4[e] = kk[e] * (1.0f + (a[e] - 1.0f) * kav[e]); A4[e] = -kf; B4[e] = kf * a[e]; R4[e] = MODE == SCAN_FINAL ? rr[e] : 0.f;
        }
        float* bp = buf + ts * 64 + jg * 4;
        *(f32x4*)(bp) = W4; *(f32x4*)(bp + 1024) = K4; *(f32x4*)(bp + 2048) = A4; *(f32x4*)(bp + 3072) = B4;
        if ((jg >> 3) == half) *(f32x4*)(buf + 5120 + ts * 32 + (jg & 7) * 4) = (f32x4){vv[0], vv[1], vv[2], vv[3]};
        if (MODE == SCAN_FINAL) *(f32x4*)(bp + 4096) = R4;
    };
    f32x2 S[4], P[4];
#pragma unroll
    for (int q = 0; q < 4; ++q) {
        S[q] = (f32x2){0.f, 0.f};
        P[q] = (f32x2){((half * 32 + il) == cgp * 8 + 2 * q) ? 1.0f : 0.f, ((half * 32 + il) == cgp * 8 + 2 * q + 1) ? 1.0f : 0.f};
    }
    __syncthreads();
    if (MODE == SCAN_FINAL && seg > 0) {
        float* srow = (float*)lds;
        for (int q = 0; q < seg; ++q) {
            const float* Zq = FS + (size_t)(q * 2 + 0) * 4096 + (size_t)(half * 32 + il) * 64 + cgp * 8;
            const float* Pq = FS + (size_t)(q * 2 + 1) * 4096 + cgp * 8;
            *(f32x4*)(srow + il * 64 + cgp * 8) = (f32x4){S[0].x, S[0].y, S[1].x, S[1].y};
            *(f32x4*)(srow + il * 64 + cgp * 8 + 4) = (f32x4){S[2].x, S[2].y, S[3].x, S[3].y};
            __syncthreads();
            f32x4 n0 = *(const f32x4*)Zq, n1 = *(const f32x4*)(Zq + 4);
            if (q > 0)
#pragma unroll 4
            for (int m = 0; m < 64; ++m) {
                const float sm = srow[il * 64 + m];
                n0 += sm * *(const f32x4*)(Pq + (size_t)m * 64); n1 += sm * *(const f32x4*)(Pq + (size_t)m * 64 + 4);
            }
            __syncthreads();
            S[0] = v2lo(n0); S[1] = v2hi(n0); S[2] = v2lo(n1); S[3] = v2hi(n1);
        }
    }
    stage_load(0); stage_write(bufs);
    __syncthreads();
    constexpr int NCH = SEGLEN / 16;
    for (int c = 0; c < NCH; ++c) {
        const float* buf = bufs + (c & 1) * SCAN_BUF;
        float* yb = ybuf + (c & 1) * 512;
        if (MODE == SCAN_FINAL && c > 0) {
            const float* yp = ybuf + ((c - 1) & 1) * 512;
#pragma unroll
            for (int q = 0; q < 2; ++q) { const int idx = tid + 256 * q; YS[(size_t)(tokb + (c - 1) * 16 + (idx >> 5)) * 1024 + hh * 64 + half * 32 + (idx & 31)] = f2bf(yp[idx]); }
        }
        if (c + 1 < NCH) stage_load(c + 1);
        float ykeep0 = 0.f, ykeep1 = 0.f;
        auto ldstep = [&](int t, StepVec& sv) {
            const float* bp = buf + t * 64 + cgp * 8;
            ld4pairs(bp, sv.w); ld4pairs(bp + 1024, sv.k); ld4pairs(bp + 2048, sv.a); ld4pairs(bp + 3072, sv.b);
            if (MODE == SCAN_FINAL) ld4pairs(bp + 4096, sv.r);
            sv.v = buf[5120 + t * 32 + il];
        };
        StepVec sv[2];
        ldstep(0, sv[0]);
#pragma unroll 2
        for (int t = 0; t < 16; ++t) {
            ldstep(t + 1, sv[(t + 1) & 1]);
            const StepVec& x = sv[t & 1];
            f32x2 d2 = S[0] * x.a[0]; d2 = S[1] * x.a[1] + d2; d2 = S[2] * x.a[2] + d2; d2 = S[3] * x.a[3] + d2;
            float sa = d2.x + d2.y;
            const f32x2 vv2 = (f32x2){x.v, x.v};
            f32x2 tq[4];
#pragma unroll
            for (int e = 0; e < 4; ++e) tq[e] = S[e] * x.w[e] + vv2 * x.k[e];
            sa = row8_sum(sa);
            const f32x2 sa2 = (f32x2){sa, sa};
#pragma unroll
            for (int e = 0; e < 4; ++e) S[e] = tq[e] + sa2 * x.b[e];
            if (MODE == SCAN_PASS1) {
                f32x2 e2 = P[0] * x.a[0]; e2 = P[1] * x.a[1] + e2; e2 = P[2] * x.a[2] + e2; e2 = P[3] * x.a[3] + e2;
                float pa = e2.x + e2.y;
                f32x2 pq[4];
#pragma unroll
                for (int e = 0; e < 4; ++e) pq[e] = P[e] * x.w[e];
                pa = row8_sum(pa);
                const f32x2 pa2 = (f32x2){pa, pa};
#pragma unroll
                for (int e = 0; e < 4; ++e) P[e] = pq[e] + pa2 * x.b[e];
            }
            if (MODE == SCAN_FINAL) {
                f32x2 y2 = S[0] * x.r[0]; y2 = S[1] * x.r[1] + y2; y2 = S[2] * x.r[2] + y2; y2 = S[3] * x.r[3] + y2;
                float y = y2.x + y2.y;
                y = row8_sum(y);
                if (cgp == (t & 7)) { if (t < 8) ykeep0 = y; else ykeep1 = y; }
            }
            __builtin_amdgcn_sched_barrier(0);
        }
        if (MODE == SCAN_FINAL) { yb[cgp * 32 + il] = ykeep0; yb[(cgp + 8) * 32 + il] = ykeep1; }
        if (c + 1 < NCH) stage_write(bufs + ((c + 1) & 1) * SCAN_BUF);
        __syncthreads();
    }
    if (MODE == SCAN_FINAL) {
        const float* yp = ybuf + ((NCH - 1) & 1) * 512;
#pragma unroll
        for (int q = 0; q < 2; ++q) { const int idx = tid + 256 * q; YS[(size_t)(tokb + (NCH - 1) * 16 + (idx >> 5)) * 1024 + hh * 64 + half * 32 + (idx & 31)] = f2bf(yp[idx]); }
    } else {
        float* dz = FS + (size_t)(seg * 2 + 0) * 4096 + (size_t)(half * 32 + il) * 64 + cgp * 8;
        *(f32x4*)dz = (f32x4){S[0].x, S[0].y, S[1].x, S[1].y}; *(f32x4*)(dz + 4) = (f32x4){S[2].x, S[2].y, S[3].x, S[3].y};
        if (MODE == SCAN_PASS1) {
            float* dp = FS + (size_t)(seg * 2 + 1) * 4096 + (size_t)(half * 32 + il) * 64 + cgp * 8;
            *(f32x4*)dp = (f32x4){P[0].x, P[0].y, P[1].x, P[1].y}; *(f32x4*)(dp + 4) = (f32x4){P[2].x, P[2].y, P[3].x, P[3].y};
        }
    }
}
constexpr int N_SCAN1 = 64 * (NSEG - 1), N_SCAN2 = 64 * NSEG;
DI void scan_item_pass1(const Params& p, int l, int it, char* lds) {
    const int half = it & 1, bh = (it >> 1) & 31, seg = (NSEG - 2) - (it >> 6);
    if (seg == 0) scan_block<SCAN_PASS1_DATA>(p, l, bh >> 4, bh & 15, seg, half, lds);
    else scan_block<SCAN_PASS1>(p, l, bh >> 4, bh & 15, seg, half, lds);
}
DI void scan_item_pass2(const Params& p, int l, int it, char* lds) {
    const int half = it & 1, bh = (it >> 1) & 31, seg = it >> 6;
    scan_block<SCAN_FINAL>(p, l, bh >> 4, bh & 15, seg, half, lds);
}

constexpr int ATT_LDK = 72;
DI void attn_unit(const Params& p, int l, int unit, char* lds) {
    const int tid = threadIdx.x, lane = tid & 63, wid = tid >> 6, c = wid >> 1, qs = wid & 1, r32 = lane & 31, h = lane >> 5;
    const int qb = 127 - (unit >> 4), bh = unit & 15, hh = bh & 7, b = bh >> 3;
    const bf16_t* Qg = (const bf16_t*)(p.ws + OFF_Q);
    const bf16_t* Kg = (const bf16_t*)(p.ws + OFF_K);
    const bf16_t* VTg = (const bf16_t*)(p.ws + OFF_VT) + (size_t)bh * 128 * 8192;
    const int query = qb * 64 + qs * 32 + r32;
    bf16x8 qf[4];
#pragma unroll
    for (int ks = 0; ks < 4; ++ks) qf[ks] = *(const bf16x8*)(Qg + ((size_t)(bh * 2 + c) * SEQ + query) * 64 + ks * 16 + h * 8);
    auto issue = [&](int kt) {
        char* st = lds + (kt & 1) * 32768 + tid * 16;
#pragma unroll
        for (int i = 0; i < 4; ++i) {
            const int bb = tid * 16 + i * 4096, cm = bb >> 13, row = (bb >> 7) & 63, kc = ((bb >> 4) & 7) ^ ((row >> 1) & 7);
            __builtin_amdgcn_global_load_lds((const unsigned*)(Kg + ((size_t)(bh * 2 + cm) * SEQ + kt * 64 + row) * 64 + kc * 8), (LDSP unsigned*)(st + i * 4096), 16, 0, 0);
            __builtin_amdgcn_global_load_lds((const unsigned*)(VTg + (size_t)kt * 8192 + (tid + 256 * i) * 8), (LDSP unsigned*)(st + 16384 + i * 4096), 16, 0, 0);
        }
    };
    f32x16 O[4];
#pragma unroll
    for (int d = 0; d < 4; ++d)
#pragma unroll
        for (int e = 0; e < 16; ++e) O[d][e] = 0.f;
    float m_run = -INFINITY, lsum = 0.f;
    const int kswz = (r32 >> 1) & 7;
    issue(0);
    for (int kt = 0; kt <= qb; ++kt) {
        asm volatile("s_waitcnt vmcnt(0)" ::: "memory");
        __syncthreads();
        if (kt < qb) issue(kt + 1);
        const char* sKb = lds + (kt & 1) * 32768;
        const bf16_t* sVT = (const bf16_t*)(sKb + 16384);
        f32x16 st[2];
#pragma unroll
        for (int kb = 0; kb < 2; ++kb) {
#pragma unroll
            for (int e = 0; e < 16; ++e) st[kb][e] = 0.f;
#pragma unroll
            for (int ks = 0; ks < 4; ++ks) {
                const bf16x8 kf = *(const bf16x8*)(sKb + (c * 64 + kb * 32 + r32) * 128 + (((ks * 2 + h) ^ kswz) << 4));
                st[kb] = MFMA32(kf, qf[ks], st[kb]);
            }
        }
        if (kt == qb) {
            const int ql = qs * 32 + r32;
#pragma unroll
            for (int kb = 0; kb < 2; ++kb)
#pragma unroll
                for (int e = 0; e < 16; ++e) { const int keyl = kb * 32 + (e & 3) + 8 * (e >> 2) + 4 * h; if (keyl > ql) st[kb][e] = -INFINITY; }
        }
        float mx = st[0][0];
#pragma unroll
        for (int kb = 0; kb < 2; ++kb)
#pragma unroll
            for (int e = 0; e < 16; ++e) mx = fmaxf(mx, st[kb][e]);
        mx = fmaxf(mx, __shfl_xor(mx, 32));
        if (__any(mx > m_run + 8.0f)) {
            const float mnew = fmaxf(m_run, mx);
            const float alpha = __builtin_amdgcn_exp2f(m_run - mnew);
            m_run = mnew;
            lsum *= alpha;
#pragma unroll
            for (int d = 0; d < 4; ++d)
#pragma unroll
                for (int e = 0; e < 16; ++e) O[d][e] *= alpha;
        }
        float ps = 0.f;
#pragma unroll
        for (int kb = 0; kb < 2; ++kb)
#pragma unroll
            for (int e = 0; e < 16; ++e) { st[kb][e] = __builtin_amdgcn_exp2f(st[kb][e] - m_run); ps += st[kb][e]; }
        lsum += ps;
        bf16x8 pf[2][2];
#pragma unroll
        for (int kb = 0; kb < 2; ++kb)
#pragma unroll
            for (int s = 0; s < 2; ++s) {
                u32x4 pk;
                pk.x = pk2(st[kb][8 * s + 0], st[kb][8 * s + 1]); pk.y = pk2(st[kb][8 * s + 2], st[kb][8 * s + 3]);
                pk.z = pk2(st[kb][8 * s + 4], st[kb][8 * s + 5]); pk.w = pk2(st[kb][8 * s + 6], st[kb][8 * s + 7]);
                pf[kb][s] = __builtin_bit_cast(bf16x8, pk);
            }
#pragma unroll
        for (int d = 0; d < 4; ++d)
#pragma unroll
            for (int kb = 0; kb < 2; ++kb)
#pragma unroll
                for (int s = 0; s < 2; ++s) {
                    const bf16x8 vf = *(const bf16x8*)(sVT + (((d * 2 + kb) * 2 + s) * 64 + lane) * 8);
                    O[d] = MFMA32(vf, pf[kb][s], O[d]);
                }
    }
    const float ltot = lsum + __shfl_xor(lsum, 32);
    const float inv = 1.0f / ltot;
    float* xo = (float*)lds;
    __syncthreads();
    if (c == 1) {
#pragma unroll
        for (int d = 0; d < 4; ++d)
#pragma unroll
            for (int e = 0; e < 16; ++e) xo[(qs * 64 + d * 16 + e) * 64 + lane] = O[d][e] * inv;
    }
    __syncthreads();
    if (c == 0) {
        const float lam = ((const float*)(p.ws + OFF_CTRL + CT_LAM))[l];
        const float lam_init = 0.8f - 0.6f * expf(-0.3f * (float)l);
        float ss = 0.f;
#pragma unroll
        for (int d = 0; d < 4; ++d)
#pragma unroll
            for (int e = 0; e < 16; ++e) { const float o = O[d][e] * inv - lam * xo[(qs * 64 + d * 16 + e) * 64 + lane]; O[d][e] = o; ss += o * o; }
        ss += __shfl_xor(ss, 32);
        const float rstd = rsqrtf(ss * (1.0f / 128.0f) + 1e-6f) * (1.0f - lam_init);
        bf16_t* outp = (bf16_t*)(p.ws + OFF_ATTP) + (size_t)(b * SEQ + query) * 1024 + hh * 128;
        const float* hg = (const float*)p.in[I_AHG] + (size_t)(l * 8 + hh) * 128;
#pragma unroll
        for (int d = 0; d < 4; ++d)
#pragma unroll
            for (int g4 = 0; g4 < 4; ++g4) {
                const int dv0 = d * 32 + 8 * g4 + 4 * h;
                const f32x4 g = *(const f32x4*)(hg + dv0);
                *(u32x2*)(outp + dv0) = pack4(O[d][g4 * 4 + 0] * rstd * g[0], O[d][g4 * 4 + 1] * rstd * g[1], O[d][g4 * 4 + 2] * rstd * g[2], O[d][g4 * 4 + 3] * rstd * g[3]);
            }
    }
}

DI void rwkv_post_tile(const Params& p, int l, int tile, char* lds) {
    const int tid = threadIdx.x, t0 = tile * 16, n4 = tid * 4;
    const bf16_t* ZR = (const bf16_t*)(p.ws + OFF_ZR);
    const bf16_t* Ab = (const bf16_t*)(p.ws + OFF_A);
    const bf16_t* YS = (const bf16_t*)(p.ws + OFF_YS);
    const float* mu = (const float*)p.in[I_MU] + (size_t)l * RWKV_LD;
    float* sg = (float*)lds;
    __syncthreads();
    {
        const int tk = tid >> 4, c8 = (tid & 15) * 8;
        float z[8]; zr_shift8(ZR, mu, t0 + tk, 3200 + c8, z);
#pragma unroll
        for (int e = 0; e < 8; ++e) sg[tk * 128 + c8 + e] = sigmoidf_(z[e]);
    }
    __syncthreads();
    f32x4 gacc[16];
#pragma unroll
    for (int t = 0; t < 16; ++t) gacc[t] = (f32x4){0.f, 0.f, 0.f, 0.f};
    const float* g2 = (const float*)p.in[I_G2] + (size_t)l * 128 * 1024 + n4;
#pragma unroll 2
    for (int k = 0; k < 128; k += 4) {
        const f32x4 w0 = *(const f32x4*)(g2 + (size_t)(k + 0) * 1024), w1 = *(const f32x4*)(g2 + (size_t)(k + 1) * 1024),
                    w2 = *(const f32x4*)(g2 + (size_t)(k + 2) * 1024), w3 = *(const f32x4*)(g2 + (size_t)(k + 3) * 1024);
#pragma unroll
        for (int t = 0; t < 16; ++t) {
            const f32x4 a = *(const f32x4*)(sg + t * 128 + k);
            gacc[t] += a[0] * w0 + a[1] * w1 + a[2] * w2 + a[3] * w3;
        }
    }
    const f32x4 kav = *(const f32x4*)((const float*)p.in[I_KA] + l * 1024 + n4);
    const f32x4 rkv = *(const f32x4*)((const float*)p.in[I_RK] + l * 1024 + n4);
    const f32x4 gng = *(const f32x4*)((const float*)p.in[I_GNG] + l * 1024 + n4);
    const f32x4 gnb = *(const f32x4*)((const float*)p.in[I_GNB] + l * 1024 + n4);
    bf16_t* out = (bf16_t*)(p.ws + OFF_RWKVP);
#pragma unroll
    for (int t = 0; t < 16; ++t) {
        const int tok = t0 + t;
        float r[4], k[4], v[4], a[4], y[4];
        zr_shift4(ZR, mu, tok, n4, r); zr_shift4(ZR, mu, tok, 1024 + n4, k); zr_shift4(ZR, mu, tok, 2048 + n4, v);
        unpack4(*(const u32x2*)(Ab + (size_t)tok * 1024 + n4), a);
        unpack4(*(const u32x2*)(YS + (size_t)tok * 1024 + n4), y);
        float cf = 0.f, s1 = 0.f, s2 = 0.f;
#pragma unroll
        for (int e = 0; e < 4; ++e) { const float kn = k[e] * (1.0f + (a[e] - 1.0f) * kav[e]); cf += r[e] * kn * rkv[e]; s1 += y[e]; s2 += y[e] * y[e]; }
        cf = row16_sum(cf); s1 = row16_sum(s1); s2 = row16_sum(s2);
        const float mean = s1 * (1.0f / 64.0f), var = fmaxf(s2 * (1.0f / 64.0f) - mean * mean, 0.f), rstd = rsqrtf(var + 64e-5f);
        float o[4];
#pragma unroll
        for (int e = 0; e < 4; ++e) o[e] = ((y[e] - mean) * rstd * gng[e] + gnb[e] + cf * v[e]) * gacc[t][e];
        *(u32x2*)(out + (size_t)tok * 1024 + n4) = pack4(o[0], o[1], o[2], o[3]);
    }
}

DI void phaseF_tile(const Params& p, int mt, int nt, char* lds) {
    const int tid = threadIdx.x, lane = tid & 63, wid = tid >> 6, wm = wid >> 1, wn = wid & 1, fr = lane & 15, fq = lane >> 4;
    const int m0 = mt * 128 + wm * 64, nb = nt * 128 + wn * 64;
    const bf16_t* ZG = (const bf16_t*)(p.ws + OFF_ZG);
    f32x4 sum[4][4]; zero_acc(sum);
#pragma unroll 1
    for (int br = 0; br < 3; ++br) {
        const size_t xoff = br == 0 ? OFF_ATTP : br == 1 ? OFF_CONVP : OFF_RWKVP;
        const size_t woff = br == 0 ? W_ATTO : br == 1 ? W_CONVO : W_RWKVO;
        f32x4 acc[4][4]; zero_acc(acc);
        gemm_mainloop<false>(acc, (const bf16_t*)(p.ws + xoff) + (size_t)mt * 128 * 1024, 1024, (const bf16_t*)(p.ws + OFF_W + woff) + (size_t)nt * 128 * 1024, 1024, 1024, lds);
#pragma unroll
        for (int ti = 0; ti < 4; ++ti) {
            const int tok = m0 + ti * 16 + fr;
#pragma unroll
            for (int ni = 0; ni < 4; ++ni) {
                float g[4]; unpack4(*(const u32x2*)(ZG + (size_t)tok * ZG_LD + br * 1024 + nb + ni * 16 + fq * 4), g);
#pragma unroll
                for (int r = 0; r < 4; ++r) sum[ti][ni][r] += g[r] * acc[ti][ni][r];
            }
        }
    }
    bf16_t* out = (bf16_t*)(p.ws + OFF_MERGED);
#pragma unroll
    for (int ti = 0; ti < 4; ++ti) {
        const int tok = m0 + ti * 16 + fr;
#pragma unroll
        for (int ni = 0; ni < 4; ++ni)
            *(u32x2*)(out + (size_t)tok * 1024 + nb + ni * 16 + fq * 4) = pack4(sum[ti][ni][0], sum[ti][ni][1], sum[ti][ni][2], sum[ti][ni][3]);
    }
}
DI void phaseG_tile(const Params& p, int l, int mt, int nt, char* lds) {
    const int tid = threadIdx.x, lane = tid & 63, wid = tid >> 6, wm = wid >> 1, wn = wid & 1, fr = lane & 15, fq = lane >> 4;
    const int m0 = mt * 128 + wm * 64, nb = nt * 128 + wn * 64;
    f32x4 acc[4][4]; zero_acc(acc);
    gemm_mainloop<false>(acc, (const bf16_t*)(p.ws + OFF_MERGED) + (size_t)mt * 128 * 1024, 1024, (const bf16_t*)(p.ws + OFF_W + W_OUT) + (size_t)nt * 128 * 1024, 1024, 1024, lds);
    const float* xin = l == 0 ? (const float*)p.in[I_X] : p.out;
    const float* ada = (const float*)(p.ws + OFF_CTRL + CT_ADA) + (size_t)l * 2 * 6144;
#pragma unroll
    for (int ti = 0; ti < 4; ++ti) {
        const int tok = m0 + ti * 16 + fr, b = tok >> 13;
#pragma unroll
        for (int ni = 0; ni < 4; ++ni) {
            const int n = nb + ni * 16 + fq * 4;
            const f32x4 xv = *(const f32x4*)(xin + (size_t)tok * 1024 + n), gt = *(const f32x4*)(ada + b * 6144 + 2 * 1024 + n);
            *(f32x4*)(p.out + (size_t)tok * 1024 + n) = xv + (1.0f + gt) * acc[ti][ni];
        }
    }
}
DI void phaseI_tile(const Params& p, int mt, int nt, char* lds) {
    const int tid = threadIdx.x, lane = tid & 63, wid = tid >> 6, wm = wid >> 1, wn = wid & 1, fr = lane & 15, fq = lane >> 4;
    const int m0 = mt * 128 + wm * 64, nb = nt * 128 + wn * 64;
    f32x4 acc[4][4]; zero_acc(acc);
    gemm_mainloop<false>(acc, (const bf16_t*)(p.ws + OFF_H) + (size_t)mt * 128 * 1024, 1024, (const bf16_t*)(p.ws + OFF_W + W_QP) + (size_t)nt * 128 * 1024, 1024, 1024, lds);
    bf16_t* out = (bf16_t*)(p.ws + OFF_QP);
#pragma unroll
    for (int ti = 0; ti < 4; ++ti) {
        const int tok = m0 + ti * 16 + fr;
#pragma unroll
        for (int ni = 0; ni < 4; ++ni)
            *(u32x2*)(out + (size_t)tok * 2048 + nb + ni * 16 + fq * 4) = pack4(acc[ti][ni][0], acc[ti][ni][1], acc[ti][ni][2], acc[ti][ni][3]);
    }
}
DI void phaseJ_tile(const Params& p, int mt, int g, char* lds) {
    const int tid = threadIdx.x, lane = tid & 63, wid = tid >> 6, wm = wid >> 1, wn = wid & 1, fr = lane & 15, fq = lane >> 4;
    const int m0 = mt * 128 + wm * 64, nb = wn * 64;
    f32x4 acc[4][4]; zero_acc(acc);
    gemm_mainloop<true>(acc, (const bf16_t*)(p.ws + OFF_QP) + (size_t)mt * 128 * 2048 + g * 128, 2048, (const bf16_t*)(p.ws + OFF_W + ((g & 1) ? W_KEY2 : W_KEY1)), 128, 128, lds);
    float* out = (float*)(p.ws + OFF_SCORES);
#pragma unroll
    for (int ni = 0; ni < 4; ++ni) {
        const int n = nb + ni * 16 + fr;
#pragma unroll
        for (int ti = 0; ti < 4; ++ti) *(f32x4*)(out + (size_t)(g * 128 + n) * NT + m0 + ti * 16 + fq * 4) = acc[ti][ni];
    }
}

DI void ins16(float (&a)[16], float x) {
#pragma unroll
    for (int i = 0; i < 16; ++i) { const float t = fmaxf(a[i], x); x = fminf(a[i], x); a[i] = t; }
}
DI void topk_thread(const Params& p, int idx) {
    const int hd = idx >> 14, t = idx & (NT - 1);
    const float* s1 = (const float*)(p.ws + OFF_SCORES) + (size_t)(hd * 256) * NT + t;
    const float* s2 = s1 + (size_t)128 * NT;
    float a[16], b[16], c[16];
#pragma unroll
    for (int i = 0; i < 16; ++i) { a[i] = -INFINITY; b[i] = -INFINITY; c[i] = -INFINITY; }
#pragma unroll 8
    for (int n = 0; n < 128; ++n) {
        const float x1 = __uint_as_float((__float_as_uint(s1[(size_t)n * NT]) & 0xFFFFFF80u) | (unsigned)(127 - n));
        const float x2 = __uint_as_float((__float_as_uint(s2[(size_t)n * NT]) & 0xFFFFFF80u) | (unsigned)(127 - n));
        ins16(a, x1); ins16(b, x2);
    }
    float v1[16], v2[16]; int i1[16], i2[16];
#pragma unroll
    for (int i = 0; i < 16; ++i) {
        const unsigned ua = __float_as_uint(a[i]), ub = __float_as_uint(b[i]);
        v1[i] = __uint_as_float(ua & 0xFFFFFF80u); i1[i] = 127 - (int)(ua & 127u);
        v2[i] = __uint_as_float(ub & 0xFFFFFF80u); i2[i] = 127 - (int)(ub & 127u);
    }
#pragma unroll
    for (int i = 0; i < 16; ++i)
#pragma unroll
        for (int j = 0; j < 16; ++j)
            if ((i + 1) * (j + 1) <= 16) ins16(c, __uint_as_float((__float_as_uint(v1[i] + v2[j]) & 0xFFFFFF00u) | (unsigned)(255 - (i * 16 + j))));
    float tv[16]; int eid[16];
#pragma unroll
    for (int r = 0; r < 16; ++r) {
        const unsigned u = __float_as_uint(c[r]);
        tv[r] = __uint_as_float(u & 0xFFFFFF00u);
        const int flat = 255 - (int)(u & 255u), ii = flat >> 4, jj = flat & 15;
        int e1 = 0, e2 = 0;
#pragma unroll
        for (int i = 0; i < 16; ++i) { e1 = (ii == i) ? i1[i] : e1; e2 = (jj == i) ? i2[i] : e2; }
        eid[r] = e1 * 128 + e2;
    }
    float sm = 0.f;
    const float mx = tv[0];
#pragma unroll
    for (int r = 0; r < 16; ++r) { tv[r] = __expf(tv[r] - mx); sm += tv[r]; }
    const float inv = 1.0f / sm;
    int* ep = (int*)(p.ws + OFF_EID) + (size_t)t * 128 + hd * 16;
    float* gp = (float*)(p.ws + OFF_GATE) + (size_t)t * 128 + hd * 16;
#pragma unroll
    for (int q = 0; q < 4; ++q) {
        *(u32x4*)(ep + q * 4) = (u32x4){(unsigned)eid[q * 4], (unsigned)eid[q * 4 + 1], (unsigned)eid[q * 4 + 2], (unsigned)eid[q * 4 + 3]};
        *(f32x4*)(gp + q * 4) = (f32x4){tv[q * 4] * inv, tv[q * 4 + 1] * inv, tv[q * 4 + 2] * inv, tv[q * 4 + 3] * inv};
    }
}

DI void cvt_u8x4(unsigned w, float (&f)[4]) { f[0] = (float)(w & 255u); f[1] = (float)((w >> 8) & 255u); f[2] = (float)((w >> 16) & 255u); f[3] = (float)(w >> 24); }
DI float gelu_zs(float v) {
    const float av = fabsf(v), t = __builtin_amdgcn_rcpf(av * 0.2316418882f + 1.0f);
    float q = t * 0.5307027145f + (-0.7265760135f); q = q * t + 0.7107068705f; q = q * t + (-0.142248368f); q = q * t + 0.127414796f; q = q * t;
    const float e = __builtin_amdgcn_exp2f(v * v * (-0.72134752044f));
    const float m = v * (q * e);
    return v < 0.f ? m : v - m;
}
DI void peer_token(const Params& p, int l, int t) {
    const int lane = threadIdx.x & 63, b = t >> 13;
    const unsigned char* U = (const unsigned char*)(p.ws + OFF_PU8);
    const unsigned char* V = (const unsigned char*)(p.ws + OFF_PV8);
    const float* SU = (const float*)(p.ws + OFF_PSU);
    const float* SV = (const float*)(p.ws + OFF_PSV);
    bf16_t* H = (bf16_t*)(p.ws + OFF_H);
    int hq[4]; float sh;
    {
        float hv[16]; float f[8];
        unpack8(*(const u32x4*)(H + (size_t)t * 1024 + lane * 16), f); for (int e = 0; e < 8; ++e) hv[e] = f[e];
        unpack8(*(const u32x4*)(H + (size_t)t * 1024 + lane * 16 + 8), f); for (int e = 0; e < 8; ++e) hv[8 + e] = f[e];
        float am = 0.f;
#pragma unroll
        for (int e = 0; e < 16; ++e) am = fmaxf(am, fabsf(hv[e]));
        am = wave_max(am);
        sh = am > 0.f ? am * (1.0f / 127.0f) : 1.0f;
        const float ish = am > 0.f ? 127.0f / am : 0.f;
#pragma unroll
        for (int q = 0; q < 4; ++q) {
            unsigned w = 0;
#pragma unroll
            for (int e = 0; e < 4; ++e) w |= ((unsigned)(int)rintf(hv[q * 4 + e] * ish) & 255u) << (8 * e);
            hq[q] = (int)w;
        }
    }
    const int* eidp = (const int*)(p.ws + OFF_EID) + (size_t)t * 128;
    const float* gatep = (const float*)(p.ws + OFF_GATE) + (size_t)t * 128;
    const int id0 = eidp[lane], id1 = eidp[64 + lane];
    const float g0 = gatep[lane], g1 = gatep[64 + lane];
    const float su0 = SU[id0] * sh, su1 = SU[id1] * sh, gs0 = g0 * SV[id0], gs1 = g1 * SV[id1];
    float acc[16], csum = 0.f;
#pragma unroll
    for (int e = 0; e < 16; ++e) acc[e] = 0.f;
    const int eidx = lane >> 3;
    const bool hi32 = (lane & 32) != 0, hi16 = (lane & 16) != 0, hi8 = (lane & 8) != 0;
#pragma unroll 1
    for (int g = 0; g < 16; ++g) {
        const int jbase = (g & 7) * 8;
        const int idr = (g & 8) ? id1 : id0; const float sur = (g & 8) ? su1 : su0, gsr = (g & 8) ? gs1 : gs0;
        u32x4 uq[8], vq[8];
#pragma unroll
        for (int e = 0; e < 8; ++e) {
            const int id = __builtin_amdgcn_readlane(idr, jbase + e);
            uq[e] = *(const u32x4*)(U + (size_t)id * 1024 + lane * 16);
            vq[e] = *(const u32x4*)(V + (size_t)id * 1024 + lane * 16);
        }
        float d[8];
#pragma unroll
        for (int e = 0; e < 8; ++e) {
            int sdot = __builtin_amdgcn_sdot4((int)uq[e].x, hq[0], 0, false);
            sdot = __builtin_amdgcn_sdot4((int)uq[e].y, hq[1], sdot, false);
            sdot = __builtin_amdgcn_sdot4((int)uq[e].z, hq[2], sdot, false);
            sdot = __builtin_amdgcn_sdot4((int)uq[e].w, hq[3], sdot, false);
            d[e] = (float)sdot;
        }
        float r4[4], r2[2];
#pragma unroll
        for (int i = 0; i < 4; ++i) { const float keep = hi32 ? d[4 + i] : d[i], send = hi32 ? d[i] : d[4 + i]; r4[i] = keep + __shfl_xor(send, 32); }
#pragma unroll
        for (int i = 0; i < 2; ++i) { const float keep = hi16 ? r4[2 + i] : r4[i], send = hi16 ? r4[i] : r4[2 + i]; r2[i] = keep + __shfl_xor(send, 16); }
        float r1;
        { const float keep = hi8 ? r2[1] : r2[0], send = hi8 ? r2[0] : r2[1]; r1 = keep + __shfl_xor(send, 8); }
        r1 = row8_sum(r1);
        const float dotv = r1 * __shfl(sur, jbase + eidx);
        const float ccl = gelu_zs(dotv) * __shfl(gsr, jbase + eidx);
#pragma unroll
        for (int e = 0; e < 8; ++e) {
            const float cc = __int_as_float(__builtin_amdgcn_readlane(__float_as_int(ccl), e * 8));
            csum += cc;
            float f[4];
            cvt_u8x4(vq[e].x, f); acc[0] += cc * f[0]; acc[1] += cc * f[1]; acc[2] += cc * f[2]; acc[3] += cc * f[3];
            cvt_u8x4(vq[e].y, f); acc[4] += cc * f[0]; acc[5] += cc * f[1]; acc[6] += cc * f[2]; acc[7] += cc * f[3];
            cvt_u8x4(vq[e].z, f); acc[8] += cc * f[0]; acc[9] += cc * f[1]; acc[10] += cc * f[2]; acc[11] += cc * f[3];
            cvt_u8x4(vq[e].w, f); acc[12] += cc * f[0]; acc[13] += cc * f[1]; acc[14] += cc * f[2]; acc[15] += cc * f[3];
        }
    }
#pragma unroll
    for (int e = 0; e < 16; ++e) acc[e] -= 128.0f * csum;
    const float* ada = (const float*)(p.ws + OFF_CTRL + CT_ADA) + (size_t)(l * 2 + b) * 6144;
    float xv[16], ss = 0.f;
#pragma unroll
    for (int q = 0; q < 4; ++q) {
        const int n = lane * 16 + q * 4;
        const f32x4 x1 = *(const f32x4*)(p.out + (size_t)t * 1024 + n), gt = *(const f32x4*)(ada + 5 * 1024 + n);
#pragma unroll
        for (int e = 0; e < 4; ++e) { const float x2 = x1[e] + (1.0f + gt[e]) * acc[q * 4 + e]; xv[q * 4 + e] = x2; ss += x2 * x2; }
    }
    ss = wave_sum(ss);
    const float rstd = rsqrtf(ss * (1.0f / 1024.0f) + 1e-6f);
    if (l + 1 < DEPTH) {
        const float* ada2 = (const float*)(p.ws + OFF_CTRL + CT_ADA) + (size_t)((l + 1) * 2 + b) * 6144;
        const float* g1n = (const float*)p.in[I_N1G] + (size_t)(l + 1) * 1024;
        float o[16];
#pragma unroll
        for (int q = 0; q < 4; ++q) {
            const int n = lane * 16 + q * 4;
            const f32x4 g = *(const f32x4*)(g1n + n), sh = *(const f32x4*)(ada2 + n), sc = *(const f32x4*)(ada2 + 1024 + n);
            *(f32x4*)(p.out + (size_t)t * 1024 + n) = (f32x4){xv[q * 4], xv[q * 4 + 1], xv[q * 4 + 2], xv[q * 4 + 3]};
#pragma unroll
            for (int e = 0; e < 4; ++e) o[q * 4 + e] = xv[q * 4 + e] * rstd * g[e] * (1.0f + sc[e]) + sh[e];
        }
        u32x4 w0, w1;
        w0.x = pk2(o[0], o[1]); w0.y = pk2(o[2], o[3]); w0.z = pk2(o[4], o[5]); w0.w = pk2(o[6], o[7]);
        w1.x = pk2(o[8], o[9]); w1.y = pk2(o[10], o[11]); w1.z = pk2(o[12], o[13]); w1.w = pk2(o[14], o[15]);
        *(u32x4*)(H + (size_t)t * 1024 + lane * 16) = w0; *(u32x4*)(H + (size_t)t * 1024 + lane * 16 + 8) = w1;
    } else {
        const float* fg = (const float*)p.in[I_FG];
#pragma unroll
        for (int q = 0; q < 4; ++q) {
            const int n = lane * 16 + q * 4;
            const f32x4 g = *(const f32x4*)(fg + n);
            f32x4 o;
#pragma unroll
            for (int e = 0; e < 4; ++e) o[e] = xv[q * 4 + e] * rstd * g[e];
            *(f32x4*)(p.out + (size_t)t * 1024 + n) = o;
        }
    }
}

#define XB_TMO      128
#define XB_XCNT(j)  (256  + 64 * (j))
#define XB_XSUB(j)  (1280 + 64 * (j))
#define XB_XGEN(j)  (2304 + 64 * (j))
#define XB_TOP      3328
#define XB_TOPGEN   3392
#define XCD_BAR_WORDS 3456
#define XB_SPIN_CAP (1u << 18)
#define LAS __attribute__((address_space(3)))
DI unsigned xb_ld(unsigned* q)              { return __hip_atomic_load(q, __ATOMIC_RELAXED, __HIP_MEMORY_SCOPE_AGENT); }
DI unsigned xb_add(unsigned* q, unsigned v) { return __hip_atomic_fetch_add(q, v, __ATOMIC_RELAXED, __HIP_MEMORY_SCOPE_AGENT); }
DI unsigned xb_xcc_id() { return (unsigned)__builtin_amdgcn_s_getreg((3 << 11) | 20) & 0xFu; }
#define XB_SPIN(cond, bar) do { unsigned _sp = 0; while (cond) { __builtin_amdgcn_s_sleep(1); \
    if ((++_sp & 255u) == 0u) { if (xb_ld(&(bar)[XB_TMO])) break; if (_sp > XB_SPIN_CAP) { atomicAdd(&(bar)[XB_TMO], 1u); break; } } } } while (0)
struct XcdBarrier { unsigned* bar; unsigned x; volatile LAS unsigned* st; };
DI XcdBarrier xcd_barrier_post(unsigned* bar, volatile LAS unsigned* st) {
    XcdBarrier b; b.bar = bar; b.x = xb_xcc_id(); b.st = st;
    if (threadIdx.x == 0) (void)xb_add(&bar[XB_XCNT(b.x)], 1u);
    return b;
}
DI void xcd_barrier_complete(unsigned* bar, unsigned x, unsigned& nloc, unsigned& nx) {
    const unsigned G = gridDim.x * gridDim.y * gridDim.z;
    unsigned sum, cnt, mine, sp = 0u;
    for (;;) {
        sum = 0u; cnt = 0u; mine = 0u;
#pragma unroll
        for (unsigned j = 0; j < 16; ++j) { const unsigned c = xb_ld(&bar[XB_XCNT(j)]); sum += c; cnt += (c > 0u) ? 1u : 0u; mine = (j == x) ? c : mine; }
        if (sum == G) break;
        __builtin_amdgcn_s_sleep(1);
        if ((++sp & 255u) == 0u) { if (xb_ld(&bar[XB_TMO])) break; if (sp > XB_SPIN_CAP) { atomicAdd(&bar[XB_TMO], 1u); break; } }
    }
    nloc = mine > 0u ? mine : 1u; nx = cnt > 0u ? cnt : 1u;
}
DI void xcd_barrier(const XcdBarrier& b) {
    asm volatile("s_waitcnt vmcnt(0)" ::: "memory");
    __syncthreads();
    if (threadIdx.x == 0) {
        unsigned* bar = b.bar;
        __builtin_amdgcn_s_waitcnt(0);
        unsigned nloc = b.st[0], nx = b.st[1];
        if (nloc == 0u) { xcd_barrier_complete(bar, b.x, nloc, nx); b.st[0] = nloc; b.st[1] = nx; }
        const unsigned old = xb_add(&bar[XB_XSUB(b.x)], 1u);
        const unsigned gen = old / nloc;
        if (old + 1u == (gen + 1u) * nloc) {
            __builtin_amdgcn_fence(__ATOMIC_RELEASE, "agent");
            asm volatile("s_waitcnt vmcnt(0)" ::: "memory");
            const unsigned og = xb_add(&bar[XB_TOP], 1u);
            const unsigned tg = og / nx;
            if (og + 1u == (tg + 1u) * nx) xb_add(&bar[XB_TOPGEN], 1u);
            else XB_SPIN(xb_ld(&bar[XB_TOPGEN]) == tg, bar);
            __builtin_amdgcn_fence(__ATOMIC_ACQUIRE, "agent");
            xb_add(&bar[XB_XGEN(b.x)], 1u);
            asm volatile("s_waitcnt vmcnt(0)" ::: "memory");
        } else {
            XB_SPIN(xb_ld(&bar[XB_XGEN(b.x)]) == gen, bar);
            __builtin_amdgcn_fence(__ATOMIC_ACQUIRE, "agent");
            asm volatile("s_waitcnt vmcnt(0)" ::: "memory");
        }
    }
    __syncthreads();
}
constexpr size_t CT_BAR = 16384;

constexpr int LDS_BYTES = 2 * GEMM_STAGE + 64;
constexpr int N_PHASES = 2 + 13 * DEPTH;
constexpr int ATT_U1 = 688;
#ifndef MULTI_LAUNCH
#define MULTI_LAUNCH 0
#endif

template <int ph> DI void run_phase(const Params& p, char* lds) {
    const int bid = blockIdx.x, nblk = gridDim.x, tid = threadIdx.x;
    const int gw = bid * 4 + (tid >> 6), nw = nblk * 4;
    const int vb = (nblk == 512) ? (bid % 8) * 64 + ((bid / 8) % 32) * 2 + (bid / 256) : (nblk % 8 == 0) ? (bid % 8) * (nblk / 8) + bid / 8 : bid;
    float* ada = (float*)(p.ws + OFF_CTRL + CT_ADA);
    if (ph == 0) {
        const int total = 192 + 1 + 256 + NCONV_ITEMS / 2;
        for (int it = bid; it < total; it += nblk) {
            if (it < 192) ada_item(p, it, lds);
            else if (it == 192) lam_item(p);
            else if (it < 449) rope_item(p, it - 193);
            else convert_item(p, 0, it - 449, lds);
        }
        return;
    }
    if (ph == 1) {
        norm_rows(p, (const float*)p.in[I_X], (const float*)p.in[I_N1G], ada, ada + 1024, (bf16_t*)(p.ws + OFF_H));
        for (int it = NCONV_ITEMS / 2 + bid; it < NCONV_ITEMS; it += nblk) convert_item(p, 0, it, lds);
        return;
    }
    constexpr int l = (ph - 2) / 13, sub0 = (ph - 2) % 13, sub = sub0 <= 1 ? sub0 : sub0 == 2 ? 100 : sub0 <= 4 ? 2 : sub0 - 2;
    switch (sub) {
    case 0:
        for (int tile = vb; tile < 128 * 90; tile += nblk) { int mt, nt; tile_coords(tile, 90, mt, nt); phaseB_tile(p, mt, nt, lds); }
        break;
    case 1:
        for (int it = bid; it < 2048; it += nblk) { if (it < 1024) conv_tile(p, l, it, lds); else lora_in_tile(p, l, it - 1024); }
        break;
    case 100:
        for (int tile = vb; tile < 2048; tile += nblk) { int mt, nt; tile_coords(tile & 1023, 8, mt, nt); lora_wa_tile(p, l, tile >> 10, mt, nt, lds); }
        break;
    case 2: {
        const bool second = sub0 == 4;
        if (!second) { for (int it = bid; it < N_SCAN1; it += nblk) scan_item_pass1(p, l, it, lds); }
        else { for (int it = bid; it < N_SCAN2; it += nblk) scan_item_pass2(p, l, it, lds); }
        unsigned* cnt = (unsigned*)(p.ws + OFF_CTRL + CT_CNT) + 64 * (l * 2 + (second ? 1 : 0));
        int* s_unit = (int*)(lds + LDS_BYTES - 16);
        constexpr int U1X = ATT_U1 / 8;
        const int jbase = second ? U1X : 0, jlim = second ? 256 : U1X;
        if (tid == 0) s_unit[1] = 0;
        for (;;) {
            __syncthreads();
            if (tid == 0) {
                const int myx = (int)(xb_xcc_id() & 7u);
                int unit = -1, qi = s_unit[1];
                while (qi < 8) {
                    const int x = (myx + qi) & 7;
                    const int j = jbase + (int)atomicAdd(cnt + x * 8, 1u);
                    if (j < jlim) { unit = ((j >> 1) << 4) | (x * 2 + (j & 1)); break; }
                    ++qi;
                }
                s_unit[0] = unit; s_unit[1] = qi;
            }
            __syncthreads();
            const int unit = s_unit[0];
            if (unit < 0) break;
            attn_unit(p, l, unit, lds);
        }
        break; }
    case 3:
        for (int it = bid; it < 1024; it += nblk) rwkv_post_tile(p, l, it, lds);
        break;
    case 4:
        for (int tile = vb; tile < 128 * 8; tile += nblk) { int mt, nt; tile_coords(tile, 8, mt, nt); phaseF_tile(p, mt, nt, lds); }
        break;
    case 5:
        for (int it = vb; it < 1024 + 8192; it += nblk) {
            if (it < 1024) { int mt, nt; tile_coords(it, 8, mt, nt); phaseG_tile(p, l, mt, nt, lds); }
            else convert_uv_item(p, l, it - 1024);
        }
        break;
    case 6:
        norm_rows(p, p.out, (const float*)p.in[I_N2G] + (size_t)l * 1024, ada + (size_t)l * 2 * 6144 + 3 * 1024, ada + (size_t)l * 2 * 6144 + 4 * 1024, (bf16_t*)(p.ws + OFF_H));
        break;
    case 7:
        for (int tile = vb; tile < 128 * 16; tile += nblk) { int mt, nt; tile_coords(tile, 16, mt, nt); phaseI_tile(p, mt, nt, lds); }
        break;
    case 8:
        for (int tile = vb; tile < 128 * 16; tile += nblk) { int mt, nt; tile_coords(tile, 16, mt, nt); phaseJ_tile(p, mt, nt, lds); }
        break;
    case 9:
        for (int idx = bid * NTHREADS + tid; idx < NT * 8; idx += nblk * NTHREADS) topk_thread(p, idx);
        if (l + 1 < DEPTH) for (int it = bid; it < NCONV_ITEMS; it += nblk) convert_item(p, l + 1, it, lds);
        break;
    case 10:
        for (int t = gw; t < NT; t += nw) peer_token(p, l, t);
        break;
    }
}

#ifndef PROBE_PH
#define PROBE_PH -1
#endif
#ifndef PROBE_MULT
#define PROBE_MULT 3
#endif
#define PHASE(N) if (p.ph_begin <= N && N < p.ph_end) { unsigned long long pt0 = 0; if (N == PROBE_PH) pt0 = __builtin_amdgcn_s_memrealtime(); run_phase<N>(p, lds); \
    if (N + 1 < p.ph_end) { if (N == 0) cg::this_grid().sync(); else xcd_barrier(xb); } \
    if (N == PROBE_PH) { const unsigned long long pt1 = __builtin_amdgcn_s_memrealtime(); while (__builtin_amdgcn_s_memrealtime() - pt1 < PROBE_MULT * (pt1 - pt0)) __builtin_amdgcn_s_sleep(8); __syncthreads(); } }
extern __shared__ __attribute__((aligned(16))) char dyn_lds[];
__global__ void __launch_bounds__(NTHREADS, 2) mega_kernel(Params p) {
    char* lds = dyn_lds;
    volatile LAS unsigned* xst = (volatile LAS unsigned*)(lds + LDS_BYTES - 32);
    if (threadIdx.x == 0) { xst[0] = 0u; xst[1] = 0u; }
    __syncthreads();
    const XcdBarrier xb = xcd_barrier_post((unsigned*)(p.ws + OFF_CTRL + CT_BAR), xst);
    PHASE(0) PHASE(1) PHASE(2) PHASE(3) PHASE(4) PHASE(5) PHASE(6) PHASE(7) PHASE(8) PHASE(9) PHASE(10) PHASE(11) PHASE(12) PHASE(13)
    PHASE(14) PHASE(15) PHASE(16) PHASE(17) PHASE(18) PHASE(19) PHASE(20) PHASE(21) PHASE(22) PHASE(23) PHASE(24) PHASE(25) PHASE(26) PHASE(27)
    static_assert(N_PHASES == 28, "phase list");
}

extern "C" void kernel_launch(void* const* d_in, const int* in_sizes, int n_in, void* d_out, int out_size, void* d_ws, size_t ws_size, hipStream_t stream) {
    static int grid_blocks = 0;
    if (!grid_blocks) {
        int dev = 0, cus = 0, per_cu = 0;
        hipGetDevice(&dev);
        hipDeviceGetAttribute(&cus, hipDeviceAttributeMultiprocessorCount, dev);
        hipFuncSetAttribute((const void*)mega_kernel, hipFuncAttributeMaxDynamicSharedMemorySize, LDS_BYTES);
        hipOccupancyMaxActiveBlocksPerMultiprocessor(&per_cu, mega_kernel, NTHREADS, LDS_BYTES);
        if (per_cu > 2) per_cu = 2;
        if (per_cu < 1) per_cu = 1;
        grid_blocks = cus * per_cu;
        if (ws_size < WS_END) fprintf(stderr, "workspace too small: %zu < %zu\n", ws_size, (size_t)WS_END);
    }
    Params p{};
    for (int i = 0; i < N_IN; ++i) p.in[i] = d_in[i];
    p.out = (float*)d_out; p.ws = (char*)d_ws;
    hipMemsetAsync(d_ws, 0, 32768, stream);
#if MULTI_LAUNCH
    for (int ph = 0; ph < N_PHASES; ++ph) {
        p.ph_begin = ph; p.ph_end = ph + 1;
        hipLaunchKernelGGL(mega_kernel, dim3(grid_blocks), dim3(NTHREADS), LDS_BYTES, stream, p);
    }
#else
    p.ph_begin = 0; p.ph_end = N_PHASES;
    void* args[] = {&p};
    hipError_t e = hipLaunchCooperativeKernel((void*)mega_kernel, dim3(grid_blocks), dim3(NTHREADS), args, LDS_BYTES, stream);
    if (e != hipSuccess) fprintf(stderr, "cooperative launch failed: %s (grid %d)\n", hipGetErrorString(e), grid_blocks);
#endif
}
```

```cpp
#include <hip/hip_runtime.h>
#include <hip/hip_cooperative_groups.h>
#include <cstdio>
#include <cstdint>
namespace cg = cooperative_groups;
#ifndef SCAN_MFMA
#define SCAN_MFMA 1
#endif
#ifndef SCAN_TEST
#define SCAN_TEST 0
#endif

#define DI __device__ __forceinline__
typedef unsigned short bf16_t;
typedef short bf16x8 __attribute__((ext_vector_type(8)));
typedef float f32x2 __attribute__((ext_vector_type(2)));
typedef float f32x4 __attribute__((ext_vector_type(4)));
typedef float f32x16 __attribute__((ext_vector_type(16)));
typedef unsigned u32x2 __attribute__((ext_vector_type(2)));
typedef unsigned u32x4 __attribute__((ext_vector_type(4)));
typedef __bf16 nbf16x2 __attribute__((ext_vector_type(2)));

constexpr int NB = 2, SEQ = 8192, NT = NB * SEQ, DM = 1024, CIN = 11520, DEPTH = 2;
constexpr int NTHREADS = 256;
constexpr size_t MiB = (size_t)1 << 20;
constexpr size_t OFF_CTRL = 0, OFF_ROPE = 1 * MiB, OFF_W = 5 * MiB, OFF_H = 41 * MiB, OFF_Q = 73 * MiB, OFF_K = 105 * MiB,
                 OFF_VT = 137 * MiB, OFF_UC = 169 * MiB, OFF_ZR = 201 * MiB, OFF_ZG = 305 * MiB, OFF_A = 401 * MiB,
                 OFF_LW = 433 * MiB, OFF_YS = 465 * MiB, WS_END = 497 * MiB;
constexpr size_t OFF_CONVP = OFF_H, OFF_ATTP = OFF_UC, OFF_RWKVP = OFF_Q, OFF_MERGED = OFF_K, OFF_PU = OFF_ZR,
                 OFF_PV = OFF_ZR + 32 * MiB, OFF_QP = OFF_ZG, OFF_SCORES = OFF_Q, OFF_EID = OFF_A, OFF_GATE = OFF_A + 8 * MiB;
constexpr size_t W_IN = 0, W_ATTO = (size_t)CIN * 1024 * 2, W_CONVO = W_ATTO + 2 * MiB, W_RWKVO = W_CONVO + 2 * MiB,
                 W_OUT = W_RWKVO + 2 * MiB, W_QP = W_OUT + 2 * MiB, W_KEY1 = W_QP + 4 * MiB, W_KEY2 = W_KEY1 + 32768,
                 W_W2T = W_KEY2 + 32768, W_A2T = W_W2T + 131072, W_G2T = W_A2T + 131072;
static_assert(W_G2T + 262144 <= 36 * MiB, "W region overflow");
constexpr size_t CT_CNT = 0, CT_LAM = 1024, CT_ADA = 65536;
constexpr int RWKV_LD = 3328, ZG_LD = 3072;

enum { I_X = 0, I_C, I_POS, I_WADA, I_BADA, I_N1G, I_WIN, I_LQ1, I_LK1, I_LQ2, I_LK2, I_AHG, I_WATTO, I_CONVW, I_CONVB, I_CLNG, I_CLNB,
       I_WCONVO, I_MU, I_W0, I_W2, I_A0, I_A2, I_G2, I_KK, I_KA, I_RK, I_GNG, I_GNB, I_WRWKVO, I_WOUT, I_N2G, I_WQ, I_KEY1, I_KEY2,
       I_PU, I_PV, I_FG, N_IN };

struct Params {
    const void* in[N_IN];
    float* out;
    char* ws;
    int ph_begin, ph_end;
};

DI unsigned pk2(float lo, float hi) { f32x2 v = {lo, hi}; nbf16x2 b = __builtin_convertvector(v, nbf16x2); return __builtin_bit_cast(unsigned, b); }
DI float bflo(unsigned u) { return __uint_as_float(u << 16); }
DI float bfhi(unsigned u) { return __uint_as_float(u & 0xffff0000u); }
DI float bf2f(bf16_t h) { return __uint_as_float(((unsigned)h) << 16); }
DI bf16_t f2bf(float x) { return (bf16_t)(pk2(x, x) & 0xffffu); }
DI float sigmoidf_(float x) { return 1.0f / (1.0f + __expf(-x)); }
DI float siluf_(float x) { return x / (1.0f + __expf(-x)); }
template <int CTRL> DI float dpp_f(float x) { return __int_as_float(__builtin_amdgcn_update_dpp(0, __float_as_int(x), CTRL, 0xF, 0xF, true)); }
DI float row16_sum(float x) { x += dpp_f<0xB1>(x); x += dpp_f<0x4E>(x); x += dpp_f<0x141>(x); x += dpp_f<0x140>(x); return x; }
DI float row16_max(float x) { x = fmaxf(x, dpp_f<0xB1>(x)); x = fmaxf(x, dpp_f<0x4E>(x)); x = fmaxf(x, dpp_f<0x141>(x)); x = fmaxf(x, dpp_f<0x140>(x)); return x; }
DI float wave_sum(float x) { x = row16_sum(x); x += __shfl_xor(x, 16); x += __shfl_xor(x, 32); return x; }
DI float wave_max(float x) { x = row16_max(x); x = fmaxf(x, __shfl_xor(x, 16)); x = fmaxf(x, __shfl_xor(x, 32)); return x; }
DI void unpack8(u32x4 v, float (&f)[8]) { f[0] = bflo(v.x); f[1] = bfhi(v.x); f[2] = bflo(v.y); f[3] = bfhi(v.y); f[4] = bflo(v.z); f[5] = bfhi(v.z); f[6] = bflo(v.w); f[7] = bfhi(v.w); }
DI void unpack4(u32x2 v, float (&f)[4]) { f[0] = bflo(v.x); f[1] = bfhi(v.x); f[2] = bflo(v.y); f[3] = bfhi(v.y); }
DI u32x2 pack4(float a, float b, float c, float d) { u32x2 r; r.x = pk2(a, b); r.y = pk2(c, d); return r; }

#define MFMA16(a, b, c) __builtin_amdgcn_mfma_f32_16x16x32_bf16((a), (b), (c), 0, 0, 0)
#define MFMA32(a, b, c) __builtin_amdgcn_mfma_f32_32x32x16_bf16((a), (b), (c), 0, 0, 0)

constexpr int GEMM_STAGE = 32768;
#define LDSP __attribute__((address_space(3)))
template <bool NMODE>
DI void gemm_mainloop(f32x4 (&acc)[4][4], const bf16_t* X, size_t ldx, const bf16_t* W, size_t ldw, int K, char* lds) {
    const int tid = threadIdx.x, lane = tid & 63, wid = tid >> 6, wm = wid >> 1, wn = wid & 1;
    const int fr = lane & 15, fq = lane >> 4;
    const int srow = tid >> 3, skc = (tid & 7) ^ ((tid >> 4) & 7);
    const bf16_t* gx = X + (size_t)srow * ldx + skc * 8;
    const bf16_t* gw = W + (size_t)srow * ldw + skc * 8;
    const int nk = K >> 6;
    auto issue = [&](int kt) {
        char* st = lds + (kt & 1) * GEMM_STAGE + tid * 16;
        const int ko = kt * 64;
#pragma unroll
        for (int i = 0; i < 4; ++i) {
            __builtin_amdgcn_global_load_lds((const unsigned*)(gx + (size_t)(32 * i) * ldx + ko), (LDSP unsigned*)(st + i * 4096), 16, 0, 0);
            __builtin_amdgcn_global_load_lds((const unsigned*)(gw + (size_t)(32 * i) * ldw + ko), (LDSP unsigned*)(st + 16384 + i * 4096), 16, 0, 0);
        }
    };
    const int swz = (fr >> 1) & 7;
    asm volatile("s_waitcnt vmcnt(0) lgkmcnt(0)" ::: "memory");
    __syncthreads();
    issue(0);
    for (int kt = 0; kt < nk; ++kt) {
        asm volatile("s_waitcnt vmcnt(0)" ::: "memory");
        __syncthreads();
        if (kt + 1 < nk) issue(kt + 1);
        const char* sx = lds + (kt & 1) * GEMM_STAGE;
        const char* sw = sx + 16384;
#pragma unroll
        for (int ks = 0; ks < 2; ++ks) {
            const int cb = ((ks * 4 + fq) ^ swz) << 4;
            bf16x8 xf[4], wf[4];
#pragma unroll
            for (int i = 0; i < 4; ++i) {
                xf[i] = *(const bf16x8*)(sx + (wm * 64 + i * 16 + fr) * 128 + cb);
                wf[i] = *(const bf16x8*)(sw + (wn * 64 + i * 16 + fr) * 128 + cb);
            }
#pragma unroll
            for (int ti = 0; ti < 4; ++ti)
#pragma unroll
                for (int ni = 0; ni < 4; ++ni)
                    acc[ti][ni] = NMODE ? MFMA16(xf[ti], wf[ni], acc[ti][ni]) : MFMA16(wf[ni], xf[ti], acc[ti][ni]);
        }
    }
    asm volatile("" ::: "memory");
    __builtin_amdgcn_sched_barrier(0);
}
DI void zero_acc(f32x4 (&acc)[4][4]) {
#pragma unroll
    for (int i = 0; i < 4; ++i)
#pragma unroll
        for (int j = 0; j < 4; ++j) acc[i][j] = (f32x4){0.f, 0.f, 0.f, 0.f};
}
DI void tile_coords(int tile, int nN, int& mt, int& nt) { const int per = 16 * nN; const int g = tile / per, r = tile % per; nt = r >> 4; mt = g * 16 + (r & 15); }

DI void ada_item(const Params& p, int item, char* lds) {
    const int l = item / 96, cgp = item % 96, tid = threadIdx.x, lane = tid & 63, wid = tid >> 6;
    const float* c = (const float*)p.in[I_C];
    const float* w = (const float*)p.in[I_WADA] + (size_t)l * 1024 * 6144 + cgp * 64 + lane;
    float a0 = 0.f, a1 = 0.f;
    const int k0 = wid * 256;
#pragma unroll 8
    for (int k = k0; k < k0 + 256; ++k) {
        const float wv = w[(size_t)k * 6144];
        a0 += siluf_(c[k]) * wv; a1 += siluf_(c[1024 + k]) * wv;
    }
    float* red = (float*)lds;
    __syncthreads();
    red[(wid * 2 + 0) * 64 + lane] = a0; red[(wid * 2 + 1) * 64 + lane] = a1;
    __syncthreads();
    if (tid < 128) {
        const int b = tid >> 6, n = cgp * 64 + (tid & 63);
        float s = ((const float*)p.in[I_BADA])[l * 6144 + n];
        for (int w4 = 0; w4 < 4; ++w4) s += red[(w4 * 2 + b) * 64 + (tid & 63)];
        ((float*)(p.ws + OFF_CTRL + CT_ADA))[(l * 2 + b) * 6144 + n] = s;
    }
}
DI void lam_item(const Params& p) {
    if (threadIdx.x < 64) {
        const int lane = threadIdx.x;
        for (int l = 0; l < DEPTH; ++l) {
            float s1 = ((const float*)p.in[I_LQ1])[l * 64 + lane] * ((const float*)p.in[I_LK1])[l * 64 + lane];
            float s2 = ((const float*)p.in[I_LQ2])[l * 64 + lane] * ((const float*)p.in[I_LK2])[l * 64 + lane];
            s1 = wave_sum(s1); s2 = wave_sum(s2);
            const float lam_init = 0.8f - 0.6f * expf(-0.3f * (float)l);
            if (lane == 0) ((float*)(p.ws + OFF_CTRL + CT_LAM))[l] = expf(s1) - expf(s2) + lam_init;
        }
    }
}
DI void rope_item(const Params& p, int item) {
    const int* pos = (const int*)p.in[I_POS];
    float* rc = (float*)(p.ws + OFF_ROPE);
    float* rs = rc + (size_t)NT * 32;
#pragma unroll
    for (int e = 0; e < 8; ++e) {
        const int idx = item * 2048 + e * 256 + threadIdx.x;
        const int t = idx >> 5, i = idx & 31;
        const float inv = powf(10000.0f, -(float)i / 32.0f);
        const float ang = (float)pos[t] * inv;
        float sn, cs; sincosf(ang, &sn, &cs);
        rc[idx] = cs; rs[idx] = sn;
    }
}
DI int win_srcmap(int n) {
    if (n < 3072 || n >= 5120) return n;
    const int q = n - 3072, j = q >> 6, r = q & 63;
    return r < 32 ? 3072 + 32 * j + r : 3072 + 1024 + 32 * j + (r - 32);
}
DI void transpose_tile(const float* src, int N, bf16_t* dst, int k0, int n0, bool perm, char* lds, int dld = 1024) {
    float* t = (float*)lds;
    const int tid = threadIdx.x;
    const int r = tid >> 4, c4 = (tid & 15) * 4;
    int ns = n0 + c4; if (perm) ns = win_srcmap(ns);
    __syncthreads();
#pragma unroll
    for (int i = 0; i < 4; ++i) {
        const int kl = r + 16 * i;
        const f32x4 v = *(const f32x4*)(src + (size_t)(k0 + kl) * N + ns);
        t[(c4 + 0) * 65 + kl] = v[0]; t[(c4 + 1) * 65 + kl] = v[1]; t[(c4 + 2) * 65 + kl] = v[2]; t[(c4 + 3) * 65 + kl] = v[3];
    }
    __syncthreads();
    const int nl = tid >> 2, kq = (tid & 3) * 16;
    u32x4 o0, o1;
    const float* tr = t + nl * 65 + kq;
    o0.x = pk2(tr[0], tr[1]); o0.y = pk2(tr[2], tr[3]); o0.z = pk2(tr[4], tr[5]); o0.w = pk2(tr[6], tr[7]);
    o1.x = pk2(tr[8], tr[9]); o1.y = pk2(tr[10], tr[11]); o1.z = pk2(tr[12], tr[13]); o1.w = pk2(tr[14], tr[15]);
    bf16_t* d = dst + (size_t)(n0 + nl) * dld + k0 + kq;
    *(u32x4*)d = o0; *(u32x4*)(d + 8) = o1;
}
constexpr int NCONV_ITEMS = 2880 + 1024 + 512 + 2 + 32;
DI void convert_item(const Params& p, int l, int item, char* lds) {
    char* wb = p.ws + OFF_W;
    if (item < 2880) { const int kt = item % 16, nt = item / 16; transpose_tile((const float*)p.in[I_WIN] + (size_t)l * 1024 * CIN, CIN, (bf16_t*)(wb + W_IN), kt * 64, nt * 64, true, lds); return; }
    item -= 2880;
    if (item < 1024) {
        const int which = item >> 8, it = item & 255, kt = it & 15, nt = it >> 4;
        const int idx = which == 0 ? I_WATTO : which == 1 ? I_WCONVO : which == 2 ? I_WRWKVO : I_WOUT;
        const size_t off = which == 0 ? W_ATTO : which == 1 ? W_CONVO : which == 2 ? W_RWKVO : W_OUT;
        transpose_tile((const float*)p.in[idx] + (size_t)l * 1024 * 1024, 1024, (bf16_t*)(wb + off), kt * 64, nt * 64, false, lds); return;
    }
    item -= 1024;
    if (item < 512) { const int kt = item & 15, nt = item >> 4; transpose_tile((const float*)p.in[I_WQ] + (size_t)l * 1024 * 2048, 2048, (bf16_t*)(wb + W_QP), kt * 64, nt * 64, false, lds); return; }
    item -= 512;
    if (item >= 2) {
        item -= 2;
        if (item < 16) { transpose_tile((const float*)p.in[I_W2] + (size_t)l * 64 * 1024, 1024, (bf16_t*)(wb + W_W2T), 0, item * 64, false, lds, 64); return; }
        item -= 16;
        if (item < 16) { transpose_tile((const float*)p.in[I_A2] + (size_t)l * 64 * 1024, 1024, (bf16_t*)(wb + W_A2T), 0, item * 64, false, lds, 64); return; }
        return;
    }
    {
        const float* src = (const float*)p.in[item == 0 ? I_KEY1 : I_KEY2] + (size_t)l * 16384;
        bf16_t* dst = (bf16_t*)(wb + (item == 0 ? W_KEY1 : W_KEY2));
        for (int i = threadIdx.x * 4; i < 16384; i += 1024) { const f32x4 v = *(const f32x4*)(src + i); *(u32x2*)(dst + i) = pack4(v[0], v[1], v[2], v[3]); }
    }
}
constexpr size_t OFF_PU8 = OFF_ZR, OFF_PV8 = OFF_ZR + 16 * MiB, OFF_PSU = OFF_ZR + 32 * MiB, OFF_PSV = OFF_PSU + 65536;
DI void convert_uv_item(const Params& p, int l, int item) {
    const int lane = threadIdx.x & 63, rowi = item * 4 + (threadIdx.x >> 6);
    const int arr = rowi >> 14, row = rowi & 16383;
    const float* src = (const float*)p.in[arr == 0 ? I_PU : I_PV] + ((size_t)l * 16384 + row) * 1024;
    unsigned* dst = (unsigned*)(p.ws + (arr == 0 ? OFF_PU8 : OFF_PV8) + (size_t)row * 1024);
    f32x4 v[4]; float am = 0.f;
#pragma unroll
    for (int i = 0; i < 4; ++i) { v[i] = *(const f32x4*)(src + i * 256 + lane * 4); am = fmaxf(am, fmaxf(fmaxf(fabsf(v[i][0]), fabsf(v[i][1])), fmaxf(fabsf(v[i][2]), fabsf(v[i][3])))); }
    am = wave_max(am);
    const float sc = am > 0.f ? am * (1.0f / 127.0f) : 1.0f, isc = am > 0.f ? 127.0f / am : 0.f;
#pragma unroll
    for (int i = 0; i < 4; ++i) {
        unsigned w = 0;
#pragma unroll
        for (int e = 0; e < 4; ++e) { const int q = (int)rintf(v[i][e] * isc) + (arr == 0 ? 0 : 128); w |= ((unsigned)q & 255u) << (8 * e); }
        dst[i * 64 + lane] = w;
    }
    if (lane == 0) ((float*)(p.ws + (arr == 0 ? OFF_PSU : OFF_PSV)))[row] = sc;
}

DI void norm_rows(const Params& p, const float* xin, const float* gain, const float* shv, const float* scv, bf16_t* out) {
    const int lane = threadIdx.x & 63;
    const int gw = blockIdx.x * 4 + (threadIdx.x >> 6), nw = gridDim.x * 4;
    for (int t = gw; t < NT; t += nw) {
        const int b = t >> 13;
        f32x4 v[4]; float ss = 0.f;
#pragma unroll
        for (int i = 0; i < 4; ++i) { v[i] = *(const f32x4*)(xin + (size_t)t * 1024 + i * 256 + lane * 4); ss += v[i][0] * v[i][0] + v[i][1] * v[i][1] + v[i][2] * v[i][2] + v[i][3] * v[i][3]; }
        ss = wave_sum(ss);
        const float rstd = rsqrtf(ss * (1.0f / 1024.0f) + 1e-6f);
#pragma unroll
        for (int i = 0; i < 4; ++i) {
            const int n = i * 256 + lane * 4;
            const f32x4 g = *(const f32x4*)(gain + n), sc = *(const f32x4*)(scv + b * 6144 + n), sh = *(const f32x4*)(shv + b * 6144 + n);
            float o[4];
#pragma unroll
            for (int e = 0; e < 4; ++e) o[e] = v[i][e] * rstd * g[e] * (1.0f + sc[e]) + sh[e];
            *(u32x2*)(out + (size_t)t * 1024 + n) = pack4(o[0], o[1], o[2], o[3]);
        }
    }
}

DI void phaseB_tile(const Params& p, int mt, int nt, char* lds) {
    const int tid = threadIdx.x, lane = tid & 63, wid = tid >> 6, wm = wid >> 1, wn = wid & 1;
    const int fr = lane & 15, fq = lane >> 4;
    const bf16_t* X = (const bf16_t*)(p.ws + OFF_H) + (size_t)mt * 128 * 1024;
    const bf16_t* W = (const bf16_t*)(p.ws + OFF_W + W_IN) + (size_t)nt * 128 * 1024;
    const int n0 = nt * 128, nb = n0 + wn * 64;
    const int m0 = mt * 128 + wm * 64;
    f32x4 acc[4][4]; zero_acc(acc);
    if (n0 >= 2048 && n0 < 3072) {
        gemm_mainloop<true>(acc, X, 1024, W, 1024, 1024, lds);
        bf16_t* VT = (bf16_t*)(p.ws + OFF_VT);
#pragma unroll
        for (int ni = 0; ni < 4; ++ni) {
            const int col = nb - 2048 + ni * 16 + fr, hh = col >> 7, dv = col & 127, d = dv >> 5, rr = dv & 31;
#pragma unroll
            for (int ti = 0; ti < 4; ++ti) {
                const int tok = m0 + ti * 16 + fq * 4;
                const int b = tok >> 13, s = tok & 8191, kt = s >> 6, kl = s & 63, kb = kl >> 5, x = kl & 31;
                const int s_ = (x >> 4) & 1, jhi = (x >> 3) & 1, h_ = (x >> 2) & 1;
                const size_t base = ((size_t)((b * 8 + hh) * 128 + kt)) * 8192 + (size_t)(((((d * 2 + kb) * 2 + s_) * 2 + h_) * 32 + rr) * 8 + jhi * 4);
                *(u32x2*)(VT + base) = pack4(acc[ti][ni][0], acc[ti][ni][1], acc[ti][ni][2], acc[ti][ni][3]);
            }
        }
        return;
    }
    gemm_mainloop<false>(acc, X, 1024, W, 1024, 1024, lds);
    if (n0 < 2048) {
        const bool isK = n0 >= 1024;
        const int nn = nb - (isK ? 1024 : 0), hh = nn >> 7, c = (nn >> 6) & 1;
        const float scl = isK ? 1.0f : 0.125f * 1.4426950408889634f;
        bf16_t* dst = (bf16_t*)(p.ws + (isK ? OFF_K : OFF_Q));
        const float* rc = (const float*)(p.ws + OFF_ROPE);
        const float* rs = rc + (size_t)NT * 32;
#pragma unroll
        for (int ti = 0; ti < 4; ++ti) {
            const int tok = m0 + ti * 16 + fr, b = tok >> 13, s = tok & 8191;
            bf16_t* row = dst + ((size_t)(((b * 8 + hh) * 2 + c)) * SEQ + s) * 64;
#pragma unroll
            for (int ni = 0; ni < 2; ++ni) {
                const int i0 = ni * 16 + fq * 4;
                const f32x4 cs = *(const f32x4*)(rc + (size_t)tok * 32 + i0), sn = *(const f32x4*)(rs + (size_t)tok * 32 + i0);
                float o1[4], o2[4];
#pragma unroll
                for (int r = 0; r < 4; ++r) {
                    const float t1 = acc[ti][ni][r], t2 = acc[ti][ni + 2][r];
                    o1[r] = (t1 * cs[r] - t2 * sn[r]) * scl; o2[r] = (t2 * cs[r] + t1 * sn[r]) * scl;
                }
                *(u32x2*)(row + i0) = pack4(o1[0], o1[1], o1[2], o1[3]);
                *(u32x2*)(row + 32 + i0) = pack4(o2[0], o2[1], o2[2], o2[3]);
            }
        }
    } else if (n0 < 5120) {
        const int j = (nb - 3072) >> 6;
        bf16_t* UC = (bf16_t*)(p.ws + OFF_UC);
#pragma unroll
        for (int ti = 0; ti < 4; ++ti) {
            const int tok = m0 + ti * 16 + fr;
#pragma unroll
            for (int ni = 0; ni < 2; ++ni) {
                const int ch = 32 * j + ni * 16 + fq * 4;
                float o[4];
#pragma unroll
                for (int r = 0; r < 4; ++r) o[r] = acc[ti][ni][r] * sigmoidf_(acc[ti][ni + 2][r]);
                *(u32x2*)(UC + (size_t)tok * 1024 + ch) = pack4(o[0], o[1], o[2], o[3]);
            }
        }
    } else if (n0 < 8448) {
        bf16_t* ZR = (bf16_t*)(p.ws + OFF_ZR);
#pragma unroll
        for (int ti = 0; ti < 4; ++ti) {
            const int tok = m0 + ti * 16 + fr;
#pragma unroll
            for (int ni = 0; ni < 4; ++ni) {
                const int col = nb - 5120 + ni * 16 + fq * 4;
                *(u32x2*)(ZR + (size_t)tok * RWKV_LD + col) = pack4(acc[ti][ni][0], acc[ti][ni][1], acc[ti][ni][2], acc[ti][ni][3]);
            }
        }
    } else {
        bf16_t* ZG = (bf16_t*)(p.ws + OFF_ZG);
#pragma unroll
        for (int ti = 0; ti < 4; ++ti) {
            const int tok = m0 + ti * 16 + fr;
#pragma unroll
            for (int ni = 0; ni < 4; ++ni) {
                const int col = nb - 8448 + ni * 16 + fq * 4;
                *(u32x2*)(ZG + (size_t)tok * ZG_LD + col) = pack4(sigmoidf_(acc[ti][ni][0]), sigmoidf_(acc[ti][ni][1]), sigmoidf_(acc[ti][ni][2]), sigmoidf_(acc[ti][ni][3]));
            }
        }
    }
}

DI void zr_shift8(const bf16_t* ZR, const float* mu, int tok, int col, float (&z)[8]) {
    const u32x4 cv = *(const u32x4*)(ZR + (size_t)tok * RWKV_LD + col);
    u32x4 pv = (u32x4){0u, 0u, 0u, 0u};
    if ((tok & 8191) != 0) pv = *(const u32x4*)(ZR + (size_t)(tok - 1) * RWKV_LD + col);
    float c[8], q[8]; unpack8(cv, c); unpack8(pv, q);
    const f32x4 m0 = *(const f32x4*)(mu + col), m1 = *(const f32x4*)(mu + col + 4);
#pragma unroll
    for (int e = 0; e < 4; ++e) { z[e] = c[e] + m0[e] * (q[e] - c[e]); z[4 + e] = c[4 + e] + m1[e] * (q[4 + e] - c[4 + e]); }
}
DI void zr_shift4(const bf16_t* ZR, const float* mu, int tok, int col, float (&z)[4]) {
    const u32x2 cv = *(const u32x2*)(ZR + (size_t)tok * RWKV_LD + col);
    u32x2 pv = (u32x2){0u, 0u};
    if ((tok & 8191) != 0) pv = *(const u32x2*)(ZR + (size_t)(tok - 1) * RWKV_LD + col);
    float c[4], q[4]; unpack4(cv, c); unpack4(pv, q);
    const f32x4 m0 = *(const f32x4*)(mu + col);
#pragma unroll
    for (int e = 0; e < 4; ++e) z[e] = c[e] + m0[e] * (q[e] - c[e]);
}

constexpr size_t OFF_LORA = 501 * MiB;
constexpr size_t OFF_CF = 509 * MiB;
DI void lora_in_tile(const Params& p, int l, int tile) {
    const int tid = threadIdx.x, tok = tile * 16 + (tid >> 4), c8 = (tid & 15) * 8;
    const bf16_t* ZR = (const bf16_t*)(p.ws + OFF_ZR);
    const float* mu = (const float*)p.in[I_MU] + (size_t)l * RWKV_LD;
    bf16_t* out = (bf16_t*)(p.ws + OFF_LORA) + (size_t)tok * 256;
    float z[8], y[8];
    zr_shift8(ZR, mu, tok, 3072 + c8, z);
#pragma unroll
    for (int e = 0; e < 8; ++e) y[e] = c8 < 64 ? tanhf(z[e]) : z[e];
    { u32x4 w; w.x = pk2(y[0], y[1]); w.y = pk2(y[2], y[3]); w.z = pk2(y[4], y[5]); w.w = pk2(y[6], y[7]); *(u32x4*)(out + c8) = w; }
}
DI void lora_wa_tile(const Params& p, int l, int which, int mt, int nt, char* lds) {
    const int tid = threadIdx.x, lane = tid & 63, wid = tid >> 6, wm = wid >> 1, wn = wid & 1, fr = lane & 15, fq = lane >> 4;
    const int m0 = mt * 128 + wm * 64, nb = nt * 128 + wn * 64;
    f32x4 acc[4][4]; zero_acc(acc);
    gemm_mainloop<false>(acc, (const bf16_t*)(p.ws + OFF_LORA) + (size_t)mt * 128 * 256 + which * 64, 256,
                         (const bf16_t*)(p.ws + OFF_W + (which == 0 ? W_W2T : W_A2T)) + (size_t)nt * 128 * 64, 64, 64, lds);
    const float* bias = (const float*)p.in[which == 0 ? I_W0 : I_A0] + (size_t)l * 1024;
    bf16_t* dst = (bf16_t*)(p.ws + (which == 0 ? OFF_LW : OFF_A));
    const float scl = which == 0 ? -0.6065306597126334f : 1.0f;
#pragma unroll
    for (int ni = 0; ni < 4; ++ni) {
        const int n = nb + ni * 16 + fq * 4;
        const f32x4 bv = *(const f32x4*)(bias + n);
#pragma unroll
        for (int ti = 0; ti < 4; ++ti) {
            const int tok = m0 + ti * 16 + fr;
            float o[4];
#pragma unroll
            for (int r = 0; r < 4; ++r) o[r] = scl * sigmoidf_(acc[ti][ni][r] + bv[r]);
            *(u32x2*)(dst + (size_t)tok * 1024 + n) = pack4(o[0], o[1], o[2], o[3]);
        }
    }
}

DI void conv_tile(const Params& p, int l, int tile, char* lds) {
    const int tid = threadIdx.x, lane = tid & 63, wid = tid >> 6, t0 = tile * 16, s0 = t0 & 8191;
    const bf16_t* UC = (const bf16_t*)(p.ws + OFF_UC);
    bf16_t* out = (bf16_t*)(p.ws + OFF_CONVP);
    float* su = (float*)lds;
    float* red = su + 46 * 256;
    float s1[16], s2[16];
#pragma unroll
    for (int t = 0; t < 16; ++t) { s1[t] = 0.f; s2[t] = 0.f; }
#pragma unroll 1
    for (int ps = 0; ps < 4; ++ps) {
        const int cbase = ps * 256;
        __syncthreads();
        for (int ch = tid; ch < 46 * 32; ch += 256) {
            const int row = ch >> 5, c8 = (ch & 31) * 8;
            u32x4 v = (u32x4){0u, 0u, 0u, 0u};
            if (s0 - 30 + row >= 0) v = *(const u32x4*)(UC + (size_t)(t0 - 30 + row) * 1024 + cbase + c8);
            float f[8]; unpack8(v, f);
            *(f32x4*)(su + row * 256 + c8) = (f32x4){f[0], f[1], f[2], f[3]};
            *(f32x4*)(su + row * 256 + c8 + 4) = (f32x4){f[4], f[5], f[6], f[7]};
        }
        __syncthreads();
        const int c = cbase + tid;
        float w[31];
#pragma unroll
        for (int j = 0; j < 31; ++j) w[j] = ((const float*)p.in[I_CONVW])[(size_t)l * 31 * 1024 + j * 1024 + c];
        const float bias = ((const float*)p.in[I_CONVB])[l * 1024 + c];
        float acc[16];
#pragma unroll
        for (int t = 0; t < 16; ++t) acc[t] = bias;
#pragma unroll
        for (int rr = 0; rr < 46; ++rr) {
            const float uval = su[rr * 256 + tid];
#pragma unroll
            for (int t = 0; t < 16; ++t) if (rr - t >= 0 && rr - t <= 30) acc[t] += w[rr - t] * uval;
        }
#pragma unroll
        for (int t = 0; t < 16; ++t) {
            const bf16_t hb = f2bf(acc[t]); const float yr = bf2f(hb);
            s1[t] += yr; s2[t] += yr * yr;
            out[(size_t)(t0 + t) * 1024 + c] = hb;
        }
    }
    __syncthreads();
#pragma unroll
    for (int t = 0; t < 16; ++t) {
        const float a = wave_sum(s1[t]), b2 = wave_sum(s2[t]);
        if (lane == 0) { red[(wid * 16 + t) * 2] = a; red[(wid * 16 + t) * 2 + 1] = b2; }
    }
    __syncthreads();
#pragma unroll 1
    for (int ps = 0; ps < 4; ++ps) {
        const int c = ps * 256 + tid;
        const float g = ((const float*)p.in[I_CLNG])[l * 1024 + c], bb = ((const float*)p.in[I_CLNB])[l * 1024 + c];
#pragma unroll
        for (int t = 0; t < 16; ++t) {
            const float a = red[t * 2] + red[(16 + t) * 2] + red[(32 + t) * 2] + red[(48 + t) * 2];
            const float b2 = red[t * 2 + 1] + red[(16 + t) * 2 + 1] + red[(32 + t) * 2 + 1] + red[(48 + t) * 2 + 1];
            const float mean = a * (1.0f / 1024.0f), var = fmaxf(b2 * (1.0f / 1024.0f) - mean * mean, 0.f);
            const float y = bf2f(out[(size_t)(t0 + t) * 1024 + c]);
            const float yn = (y - mean) * rsqrtf(var + 1e-5f) * g + bb;
            out[(size_t)(t0 + t) * 1024 + c] = f2bf(siluf_(yn));
        }
    }
}

constexpr int NSEG = 4, SEGLEN = SEQ / NSEG;
constexpr int SCAN_BUF = 5 * 1024 + 512;
constexpr size_t OFF_FS = 497 * MiB;
static_assert((size_t)NB * 16 * NSEG * 2 * 4096 * 4 <= 15 * MiB, "segment state region");
DI float row8_sum(float x) { x += dpp_f<0xB1>(x); x += dpp_f<0x4E>(x); x += dpp_f<0x141>(x); return x; }
enum { SCAN_PASS1 = 0, SCAN_PASS1_DATA = 1, SCAN_FINAL = 2 };
struct StepVec { f32x2 w[4], a[4], b[4], k[4], r[4]; float v; };
DI f32x2 v2lo(f32x4 v) { return __builtin_shufflevector(v, v, 0, 1); }
DI f32x2 v2hi(f32x4 v) { return __builtin_shufflevector(v, v, 2, 3); }
DI void ld4pairs(const float* q, f32x2 (&d)[4]) { const f32x4 x = *(const f32x4*)q, y = *(const f32x4*)(q + 4); d[0] = v2lo(x); d[1] = v2hi(x); d[2] = v2lo(y); d[3] = v2hi(y); }

template <int MODE>
DI void scan_block(const Params& p, int l, int b, int hh, int seg, int half, char* lds) {
    const int tid = threadIdx.x;
    const int il = tid >> 3, cgp = tid & 7;
    const int ts = tid >> 4, jg = tid & 15;
    float* bufs = (float*)lds;
    float* ybuf = bufs + 2 * SCAN_BUF;
    const bf16_t* ZR = (const bf16_t*)(p.ws + OFF_ZR);
    const bf16_t* Ab = (const bf16_t*)(p.ws + OFF_A);
    const bf16_t* Lb = (const bf16_t*)(p.ws + OFF_LW);
    bf16_t* YS = (bf16_t*)(p.ws + OFF_YS);
    float* FS = (float*)(p.ws + OFF_FS) + (size_t)((b * 16 + hh) * NSEG) * 2 * 4096;
    const float* mu = (const float*)p.in[I_MU] + (size_t)l * RWKV_LD;
    const int ncol = hh * 64 + jg * 4;
    const f32x4 kkv = *(const f32x4*)((const float*)p.in[I_KK] + l * 1024 + ncol);
    const f32x4 kav = *(const f32x4*)((const float*)p.in[I_KA] + l * 1024 + ncol);
    const int tokb = b * SEQ + seg * SEGLEN;
    float rr[4], kk[4], vv[4]; u32x2 av, lv;
    auto stage_load = [&](int c) {
        const int tok = tokb + c * 16 + ts;
        if (MODE == SCAN_FINAL) zr_shift4(ZR, mu, tok, ncol, rr);
        zr_shift4(ZR, mu, tok, 1024 + ncol, kk);
        zr_shift4(ZR, mu, tok, 2048 + ncol, vv);
        av = *(const u32x2*)(Ab + (size_t)tok * 1024 + ncol); lv = *(const u32x2*)(Lb + (size_t)tok * 1024 + ncol);
    };
    auto stage_write = [&](float* buf) {
        float a[4], lw[4]; unpack4(av, a); unpack4(lv, lw);
        float kq[4], ss = 0.f;
#pragma unroll
        for (int e = 0; e < 4; ++e) { kq[e] = kk[e] * kkv[e]; ss += kq[e] * kq[e]; }
        ss = row16_sum(ss);
        const float inv = 1.0f / fmaxf(sqrtf(ss), 1e-12f);
        f32x4 W4, K4, A4, B4, R4;
#pragma unroll
        for (int e = 0; e < 4; ++e) {
            const float kf = kq[e] * inv;
            W4[e] = __expf(lw[e]); K4[e] = kk[e] * (1.0f + (a[e] - 1.0f) * kav[e]); A4[e] = -kf; B4[e] = kf * a[e]; R4[e] = MODE == SCAN_FINAL ? rr[e] : 0.f;
        }
        float* bp = buf + ts * 64 + jg * 4;
        *(f32x4*)(bp) = W4; *(f32x4*)(bp + 1024) = K4; *(f32x4*)(bp + 2048) = A4; *(f32x4*)(bp + 3072) = B4;
        if ((jg >> 3) == half) *(f32x4*)(buf + 5120 + ts * 32 + (jg & 7) * 4) = (f32x4){vv[0], vv[1], vv[2], vv[3]};
        if (MODE == SCAN_FINAL) *(f32x4*)(bp + 4096) = R4;
    };
    f32x2 S[4], P[4];
#pragma unroll
    for (int q = 0; q < 4; ++q) {
        S[q] = (f32x2){0.f, 0.f};
        P[q] = (f32x2){((half * 32 + il) == cgp * 8 + 2 * q) ? 1.0f : 0.f, ((half * 32 + il) == cgp * 8 + 2 * q + 1) ? 1.0f : 0.f};
    }
    __syncthreads();
    if (MODE == SCAN_FINAL && seg > 0) {
        float* srow = (float*)lds;
        for (int q = 0; q < seg; ++q) {
            const float* Zq = FS + (size_t)(q * 2 + 0) * 4096 + (size_t)(half * 32 + il) * 64 + cgp * 8;
            const float* Pq = FS + (size_t)(q * 2 + 1) * 4096 + cgp * 8;
            *(f32x4*)(srow + il * 64 + cgp * 8) = (f32x4){S[0].x, S[0].y, S[1].x, S[1].y};
            *(f32x4*)(srow + il * 64 + cgp * 8 + 4) = (f32x4){S[2].x, S[2].y, S[3].x, S[3].y};
            __syncthreads();
            f32x4 n0 = *(const f32x4*)Zq, n1 = *(const f32x4*)(Zq + 4);
            if (q > 0)
#pragma unroll 4
            for (int m = 0; m < 64; ++m) {
                const float sm = srow[il * 64 + m];
                n0 += sm * *(const f32x4*)(Pq + (size_t)m * 64); n1 += sm * *(const f32x4*)(Pq + (size_t)m * 64 + 4);
            }
            __syncthreads();
            S[0] = v2lo(n0); S[1] = v2hi(n0); S[2] = v2lo(n1); S[3] = v2hi(n1);
        }
    }
    stage_load(0); stage_write(bufs);
    __syncthreads();
    constexpr int NCH = SEGLEN / 16;
    for (int c = 0; c < NCH; ++c) {
        const float* buf = bufs + (c & 1) * SCAN_BUF;
        float* yb = ybuf + (c & 1) * 512;
        if (MODE == SCAN_FINAL && c > 0) {
            const float* yp = ybuf + ((c - 1) & 1) * 512;
#pragma unroll
            for (int q = 0; q < 2; ++q) { const int idx = tid + 256 * q; YS[(size_t)(tokb + (c - 1) * 16 + (idx >> 5)) * 1024 + hh * 64 + half * 32 + (idx & 31)] = f2bf(yp[idx]); }
        }
        if (c + 1 < NCH) stage_load(c + 1);
        float ykeep0 = 0.f, ykeep1 = 0.f;
        auto ldstep = [&](int t, StepVec& sv) {
            const float* bp = buf + t * 64 + cgp * 8;
            ld4pairs(bp, sv.w); ld4pairs(bp + 1024, sv.k); ld4pairs(bp + 2048, sv.a); ld4pairs(bp + 3072, sv.b);
            if (MODE == SCAN_FINAL) ld4pairs(bp + 4096, sv.r);
            sv.v = buf[5120 + t * 32 + il];
        };
        StepVec sv[2];
        ldstep(0, sv[0]);
#pragma unroll 2
        for (int t = 0; t < 16; ++t) {
            ldstep(t + 1, sv[(t + 1) & 1]);
            const StepVec& x = sv[t & 1];
            f32x2 d2 = S[0] * x.a[0]; d2 = S[1] * x.a[1] + d2; d2 = S[2] * x.a[2] + d2; d2 = S[3] * x.a[3] + d2;
            float sa = d2.x + d2.y;
            const f32x2 vv2 = (f32x2){x.v, x.v};
            f32x2 tq[4];
#pragma unroll
            for (int e = 0; e < 4; ++e) tq[e] = S[e] * x.w[e] + vv2 * x.k[e];
            sa = row8_sum(sa);
            const f32x2 sa2 = (f32x2){sa, sa};
#pragma unroll
            for (int e = 0; e < 4; ++e) S[e] = tq[e] + sa2 * x.b[e];
            if (MODE == SCAN_PASS1) {
                f32x2 e2 = P[0] * x.a[0]; e2 = P[1] * x.a[1] + e2; e2 = P[2] * x.a[2] + e2; e2 = P[3] * x.a[3] + e2;
                float pa = e2.x + e2.y;
                f32x2 pq[4];
#pragma unroll
                for (int e = 0; e < 4; ++e) pq[e] = P[e] * x.w[e];
                pa = row8_sum(pa);
                const f32x2 pa2 = (f32x2){pa, pa};
#pragma unroll
                for (int e = 0; e < 4; ++e) P[e] = pq[e] + pa2 * x.b[e];
            }
            if (MODE == SCAN_FINAL) {
                f32x2 y2 = S[0] * x.r[0]; y2 = S[1] * x.r[1] + y2; y2 = S[2] * x.r[2] + y2; y2 = S[3] * x.r[3] + y2;
                float y = y2.x + y2.y;
                y = row8_sum(y);
                if (cgp == (t & 7)) { if (t < 8) ykeep0 = y; else ykeep1 = y; }
            }
            __builtin_amdgcn_sched_barrier(0);
        }
        if (MODE == SCAN_FINAL) { yb[cgp * 32 + il] = ykeep0; yb[(cgp + 8) * 32 + il] = ykeep1; }
        if (c + 1 < NCH) stage_write(bufs + ((c + 1) & 1) * SCAN_BUF);
        __syncthreads();
    }
    if (MODE == SCAN_FINAL) {
        const float* yp = ybuf + ((NCH - 1) & 1) * 512;
#pragma unroll
        for (int q = 0; q < 2; ++q) { const int idx = tid + 256 * q; YS[(size_t)(tokb + (NCH - 1) * 16 + (idx >> 5)) * 1024 + hh * 64 + half * 32 + (idx & 31)] = f2bf(yp[idx]); }
    } else {
        float* dz = FS + (size_t)(seg * 2 + 0) * 4096 + (size_t)(half * 32 + il) * 64 + cgp * 8;
        *(f32x4*)dz = (f32x4){S[0].x, S[0].y, S[1].x, S[1].y}; *(f32x4*)(dz + 4) = (f32x4){S[2].x, S[2].y, S[3].x, S[3].y};
        if (MODE == SCAN_PASS1) {
            float* dp = FS + (size_t)(seg * 2 + 1) * 4096 + (size_t)(half * 32 + il) * 64 + cgp * 8;
            *(f32x4*)dp = (f32x4){P[0].x, P[0].y, P[1].x, P[1].y}; *(f32x4*)(dp + 4) = (f32x4){P[2].x, P[2].y, P[3].x, P[3].y};
        }
    }
}
constexpr int N_SCAN1 = 64 * (NSEG - 1), N_SCAN2 = 64 * NSEG;
DI void scan_item_pass1(const Params& p, int l, int it, char* lds) {
    const int half = it & 1, bh = (it >> 1) & 31, seg = (NSEG - 2) - (it >> 6);
    if (seg == 0) scan_block<SCAN_PASS1_DATA>(p, l, bh >> 4, bh & 15, seg, half, lds);
    else scan_block<SCAN_PASS1>(p, l, bh >> 4, bh & 15, seg, half, lds);
}
DI void scan_item_pass2(const Params& p, int l, int it, char* lds) {
    const int half = it & 1, bh = (it >> 1) & 31, seg = it >> 6;
    scan_block<SCAN_FINAL>(p, l, bh >> 4, bh & 15, seg, half, lds);
}

namespace cs {
constexpr int LDA = 72, LDB = 40;
constexpr int O_LW = 0;
constexpr int O_AT = O_LW + 4096;
constexpr int O_RT = O_AT + 16 * LDA * 2;
constexpr int O_BG = O_RT + 16 * LDA * 2;
constexpr int O_KG = O_BG + 16 * LDA * 2;
constexpr int O_BKT = O_KG + 16 * LDA * 2;
constexpr int O_UV = O_BKT + 64 * LDB * 2;
constexpr int O_XA = O_UV + 64 * LDB * 2;
constexpr int O_SA = O_XA + 64 * LDB * 2;
constexpr int O_ABB = O_SA + 64 * LDA * 2;
constexpr int O_AKB = O_ABB + 16 * 17 * 4 + 64;
constexpr int O_BRK = O_AKB + 16 * LDB * 2;
constexpr int O_TT = O_BRK + 16 * LDB * 2;
constexpr int O_G15 = O_TT + 64 * LDB * 2;
constexpr int O_END = O_G15 + 256;
static_assert(O_END <= 60000, "chunked-scan LDS map");
}
constexpr size_t OFF_TTG = 497 * MiB;
DI void scan_T_item(const Params& p, int l, int item, char* lds) {
    using namespace cs;
    const int tid = threadIdx.x, lane = tid & 63, wv = tid >> 6, fr = lane & 15, fq = lane >> 4;
    const int bh = item >> 7, grp = item & 127, b = bh >> 4, hh = bh & 15;
    const int ts = tid >> 4, jg = tid & 15;
    const bf16_t* ZR = (const bf16_t*)(p.ws + OFF_ZR);
    const bf16_t* Ab = (const bf16_t*)(p.ws + OFF_A);
    const bf16_t* Lb = (const bf16_t*)(p.ws + OFF_LW);
    const float* mu = (const float*)p.in[I_MU] + (size_t)l * RWKV_LD;
    const int ncol = hh * 64 + jg * 4;
    const f32x4 kkv = *(const f32x4*)((const float*)p.in[I_KK] + l * 1024 + ncol);
    float* sLW = (float*)lds;
    bf16_t* sA = (bf16_t*)(lds + 16384);
    bf16_t* sB = sA + 4 * 16 * LDA;
    float an[4][4], bn[4][4], lw[4][4];
    __syncthreads();
#pragma unroll
    for (int q = 0; q < 4; ++q) {
        const int tok = b * SEQ + (grp * 4 + q) * 16 + ts;
        float kk[4], a[4];
        zr_shift4(ZR, mu, tok, 1024 + ncol, kk);
        unpack4(*(const u32x2*)(Ab + (size_t)tok * 1024 + ncol), a);
        unpack4(*(const u32x2*)(Lb + (size_t)tok * 1024 + ncol), lw[q]);
        float kq[4], ss = 0.f;
#pragma unroll
        for (int e = 0; e < 4; ++e) { kq[e] = kk[e] * kkv[e]; ss += kq[e] * kq[e]; }
        ss = row16_sum(ss);
        const float inv = 1.0f / fmaxf(sqrtf(ss), 1e-12f);
#pragma unroll
        for (int e = 0; e < 4; ++e) { const float kf = kq[e] * inv; an[q][e] = -kf; bn[q][e] = kf * a[e]; }
        *(f32x4*)(sLW + (q * 16 + ts) * 64 + jg * 4) = (f32x4){lw[q][0], lw[q][1], lw[q][2], lw[q][3]};
    }
    __syncthreads();
#pragma unroll
    for (int q = 0; q < 4; ++q) {
        f32x4 pin = (f32x4){0.f, 0.f, 0.f, 0.f};
#pragma unroll
        for (int t = 0; t < 16; ++t) { const f32x4 x = *(const f32x4*)(sLW + (q * 16 + t) * 64 + jg * 4); if (t <= ts) pin += x; }
        float at4[4], bt4[4];
#pragma unroll
        for (int e = 0; e < 4; ++e) { at4[e] = an[q][e] * __expf(pin[e] - lw[q][e]); bt4[e] = bn[q][e] * __expf(-pin[e]); }
        *(u32x2*)(sA + (q * 16 + ts) * LDA + jg * 4) = pack4(at4[0], at4[1], at4[2], at4[3]);
        *(u32x2*)(sB + (q * 16 + ts) * LDA + jg * 4) = pack4(bt4[0], bt4[1], bt4[2], bt4[3]);
    }
    __syncthreads();
    f32x4 cg = (f32x4){0.f, 0.f, 0.f, 0.f};
#pragma unroll
    for (int ks = 0; ks < 2; ++ks) cg = MFMA16(*(const bf16x8*)(sB + (wv * 16 + fr) * LDA + ks * 32 + fq * 8), *(const bf16x8*)(sA + (wv * 16 + fr) * LDA + ks * 32 + fq * 8), cg);
#pragma unroll
    for (int r = 0; r < 4; ++r) if (fq * 4 + r >= fr) cg[r] = 0.f;
    float Tr[16];
#pragma unroll
    for (int sidx = 15; sidx >= 0; --sidx) {
        float acc = (sidx == fr) ? 1.0f : 0.f;
#pragma unroll
        for (int m = sidx + 1; m < 16; ++m) {
            const float asm_ = __int_as_float(__builtin_amdgcn_readlane(__float_as_int(cg[sidx & 3]), (sidx >> 2) * 16 + m));
            acc += asm_ * Tr[m];
        }
        Tr[sidx] = acc;
    }
    if (fq == 0) {
        bf16_t* dst = (bf16_t*)(p.ws + OFF_TTG) + ((size_t)(bh * 512 + grp * 4 + wv) * 16 + fr) * 16;
        u32x4 w0, w1;
        w0.x = pk2(Tr[0], Tr[1]); w0.y = pk2(Tr[2], Tr[3]); w0.z = pk2(Tr[4], Tr[5]); w0.w = pk2(Tr[6], Tr[7]);
        w1.x = pk2(Tr[8], Tr[9]); w1.y = pk2(Tr[10], Tr[11]); w1.z = pk2(Tr[12], Tr[13]); w1.w = pk2(Tr[14], Tr[15]);
        *(u32x4*)dst = w0; *(u32x4*)(dst + 8) = w1;
    }
}
constexpr int MSEG = 4, MCPS = (SEQ / 16) / MSEG;
constexpr size_t OFF_FS2 = 506 * MiB;
enum { MS_FINAL = 0, MS_DATA1 = 1, MS_IDENT = 2 };
template <int MODE>
DI void scan_mfma_block(const Params& p, int l, int b, int hh, int seg, char* lds) {
    using namespace cs;
    const int tid = threadIdx.x, lane = tid & 63, wv = tid >> 6, fr = lane & 15, fq = lane >> 4;
    const int ts = tid >> 4, jg = tid & 15;
    const bf16_t* ZR = (const bf16_t*)(p.ws + OFF_ZR);
    const bf16_t* Ab = (const bf16_t*)(p.ws + OFF_A);
    const bf16_t* Lb = (const bf16_t*)(p.ws + OFF_LW);
    const bf16_t* TTg = (const bf16_t*)(p.ws + OFF_TTG) + (size_t)((b * 16 + hh) * 512) * 256;
    bf16_t* YS = (bf16_t*)(p.ws + OFF_YS);
    const float* mu = (const float*)p.in[I_MU] + (size_t)l * RWKV_LD;
    const int ncol = hh * 64 + jg * 4;
    const f32x4 kkv = *(const f32x4*)((const float*)p.in[I_KK] + l * 1024 + ncol);
    const f32x4 kav = *(const f32x4*)((const float*)p.in[I_KA] + l * 1024 + ncol);
    float* sLW = (float*)(lds + O_LW);
    bf16_t* sAT = (bf16_t*)(lds + O_AT); bf16_t* sRT = (bf16_t*)(lds + O_RT); bf16_t* sBG = (bf16_t*)(lds + O_BG); bf16_t* sKG = (bf16_t*)(lds + O_KG);
    bf16_t* sBKT = (bf16_t*)(lds + O_BKT);
    bf16_t* sUV = (bf16_t*)(lds + O_UV) + wv * 16 * LDB; bf16_t* sXA = (bf16_t*)(lds + O_XA) + wv * 16 * LDB; bf16_t* sSA = (bf16_t*)(lds + O_SA) + wv * 16 * LDA;
    bf16_t* sAKB = (bf16_t*)(lds + O_AKB); bf16_t* sBRK = (bf16_t*)(lds + O_BRK);
    float* sG15 = (float*)(lds + O_G15);
    __syncthreads();
    for (int i = tid; i < O_END / 4; i += NTHREADS) ((unsigned*)lds)[i] = 0u;
    f32x4 S[4];
#pragma unroll
    for (int cb = 0; cb < 4; ++cb)
#pragma unroll
        for (int r = 0; r < 4; ++r) S[cb][r] = (MODE == MS_IDENT && (wv * 16 + fq * 4 + r) == (cb * 16 + fr)) ? 1.0f : 0.f;
    float* FS = (float*)(p.ws + OFF_FS2) + (size_t)((b * 16 + hh) * MSEG) * 2 * 4096;
    if (MODE == MS_FINAL && seg > 0) {
        float* sS = (float*)lds + wv * 1024;
        for (int q = 0; q < seg; ++q) {
            const float* Zq = FS + (size_t)(q * 2 + 0) * 4096;
            const float* Pq = FS + (size_t)(q * 2 + 1) * 4096;
            f32x4 nw[4];
#pragma unroll
            for (int cb = 0; cb < 4; ++cb)
#pragma unroll
                for (int r = 0; r < 4; ++r) nw[cb][r] = Zq[(size_t)(wv * 16 + fq * 4 + r) * 64 + cb * 16 + fr];
            if (q > 0) {
                __syncthreads();
#pragma unroll
                for (int cb = 0; cb < 4; ++cb)
#pragma unroll
                    for (int r = 0; r < 4; ++r) sS[(fq * 4 + r) * 64 + cb * 16 + fr] = S[cb][r];
                __syncthreads();
#pragma unroll 1
                for (int m = 0; m < 64; ++m) {
                    const float p0 = Pq[m * 64 + fr], p1 = Pq[m * 64 + 16 + fr], p2 = Pq[m * 64 + 32 + fr], p3 = Pq[m * 64 + 48 + fr];
#pragma unroll
                    for (int r = 0; r < 4; ++r) { const float sm = sS[(fq * 4 + r) * 64 + m]; nw[0][r] += sm * p0; nw[1][r] += sm * p1; nw[2][r] += sm * p2; nw[3][r] += sm * p3; }
                }
            }
#pragma unroll
            for (int cb = 0; cb < 4; ++cb) S[cb] = nw[cb];
        }
        __syncthreads();
        for (int i = tid; i < 4096; i += NTHREADS) ((unsigned*)lds)[i] = 0u;
        __syncthreads();
#pragma unroll
        for (int cb = 0; cb < 4; ++cb)
#pragma unroll
            for (int r = 0; r < 4; ++r) sSA[(fq * 4 + r) * LDA + cb * 16 + fr] = f2bf(S[cb][r]);
    } else if (MODE == MS_IDENT) {
        __syncthreads();
#pragma unroll
        for (int cb = 0; cb < 4; ++cb)
#pragma unroll
            for (int r = 0; r < 4; ++r) sSA[(fq * 4 + r) * LDA + cb * 16 + fr] = f2bf(S[cb][r]);
    }
    const int tokb = b * SEQ + seg * MCPS * 16;
    float rr[4], kk[4], vv[4]; u32x2 av, lv; u32x4 tq;
    auto stage_load = [&](int c) {
        const int tok = tokb + c * 16 + ts;
        zr_shift4(ZR, mu, tok, ncol, rr); zr_shift4(ZR, mu, tok, 1024 + ncol, kk); zr_shift4(ZR, mu, tok, 2048 + ncol, vv);
        av = *(const u32x2*)(Ab + (size_t)tok * 1024 + ncol); lv = *(const u32x2*)(Lb + (size_t)tok * 1024 + ncol);
        tq = *(const u32x4*)(TTg + (size_t)(seg * MCPS + c) * 256 + fr * 16 + (fq & 1) * 8);
    };
    stage_load(0);
    for (int c = 0; c < MCPS; ++c) {
        float a[4], lw[4]; unpack4(av, a); unpack4(lv, lw);
        float kq[4], ss = 0.f;
#pragma unroll
        for (int e = 0; e < 4; ++e) { kq[e] = kk[e] * kkv[e]; ss += kq[e] * kq[e]; }
        ss = row16_sum(ss);
        const float inv = 1.0f / fmaxf(sqrtf(ss), 1e-12f);
        float kn[4], an[4], bn[4], rn[4], vn[4];
#pragma unroll
        for (int e = 0; e < 4; ++e) { const float kf = kq[e] * inv; kn[e] = kk[e] * (1.0f + (a[e] - 1.0f) * kav[e]); an[e] = -kf; bn[e] = kf * a[e]; rn[e] = rr[e]; vn[e] = vv[e]; }
        const bf16x8 tfrag = fq < 2 ? __builtin_bit_cast(bf16x8, tq) : (bf16x8){0, 0, 0, 0, 0, 0, 0, 0};
        *(f32x4*)(sLW + ts * 64 + jg * 4) = (f32x4){lw[0], lw[1], lw[2], lw[3]};
        if (c + 1 < MCPS) stage_load(c + 1);
        __syncthreads();
        f32x4 pin = (f32x4){0.f, 0.f, 0.f, 0.f}, pall = pin;
#pragma unroll
        for (int t = 0; t < 16; ++t) { const f32x4 x = *(const f32x4*)(sLW + t * 64 + jg * 4); pall += x; if (t <= ts) pin += x; }
        {
            float at4[4], rt4[4], bt4[4], kt4[4];
#pragma unroll
            for (int e = 0; e < 4; ++e) {
                const float g = __expf(pin[e]), gp = __expf(pin[e] - lw[e]), gi = __expf(-pin[e]);
                at4[e] = an[e] * gp; rt4[e] = rn[e] * g; bt4[e] = bn[e] * gi; kt4[e] = kn[e] * gi;
            }
            *(u32x2*)(sAT + ts * LDA + jg * 4) = pack4(at4[0], at4[1], at4[2], at4[3]);
            *(u32x2*)(sRT + ts * LDA + jg * 4) = pack4(rt4[0], rt4[1], rt4[2], rt4[3]);
            *(u32x2*)(sBG + ts * LDA + jg * 4) = pack4(bt4[0], bt4[1], bt4[2], bt4[3]);
            *(u32x2*)(sKG + ts * LDA + jg * 4) = pack4(kt4[0], kt4[1], kt4[2], kt4[3]);
#pragma unroll
            for (int e = 0; e < 4; ++e) {
                sBKT[(jg * 4 + e) * LDB + ts] = f2bf(bt4[e]); sBKT[(jg * 4 + e) * LDB + 16 + ts] = f2bf(kt4[e]);
                if (MODE != MS_IDENT) ((bf16_t*)(lds + O_UV))[((jg >> 2) * 16 + (jg & 3) * 4 + e) * LDB + 16 + ts] = f2bf(vn[e]);
            }
            if (ts == 15) *(f32x4*)(sG15 + jg * 4) = (f32x4){__expf(pall[0]), __expf(pall[1]), __expf(pall[2]), __expf(pall[3])};
        }
        __syncthreads();
        if (wv != 0) {
            const bf16_t* P = (wv & 1) ? sKG : sBG;
            const bf16_t* Q = (wv & 2) ? sRT : sAT;
            f32x4 cg = (f32x4){0.f, 0.f, 0.f, 0.f};
#pragma unroll
            for (int ks = 0; ks < 2; ++ks) cg = MFMA16(*(const bf16x8*)(P + fr * LDA + ks * 32 + fq * 8), *(const bf16x8*)(Q + fr * LDA + ks * 32 + fq * 8), cg);
#pragma unroll
            for (int r = 0; r < 4; ++r) { const int sidx = fq * 4 + r; const bool keep = (wv & 2) ? (sidx <= fr) : (sidx < fr); if (!keep) cg[r] = 0.f; }
            if (wv == 1) *(u32x2*)(sAKB + fr * LDB + 16 + fq * 4) = pack4(cg[0], cg[1], cg[2], cg[3]);
            else if (wv == 2) *(u32x2*)(sBRK + fr * LDB + fq * 4) = pack4(cg[0], cg[1], cg[2], cg[3]);
            else *(u32x2*)(sBRK + fr * LDB + 16 + fq * 4) = pack4(cg[0], cg[1], cg[2], cg[3]);
        }
        __syncthreads();
        f32x4 x1 = (f32x4){0.f, 0.f, 0.f, 0.f}, yv = x1;
        {
            const bf16x8 s0 = *(const bf16x8*)(sSA + fr * LDA + fq * 8), s1 = *(const bf16x8*)(sSA + fr * LDA + 32 + fq * 8);
            const bf16x8 uv = *(const bf16x8*)(sUV + fr * LDB + fq * 8);
            x1 = MFMA16(s0, *(const bf16x8*)(sAT + fr * LDA + fq * 8), x1);
            x1 = MFMA16(s1, *(const bf16x8*)(sAT + fr * LDA + 32 + fq * 8), x1);
            x1 = MFMA16(uv, *(const bf16x8*)(sAKB + fr * LDB + fq * 8), x1);
            yv = MFMA16(s0, *(const bf16x8*)(sRT + fr * LDA + fq * 8), yv);
            yv = MFMA16(s1, *(const bf16x8*)(sRT + fr * LDA + 32 + fq * 8), yv);
        }
#pragma unroll
        for (int r = 0; r < 4; ++r) sXA[(fq * 4 + r) * LDB + fr] = f2bf(x1[r]);
        asm volatile("s_waitcnt lgkmcnt(0)" ::: "memory");
        f32x4 u = (f32x4){0.f, 0.f, 0.f, 0.f};
        u = MFMA16(*(const bf16x8*)(sXA + fr * LDB + fq * 8), tfrag, u);
#pragma unroll
        for (int r = 0; r < 4; ++r) sUV[(fq * 4 + r) * LDB + fr] = f2bf(u[r]);
        asm volatile("s_waitcnt lgkmcnt(0)" ::: "memory");
        {
            const bf16x8 uv = *(const bf16x8*)(sUV + fr * LDB + fq * 8);
            yv = MFMA16(uv, *(const bf16x8*)(sBRK + fr * LDB + fq * 8), yv);
#pragma unroll
            for (int cb = 0; cb < 4; ++cb) S[cb] = MFMA16(uv, *(const bf16x8*)(sBKT + (cb * 16 + fr) * LDB + fq * 8), S[cb]);
        }
        if (MODE == MS_FINAL) *(u32x2*)(YS + (size_t)(tokb + c * 16 + fr) * 1024 + hh * 64 + wv * 16 + fq * 4) = pack4(yv[0], yv[1], yv[2], yv[3]);
#pragma unroll
        for (int cb = 0; cb < 4; ++cb) {
            const float g15 = sG15[cb * 16 + fr];
#pragma unroll
            for (int r = 0; r < 4; ++r) { S[cb][r] *= g15; sSA[(fq * 4 + r) * LDA + cb * 16 + fr] = f2bf(S[cb][r]); }
        }
    }
    if (MODE != MS_FINAL) {
        float* dst = FS + (size_t)(seg * 2 + (MODE == MS_IDENT ? 1 : 0)) * 4096;
#pragma unroll
        for (int cb = 0; cb < 4; ++cb)
#pragma unroll
            for (int r = 0; r < 4; ++r) dst[(size_t)(wv * 16 + fq * 4 + r) * 64 + cb * 16 + fr] = S[cb][r];
    }
}
constexpr int N_MS1 = 32 * (1 + 2 * (MSEG - 2)), N_MS2 = 32 * MSEG;
DI void ms_item_pass1(const Params& p, int l, int it, char* lds) {
    const int bh = it & 31, k = it >> 5;
    if (k & 1) scan_mfma_block<MS_IDENT>(p, l, bh >> 4, bh & 15, (k + 1) >> 1, lds);
    else scan_mfma_block<MS_DATA1>(p, l, bh >> 4, bh & 15, k >> 1, lds);
}
DI void ms_item_pass2(const Params& p, int l, int it, char* lds) {
    const int bh = it & 31, seg = it >> 5;
    scan_mfma_block<MS_FINAL>(p, l, bh >> 4, bh & 15, seg, lds);
}

constexpr int ATT_LDK = 72;
DI void attn_unit(const Params& p, int l, int unit, char* lds) {
    const int tid = threadIdx.x, lane = tid & 63, wid = tid >> 6, c = wid >> 1, qs = wid & 1, r32 = lane & 31, h = lane >> 5;
    const int qb = 127 - (unit >> 4), bh = unit & 15, hh = bh & 7, b = bh >> 3;
    const bf16_t* Qg = (const bf16_t*)(p.ws + OFF_Q);
    const bf16_t* Kg = (const bf16_t*)(p.ws + OFF_K);
    const bf16_t* VTg = (const bf16_t*)(p.ws + OFF_VT) + (size_t)bh * 128 * 8192;
    const int query = qb * 64 + qs * 32 + r32;
    bf16x8 qf[4];
#pragma unroll
    for (int ks = 0; ks < 4; ++ks) qf[ks] = *(const bf16x8*)(Qg + ((size_t)(bh * 2 + c) * SEQ + query) * 64 + ks * 16 + h * 8);
    auto issue = [&](int kt) {
        char* st = lds + (kt & 1) * 32768 + tid * 16;
#pragma unroll
        for (int i = 0; i < 4; ++i) {
            const int bb = tid * 16 + i * 4096, cm = bb >> 13, row = (bb >> 7) & 63, kc = ((bb >> 4) & 7) ^ ((row >> 1) & 7);
            __builtin_amdgcn_global_load_lds((const unsigned*)(Kg + ((size_t)(bh * 2 + cm) * SEQ + kt * 64 + row) * 64 + kc * 8), (LDSP unsigned*)(st + i * 4096), 16, 0, 0);
            __builtin_amdgcn_global_load_lds((const unsigned*)(VTg + (size_t)kt * 8192 + (tid + 256 * i) * 8), (LDSP unsigned*)(st + 16384 + i * 4096), 16, 0, 0);
        }
    };
    f32x16 O[4];
#pragma unroll
    for (int d = 0; d < 4; ++d)
#pragma unroll
        for (int e = 0; e < 16; ++e) O[d][e] = 0.f;
    float m_run = -INFINITY, lsum = 0.f;
    const int kswz = (r32 >> 1) & 7;
    issue(0);
    for (int kt = 0; kt <= qb; ++kt) {
        asm volatile("s_waitcnt vmcnt(0)" ::: "memory");
        __syncthreads();
        if (kt < qb) issue(kt + 1);
        const char* sKb = lds + (kt & 1) * 32768;
        const bf16_t* sVT = (const bf16_t*)(sKb + 16384);
        f32x16 st[2];
#pragma unroll
        for (int kb = 0; kb < 2; ++kb) {
#pragma unroll
            for (int e = 0; e < 16; ++e) st[kb][e] = 0.f;
#pragma unroll
            for (int ks = 0; ks < 4; ++ks) {
                const bf16x8 kf = *(const bf16x8*)(sKb + (c * 64 + kb * 32 + r32) * 128 + (((ks * 2 + h) ^ kswz) << 4));
                st[kb] = MFMA32(kf, qf[ks], st[kb]);
            }
        }
        if (kt == qb) {
            const int ql = qs * 32 + r32;
#pragma unroll
            for (int kb = 0; kb < 2; ++kb)
#pragma unroll
                for (int e = 0; e < 16; ++e) { const int keyl = kb * 32 + (e & 3) + 8 * (e >> 2) + 4 * h; if (keyl > ql) st[kb][e] = -INFINITY; }
        }
        float mx = st[0][0];
#pragma unroll
        for (int kb = 0; kb < 2; ++kb)
#pragma unroll
            for (int e = 0; e < 16; ++e) mx = fmaxf(mx, st[kb][e]);
        mx = fmaxf(mx, __shfl_xor(mx, 32));
        if (__any(mx > m_run + 8.0f)) {
            const float mnew = fmaxf(m_run, mx);
            const float alpha = __builtin_amdgcn_exp2f(m_run - mnew);
            m_run = mnew;
            lsum *= alpha;
#pragma unroll
            for (int d = 0; d < 4; ++d)
#pragma unroll
                for (int e = 0; e < 16; ++e) O[d][e] *= alpha;
        }
        float ps = 0.f;
#pragma unroll
        for (int kb = 0; kb < 2; ++kb)
#pragma unroll
            for (int e = 0; e < 16; ++e) { st[kb][e] = __builtin_amdgcn_exp2f(st[kb][e] - m_run); ps += st[kb][e]; }
        lsum += ps;
        bf16x8 pf[2][2];
#pragma unroll
        for (int kb = 0; kb < 2; ++kb)
#pragma unroll
            for (int s = 0; s < 2; ++s) {
                u32x4 pk;
                pk.x = pk2(st[kb][8 * s + 0], st[kb][8 * s + 1]); pk.y = pk2(st[kb][8 * s + 2], st[kb][8 * s + 3]);
                pk.z = pk2(st[kb][8 * s + 4], st[kb][8 * s + 5]); pk.w = pk2(st[kb][8 * s + 6], st[kb][8 * s + 7]);
                pf[kb][s] = __builtin_bit_cast(bf16x8, pk);
            }
#pragma unroll
        for (int d = 0; d < 4; ++d)
#pragma unroll
            for (int kb = 0; kb < 2; ++kb)
#pragma unroll
                for (int s = 0; s < 2; ++s) {
                    const bf16x8 vf = *(const bf16x8*)(sVT + (((d * 2 + kb) * 2 + s) * 64 + lane) * 8);
                    O[d] = MFMA32(vf, pf[kb][s], O[d]);
                }
    }
    const float ltot = lsum + __shfl_xor(lsum, 32);
    const float inv = 1.0f / ltot;
    float* xo = (float*)lds;
    __syncthreads();
    if (c == 1) {
#pragma unroll
        for (int d = 0; d < 4; ++d)
#pragma unroll
            for (int e = 0; e < 16; ++e) xo[(qs * 64 + d * 16 + e) * 64 + lane] = O[d][e] * inv;
    }
    __syncthreads();
    if (c == 0) {
        const float lam = ((const float*)(p.ws + OFF_CTRL + CT_LAM))[l];
        const float lam_init = 0.8f - 0.6f * expf(-0.3f * (float)l);
        float ss = 0.f;
#pragma unroll
        for (int d = 0; d < 4; ++d)
#pragma unroll
            for (int e = 0; e < 16; ++e) { const float o = O[d][e] * inv - lam * xo[(qs * 64 + d * 16 + e) * 64 + lane]; O[d][e] = o; ss += o * o; }
        ss += __shfl_xor(ss, 32);
        const float rstd = rsqrtf(ss * (1.0f / 128.0f) + 1e-6f) * (1.0f - lam_init);
        bf16_t* outp = (bf16_t*)(p.ws + OFF_ATTP) + (size_t)(b * SEQ + query) * 1024 + hh * 128;
        const float* hg = (const float*)p.in[I_AHG] + (size_t)(l * 8 + hh) * 128;
#pragma unroll
        for (int d = 0; d < 4; ++d)
#pragma unroll
            for (int g4 = 0; g4 < 4; ++g4) {
                const int dv0 = d * 32 + 8 * g4 + 4 * h;
                const f32x4 g = *(const f32x4*)(hg + dv0);
                *(u32x2*)(outp + dv0) = pack4(O[d][g4 * 4 + 0] * rstd * g[0], O[d][g4 * 4 + 1] * rstd * g[1], O[d][g4 * 4 + 2] * rstd * g[2], O[d][g4 * 4 + 3] * rstd * g[3]);
            }
    }
}

DI void rwkv_post_tile(const Params& p, int l, int tile, char* lds) {
    const int tid = threadIdx.x, t0 = tile * 16, n4 = tid * 4;
    const bf16_t* ZR = (const bf16_t*)(p.ws + OFF_ZR);
    const bf16_t* Ab = (const bf16_t*)(p.ws + OFF_A);
    const bf16_t* YS = (const bf16_t*)(p.ws + OFF_YS);
    const float* mu = (const float*)p.in[I_MU] + (size_t)l * RWKV_LD;
    float* sg = (float*)lds;
    __syncthreads();
    {
        const int tk = tid >> 4, c8 = (tid & 15) * 8;
        float z[8]; zr_shift8(ZR, mu, t0 + tk, 3200 + c8, z);
#pragma unroll
        for (int e = 0; e < 8; ++e) sg[tk * 128 + c8 + e] = sigmoidf_(z[e]);
    }
    __syncthreads();
    f32x4 gacc[16];
#pragma unroll
    for (int t = 0; t < 16; ++t) gacc[t] = (f32x4){0.f, 0.f, 0.f, 0.f};
    const float* g2 = (const float*)p.in[I_G2] + (size_t)l * 128 * 1024 + n4;
#pragma unroll 2
    for (int k = 0; k < 128; k += 4) {
        const f32x4 w0 = *(const f32x4*)(g2 + (size_t)(k + 0) * 1024), w1 = *(const f32x4*)(g2 + (size_t)(k + 1) * 1024),
                    w2 = *(const f32x4*)(g2 + (size_t)(k + 2) * 1024), w3 = *(const f32x4*)(g2 + (size_t)(k + 3) * 1024);
#pragma unroll
        for (int t = 0; t < 16; ++t) {
            const f32x4 a = *(const f32x4*)(sg + t * 128 + k);
            gacc[t] += a[0] * w0 + a[1] * w1 + a[2] * w2 + a[3] * w3;
        }
    }
    const f32x4 kav = *(const f32x4*)((const float*)p.in[I_KA] + l * 1024 + n4);
    const f32x4 rkv = *(const f32x4*)((const float*)p.in[I_RK] + l * 1024 + n4);
    const f32x4 gng = *(const f32x4*)((const float*)p.in[I_GNG] + l * 1024 + n4);
    const f32x4 gnb = *(const f32x4*)((const float*)p.in[I_GNB] + l * 1024 + n4);
    bf16_t* out = (bf16_t*)(p.ws + OFF_RWKVP);
#pragma unroll
    for (int t = 0; t < 16; ++t) {
        const int tok = t0 + t;
        float r[4], k[4], v[4], a[4], y[4];
        zr_shift4(ZR, mu, tok, n4, r); zr_shift4(ZR, mu, tok, 1024 + n4, k); zr_shift4(ZR, mu, tok, 2048 + n4, v);
        unpack4(*(const u32x2*)(Ab + (size_t)tok * 1024 + n4), a);
        unpack4(*(const u32x2*)(YS + (size_t)tok * 1024 + n4), y);
        float cf = 0.f, s1 = 0.f, s2 = 0.f;
#pragma unroll
        for (int e = 0; e < 4; ++e) { const float kn = k[e] * (1.0f + (a[e] - 1.0f) * kav[e]); cf += r[e] * kn * rkv[e]; s1 += y[e]; s2 += y[e] * y[e]; }
        cf = row16_sum(cf); s1 = row16_sum(s1); s2 = row16_sum(s2);
        const float mean = s1 * (1.0f / 64.0f), var = fmaxf(s2 * (1.0f / 64.0f) - mean * mean, 0.f), rstd = rsqrtf(var + 64e-5f);
        float o[4];
#pragma unroll
        for (int e = 0; e < 4; ++e) o[e] = ((y[e] - mean) * rstd * gng[e] + gnb[e] + cf * v[e]) * gacc[t][e];
        *(u32x2*)(out + (size_t)tok * 1024 + n4) = pack4(o[0], o[1], o[2], o[3]);
    }
}

DI void phaseF_tile(const Params& p, int mt, int nt, char* lds) {
    const int tid = threadIdx.x, lane = tid & 63, wid = tid >> 6, wm = wid >> 1, wn = wid & 1, fr = lane & 15, fq = lane >> 4;
    const int m0 = mt * 128 + wm * 64, nb = nt * 128 + wn * 64;
    const bf16_t* ZG = (const bf16_t*)(p.ws + OFF_ZG);
    f32x4 sum[4][4]; zero_acc(sum);
#pragma unroll 1
    for (int br = 0; br < 3; ++br) {
        const size_t xoff = br == 0 ? OFF_ATTP : br == 1 ? OFF_CONVP : OFF_RWKVP;
        const size_t woff = br == 0 ? W_ATTO : br == 1 ? W_CONVO : W_RWKVO;
        f32x4 acc[4][4]; zero_acc(acc);
        gemm_mainloop<false>(acc, (const bf16_t*)(p.ws + xoff) + (size_t)mt * 128 * 1024, 1024, (const bf16_t*)(p.ws + OFF_W + woff) + (size_t)nt * 128 * 1024, 1024, 1024, lds);
#pragma unroll
        for (int ti = 0; ti < 4; ++ti) {
            const int tok = m0 + ti * 16 + fr;
#pragma unroll
            for (int ni = 0; ni < 4; ++ni) {
                float g[4]; unpack4(*(const u32x2*)(ZG + (size_t)tok * ZG_LD + br * 1024 + nb + ni * 16 + fq * 4), g);
#pragma unroll
                for (int r = 0; r < 4; ++r) sum[ti][ni][r] += g[r] * acc[ti][ni][r];
            }
        }
    }
    bf16_t* out = (bf16_t*)(p.ws + OFF_MERGED);
#pragma unroll
    for (int ti = 0; ti < 4; ++ti) {
        const int tok = m0 + ti * 16 + fr;
#pragma unroll
        for (int ni = 0; ni < 4; ++ni)
            *(u32x2*)(out + (size_t)tok * 1024 + nb + ni * 16 + fq * 4) = pack4(sum[ti][ni][0], sum[ti][ni][1], sum[ti][ni][2], sum[ti][ni][3]);
    }
}
DI void phaseG_tile(const Params& p, int l, int mt, int nt, char* lds) {
    const int tid = threadIdx.x, lane = tid & 63, wid = tid >> 6, wm = wid >> 1, wn = wid & 1, fr = lane & 15, fq = lane >> 4;
    const int m0 = mt * 128 + wm * 64, nb = nt * 128 + wn * 64;
    f32x4 acc[4][4]; zero_acc(acc);
    gemm_mainloop<false>(acc, (const bf16_t*)(p.ws + OFF_MERGED) + (size_t)mt * 128 * 1024, 1024, (const bf16_t*)(p.ws + OFF_W + W_OUT) + (size_t)nt * 128 * 1024, 1024, 1024, lds);
    const float* xin = l == 0 ? (const float*)p.in[I_X] : p.out;
    const float* ada = (const float*)(p.ws + OFF_CTRL + CT_ADA) + (size_t)l * 2 * 6144;
#pragma unroll
    for (int ti = 0; ti < 4; ++ti) {
        const int tok = m0 + ti * 16 + fr, b = tok >> 13;
#pragma unroll
        for (int ni = 0; ni < 4; ++ni) {
            const int n = nb + ni * 16 + fq * 4;
            const f32x4 xv = *(const f32x4*)(xin + (size_t)tok * 1024 + n), gt = *(const f32x4*)(ada + b * 6144 + 2 * 1024 + n);
            *(f32x4*)(p.out + (size_t)tok * 1024 + n) = xv + (1.0f + gt) * acc[ti][ni];
        }
    }
}
DI void phaseI_tile(const Params& p, int mt, int nt, char* lds) {
    const int tid = threadIdx.x, lane = tid & 63, wid = tid >> 6, wm = wid >> 1, wn = wid & 1, fr = lane & 15, fq = lane >> 4;
    const int m0 = mt * 128 + wm * 64, nb = nt * 128 + wn * 64;
    f32x4 acc[4][4]; zero_acc(acc);
    gemm_mainloop<false>(acc, (const bf16_t*)(p.ws + OFF_H) + (size_t)mt * 128 * 1024, 1024, (const bf16_t*)(p.ws + OFF_W + W_QP) + (size_t)nt * 128 * 1024, 1024, 1024, lds);
    bf16_t* out = (bf16_t*)(p.ws + OFF_QP);
#pragma unroll
    for (int ti = 0; ti < 4; ++ti) {
        const int tok = m0 + ti * 16 + fr;
#pragma unroll
        for (int ni = 0; ni < 4; ++ni)
            *(u32x2*)(out + (size_t)tok * 2048 + nb + ni * 16 + fq * 4) = pack4(acc[ti][ni][0], acc[ti][ni][1], acc[ti][ni][2], acc[ti][ni][3]);
    }
}
DI void phaseJ_tile(const Params& p, int mt, int g, char* lds) {
    const int tid = threadIdx.x, lane = tid & 63, wid = tid >> 6, wm = wid >> 1, wn = wid & 1, fr = lane & 15, fq = lane >> 4;
    const int m0 = mt * 128 + wm * 64, nb = wn * 64;
    f32x4 acc[4][4]; zero_acc(acc);
    gemm_mainloop<true>(acc, (const bf16_t*)(p.ws + OFF_QP) + (size_t)mt * 128 * 2048 + g * 128, 2048, (const bf16_t*)(p.ws + OFF_W + ((g & 1) ? W_KEY2 : W_KEY1)), 128, 128, lds);
    float* out = (float*)(p.ws + OFF_SCORES);
#pragma unroll
    for (int ni = 0; ni < 4; ++ni) {
        const int n = nb + ni * 16 + fr;
#pragma unroll
        for (int ti = 0; ti < 4; ++ti) *(f32x4*)(out + (size_t)(g * 128 + n) * NT + m0 + ti * 16 + fq * 4) = acc[ti][ni];
    }
}

DI void ins16(float (&a)[16], float x) {
#pragma unroll
    for (int i = 0; i < 16; ++i) { const float t = fmaxf(a[i], x); x = fminf(a[i], x); a[i] = t; }
}
DI void topk_thread(const Params& p, int idx) {
    const int hd = idx >> 14, t = idx & (NT - 1);
    const float* s1 = (const float*)(p.ws + OFF_SCORES) + (size_t)(hd * 256) * NT + t;
    const float* s2 = s1 + (size_t)128 * NT;
    float a[16], b[16], c[16];
#pragma unroll
    for (int i = 0; i < 16; ++i) { a[i] = -INFINITY; b[i] = -INFINITY; c[i] = -INFINITY; }
#pragma unroll 8
    for (int n = 0; n < 128; ++n) {
        const float x1 = __uint_as_float((__float_as_uint(s1[(size_t)n * NT]) & 0xFFFFFF80u) | (unsigned)(127 - n));
        const float x2 = __uint_as_float((__float_as_uint(s2[(size_t)n * NT]) & 0xFFFFFF80u) | (unsigned)(127 - n));
        ins16(a, x1); ins16(b, x2);
    }
    float v1[16], v2[16]; int i1[16], i2[16];
#pragma unroll
    for (int i = 0; i < 16; ++i) {
        const unsigned ua = __float_as_uint(a[i]), ub = __float_as_uint(b[i]);
        v1[i] = __uint_as_float(ua & 0xFFFFFF80u); i1[i] = 127 - (int)(ua & 127u);
        v2[i] = __uint_as_float(ub & 0xFFFFFF80u); i2[i] = 127 - (int)(ub & 127u);
    }
#pragma unroll
    for (int i = 0; i < 16; ++i)
#pragma unroll
        for (int j = 0; j < 16; ++j)
            if ((i + 1) * (j + 1) <= 16) ins16(c, __uint_as_float((__float_as_uint(v1[i] + v2[j]) & 0xFFFFFF00u) | (unsigned)(255 - (i * 16 + j))));
    float tv[16]; int eid[16];
#pragma unroll
    for (int r = 0; r < 16; ++r) {
        const unsigned u = __float_as_uint(c[r]);
        tv[r] = __uint_as_float(u & 0xFFFFFF00u);
        const int flat = 255 - (int)(u & 255u), ii = flat >> 4, jj = flat & 15;
        int e1 = 0, e2 = 0;
#pragma unroll
        for (int i = 0; i < 16; ++i) { e1 = (ii == i) ? i1[i] : e1; e2 = (jj == i) ? i2[i] : e2; }
        eid[r] = e1 * 128 + e2;
    }
    float sm = 0.f;
    const float mx = tv[0];
#pragma unroll
    for (int r = 0; r < 16; ++r) { tv[r] = __expf(tv[r] - mx); sm += tv[r]; }
    const float inv = 1.0f / sm;
    int* ep = (int*)(p.ws + OFF_EID) + (size_t)t * 128 + hd * 16;
    float* gp = (float*)(p.ws + OFF_GATE) + (size_t)t * 128 + hd * 16;
#pragma unroll
    for (int q = 0; q < 4; ++q) {
        *(u32x4*)(ep + q * 4) = (u32x4){(unsigned)eid[q * 4], (unsigned)eid[q * 4 + 1], (unsigned)eid[q * 4 + 2], (unsigned)eid[q * 4 + 3]};
        *(f32x4*)(gp + q * 4) = (f32x4){tv[q * 4] * inv, tv[q * 4 + 1] * inv, tv[q * 4 + 2] * inv, tv[q * 4 + 3] * inv};
    }
}

DI void cvt_u8x4(unsigned w, float (&f)[4]) { f[0] = (float)(w & 255u); f[1] = (float)((w >> 8) & 255u); f[2] = (float)((w >> 16) & 255u); f[3] = (float)(w >> 24); }
DI float gelu_zs(float v) {
    const float av = fabsf(v), t = __builtin_amdgcn_rcpf(av * 0.2316418882f + 1.0f);
    float q = t * 0.5307027145f + (-0.7265760135f); q = q * t + 0.7107068705f; q = q * t + (-0.142248368f); q = q * t + 0.127414796f; q = q * t;
    const float e = __builtin_amdgcn_exp2f(v * v * (-0.72134752044f));
    const float m = v * (q * e);
    return v < 0.f ? m : v - m;
}
DI void peer_token(const Params& p, int l, int t) {
    const int lane = threadIdx.x & 63, b = t >> 13;
    const unsigned char* U = (const unsigned char*)(p.ws + OFF_PU8);
    const unsigned char* V = (const unsigned char*)(p.ws + OFF_PV8);
    const float* SU = (const float*)(p.ws + OFF_PSU);
    const float* SV = (const float*)(p.ws + OFF_PSV);
    bf16_t* H = (bf16_t*)(p.ws + OFF_H);
    int hq[4]; float sh;
    {
        float hv[16]; float f[8];
        unpack8(*(const u32x4*)(H + (size_t)t * 1024 + lane * 16), f); for (int e = 0; e < 8; ++e) hv[e] = f[e];
        unpack8(*(const u32x4*)(H + (size_t)t * 1024 + lane * 16 + 8), f); for (int e = 0; e < 8; ++e) hv[8 + e] = f[e];
        float am = 0.f;
#pragma unroll
        for (int e = 0; e < 16; ++e) am = fmaxf(am, fabsf(hv[e]));
        am = wave_max(am);
        sh = am > 0.f ? am * (1.0f / 127.0f) : 1.0f;
        const float ish = am > 0.f ? 127.0f / am : 0.f;
#pragma unroll
        for (int q = 0; q < 4; ++q) {
            unsigned w = 0;
#pragma unroll
            for (int e = 0; e < 4; ++e) w |= ((unsigned)(int)rintf(hv[q * 4 + e] * ish) & 255u) << (8 * e);
            hq[q] = (int)w;
        }
    }
    const int* eidp = (const int*)(p.ws + OFF_EID) + (size_t)t * 128;
    const float* gatep = (const float*)(p.ws + OFF_GATE) + (size_t)t * 128;
    const int id0 = eidp[lane], id1 = eidp[64 + lane];
    const float g0 = gatep[lane], g1 = gatep[64 + lane];
    const float su0 = SU[id0] * sh, su1 = SU[id1] * sh, gs0 = g0 * SV[id0], gs1 = g1 * SV[id1];
    float acc[16], csum = 0.f;
#pragma unroll
    for (int e = 0; e < 16; ++e) acc[e] = 0.f;
    const int eidx = lane >> 3;
    const bool hi32 = (lane & 32) != 0, hi16 = (lane & 16) != 0, hi8 = (lane & 8) != 0;
#pragma unroll 1
    for (int g = 0; g < 16; ++g) {
        const int jbase = (g & 7) * 8;
        const int idr = (g & 8) ? id1 : id0; const float sur = (g & 8) ? su1 : su0, gsr = (g & 8) ? gs1 : gs0;
        u32x4 uq[8], vq[8];
#pragma unroll
        for (int e = 0; e < 8; ++e) {
            const int id = __builtin_amdgcn_readlane(idr, jbase + e);
            uq[e] = *(const u32x4*)(U + (size_t)id * 1024 + lane * 16);
            vq[e] = *(const u32x4*)(V + (size_t)id * 1024 + lane * 16);
        }
        float d[8];
#pragma unroll
        for (int e = 0; e < 8; ++e) {
            int sdot = __builtin_amdgcn_sdot4((int)uq[e].x, hq[0], 0, false);
            sdot = __builtin_amdgcn_sdot4((int)uq[e].y, hq[1], sdot, false);
            sdot = __builtin_amdgcn_sdot4((int)uq[e].z, hq[2], sdot, false);
            sdot = __builtin_amdgcn_sdot4((int)uq[e].w, hq[3], sdot, false);
            d[e] = (float)sdot;
        }
        float r4[4], r2[2];
#pragma unroll
        for (int i = 0; i < 4; ++i) { const float keep = hi32 ? d[4 + i] : d[i], send = hi32 ? d[i] : d[4 + i]; r4[i] = keep + __shfl_xor(send, 32); }
#pragma unroll
        for (int i = 0; i < 2; ++i) { const float keep = hi16 ? r4[2 + i] : r4[i], send = hi16 ? r4[i] : r4[2 + i]; r2[i] = keep + __shfl_xor(send, 16); }
        float r1;
        { const float keep = hi8 ? r2[1] : r2[0], send = hi8 ? r2[0] : r2[1]; r1 = keep + __shfl_xor(send, 8); }
        r1 = row8_sum(r1);
        const float dotv = r1 * __shfl(sur, jbase + eidx);
        const float ccl = gelu_zs(dotv) * __shfl(gsr, jbase + eidx);
#pragma unroll
        for (int e = 0; e < 8; ++e) {
            const float cc = __int_as_float(__builtin_amdgcn_readlane(__float_as_int(ccl), e * 8));
            csum += cc;
            float f[4];
            cvt_u8x4(vq[e].x, f); acc[0] += cc * f[0]; acc[1] += cc * f[1]; acc[2] += cc * f[2]; acc[3] += cc * f[3];
            cvt_u8x4(vq[e].y, f); acc[4] += cc * f[0]; acc[5] += cc * f[1]; acc[6] += cc * f[2]; acc[7] += cc * f[3];
            cvt_u8x4(vq[e].z, f); acc[8] += cc * f[0]; acc[9] += cc * f[1]; acc[10] += cc * f[2]; acc[11] += cc * f[3];
            cvt_u8x4(vq[e].w, f); acc[12] += cc * f[0]; acc[13] += cc * f[1]; acc[14] += cc * f[2]; acc[15] += cc * f[3];
        }
    }
#pragma unroll
    for (int e = 0; e < 16; ++e) acc[e] -= 128.0f * csum;
    const float* ada = (const float*)(p.ws + OFF_CTRL + CT_ADA) + (size_t)(l * 2 + b) * 6144;
    float xv[16], ss = 0.f;
#pragma unroll
    for (int q = 0; q < 4; ++q) {
        const int n = lane * 16 + q * 4;
        const f32x4 x1 = *(const f32x4*)(p.out + (size_t)t * 1024 + n), gt = *(const f32x4*)(ada + 5 * 1024 + n);
#pragma unroll
        for (int e = 0; e < 4; ++e) { const float x2 = x1[e] + (1.0f + gt[e]) * acc[q * 4 + e]; xv[q * 4 + e] = x2; ss += x2 * x2; }
    }
    ss = wave_sum(ss);
    const float rstd = rsqrtf(ss * (1.0f / 1024.0f) + 1e-6f);
    if (l + 1 < DEPTH) {
        const float* ada2 = (const float*)(p.ws + OFF_CTRL + CT_ADA) + (size_t)((l + 1) * 2 + b) * 6144;
        const float* g1n = (const float*)p.in[I_N1G] + (size_t)(l + 1) * 1024;
        float o[16];
#pragma unroll
        for (int q = 0; q < 4; ++q) {
            const int n = lane * 16 + q * 4;
            const f32x4 g = *(const f32x4*)(g1n + n), sh = *(const f32x4*)(ada2 + n), sc = *(const f32x4*)(ada2 + 1024 + n);
            *(f32x4*)(p.out + (size_t)t * 1024 + n) = (f32x4){xv[q * 4], xv[q * 4 + 1], xv[q * 4 + 2], xv[q * 4 + 3]};
#pragma unroll
            for (int e = 0; e < 4; ++e) o[q * 4 + e] = xv[q * 4 + e] * rstd * g[e] * (1.0f + sc[e]) + sh[e];
        }
        u32x4 w0, w1;
        w0.x = pk2(o[0], o[1]); w0.y = pk2(o[2], o[3]); w0.z = pk2(o[4], o[5]); w0.w = pk2(o[6], o[7]);
        w1.x = pk2(o[8], o[9]); w1.y = pk2(o[10], o[11]); w1.z = pk2(o[12], o[13]); w1.w = pk2(o[14], o[15]);
        *(u32x4*)(H + (size_t)t * 1024 + lane * 16) = w0; *(u32x4*)(H + (size_t)t * 1024 + lane * 16 + 8) = w1;
    } else {
        const float* fg = (const float*)p.in[I_FG];
#pragma unroll
        for (int q = 0; q < 4; ++q) {
            const int n = lane * 16 + q * 4;
            const f32x4 g = *(const f32x4*)(fg + n);
            f32x4 o;
#pragma unroll
            for (int e = 0; e < 4; ++e) o[e] = xv[q * 4 + e] * rstd * g[e];
            *(f32x4*)(p.out + (size_t)t * 1024 + n) = o;
        }
    }
}

#define XB_TMO      128
#define XB_XCNT(j)  (256  + 64 * (j))
#define XB_XSUB(j)  (1280 + 64 * (j))
#define XB_XGEN(j)  (2304 + 64 * (j))
#define XB_TOP      3328
#define XB_TOPGEN   3392
#define XCD_BAR_WORDS 3456
#define XB_SPIN_CAP (1u << 18)
#define LAS __attribute__((address_space(3)))
DI unsigned xb_ld(unsigned* q)              { return __hip_atomic_load(q, __ATOMIC_RELAXED, __HIP_MEMORY_SCOPE_AGENT); }
DI unsigned xb_add(unsigned* q, unsigned v) { return __hip_atomic_fetch_add(q, v, __ATOMIC_RELAXED, __HIP_MEMORY_SCOPE_AGENT); }
DI unsigned xb_xcc_id() { return (unsigned)__builtin_amdgcn_s_getreg((3 << 11) | 20) & 0xFu; }
#define XB_SPIN(cond, bar) do { unsigned _sp = 0; while (cond) { __builtin_amdgcn_s_sleep(1); \
    if ((++_sp & 255u) == 0u) { if (xb_ld(&(bar)[XB_TMO])) break; if (_sp > XB_SPIN_CAP) { atomicAdd(&(bar)[XB_TMO], 1u); break; } } } } while (0)
struct XcdBarrier { unsigned* bar; unsigned x; volatile LAS unsigned* st; };
DI XcdBarrier xcd_barrier_post(unsigned* bar, volatile LAS unsigned* st) {
    XcdBarrier b; b.bar = bar; b.x = xb_xcc_id(); b.st = st;
    if (threadIdx.x == 0) (void)xb_add(&bar[XB_XCNT(b.x)], 1u);
    return b;
}
DI void xcd_barrier_complete(unsigned* bar, unsigned x, unsigned& nloc, unsigned& nx) {
    const unsigned G = gridDim.x * gridDim.y * gridDim.z;
    unsigned sum, cnt, mine, sp = 0u;
    for (;;) {
        sum = 0u; cnt = 0u; mine = 0u;
#pragma unroll
        for (unsigned j = 0; j < 16; ++j) { const unsigned c = xb_ld(&bar[XB_XCNT(j)]); sum += c; cnt += (c > 0u) ? 1u : 0u; mine = (j == x) ? c : mine; }
        if (sum == G) break;
        __builtin_amdgcn_s_sleep(1);
        if ((++sp & 255u) == 0u) { if (xb_ld(&bar[XB_TMO])) break; if (sp > XB_SPIN_CAP) { atomicAdd(&bar[XB_TMO], 1u); break; } }
    }
    nloc = mine > 0u ? mine : 1u; nx = cnt > 0u ? cnt : 1u;
}
DI void xcd_barrier(const XcdBarrier& b) {
    asm volatile("s_waitcnt vmcnt(0)" ::: "memory");
    __syncthreads();
    if (threadIdx.x == 0) {
        unsigned* bar = b.bar;
        __builtin_amdgcn_s_waitcnt(0);
        unsigned nloc = b.st[0], nx = b.st[1];
        if (nloc == 0u) { xcd_barrier_complete(bar, b.x, nloc, nx); b.st[0] = nloc; b.st[1] = nx; }
        const unsigned old = xb_add(&bar[XB_XSUB(b.x)], 1u);
        const unsigned gen = old / nloc;
        if (old + 1u == (gen + 1u) * nloc) {
            __builtin_amdgcn_fence(__ATOMIC_RELEASE, "agent");
            asm volatile("s_waitcnt vmcnt(0)" ::: "memory");
            const unsigned og = xb_add(&bar[XB_TOP], 1u);
            const unsigned tg = og / nx;
            if (og + 1u == (tg + 1u) * nx) xb_add(&bar[XB_TOPGEN], 1u);
            else XB_SPIN(xb_ld(&bar[XB_TOPGEN]) == tg, bar);
            __builtin_amdgcn_fence(__ATOMIC_ACQUIRE, "agent");
            xb_add(&bar[XB_XGEN(b.x)], 1u);
            asm volatile("s_waitcnt vmcnt(0)" ::: "memory");
        } else {
            XB_SPIN(xb_ld(&bar[XB_XGEN(b.x)]) == gen, bar);
            __builtin_amdgcn_fence(__ATOMIC_ACQUIRE, "agent");
            asm volatile("s_waitcnt vmcnt(0)" ::: "memory");
        }
    }
    __syncthreads();
}
constexpr size_t CT_BAR = 16384;

constexpr int LDS_BYTES = 2 * GEMM_STAGE + 64;
constexpr int N_PHASES = 2 + 14 * DEPTH;
constexpr int ATT_U1 = 688;
#ifndef MULTI_LAUNCH
#define MULTI_LAUNCH 0
#endif

template <int ph> DI void run_phase(const Params& p, char* lds) {
    const int bid = blockIdx.x, nblk = gridDim.x, tid = threadIdx.x;
    const int gw = bid * 4 + (tid >> 6), nw = nblk * 4;
    const int vb = (nblk == 512) ? (bid % 8) * 64 + ((bid / 8) % 32) * 2 + (bid / 256) : (nblk % 8 == 0) ? (bid % 8) * (nblk / 8) + bid / 8 : bid;
    float* ada = (float*)(p.ws + OFF_CTRL + CT_ADA);
    if (ph == 0) {
        const int total = 192 + 1 + 256 + NCONV_ITEMS / 2;
        for (int it = bid; it < total; it += nblk) {
            if (it < 192) ada_item(p, it, lds);
            else if (it == 192) lam_item(p);
            else if (it < 449) rope_item(p, it - 193);
            else convert_item(p, 0, it - 449, lds);
        }
        return;
    }
    if (ph == 1) {
        norm_rows(p, (const float*)p.in[I_X], (const float*)p.in[I_N1G], ada, ada + 1024, (bf16_t*)(p.ws + OFF_H));
        for (int it = NCONV_ITEMS / 2 + bid; it < NCONV_ITEMS; it += nblk) convert_item(p, 0, it, lds);
        return;
    }
    constexpr int l = (ph - 2) / 14, sub0 = (ph - 2) % 14, sub = sub0 <= 1 ? sub0 : sub0 == 2 ? 100 : sub0 == 3 ? 101 : sub0 <= 5 ? 2 : sub0 - 3;
    switch (sub) {
    case 0:
        for (int tile = vb; tile < 128 * 90; tile += nblk) { int mt, nt; tile_coords(tile, 90, mt, nt); phaseB_tile(p, mt, nt, lds); }
        break;
    case 1:
        for (int it = bid; it < 2048; it += nblk) { if (it < 1024) conv_tile(p, l, it, lds); else lora_in_tile(p, l, it - 1024); }
        break;
    case 101:
        for (int it = bid; it < 4096; it += nblk) scan_T_item(p, l, it, lds);
        break;
    case 100:
        for (int tile = vb; tile < 2048; tile += nblk) { int mt, nt; tile_coords(tile & 1023, 8, mt, nt); lora_wa_tile(p, l, tile >> 10, mt, nt, lds); }
        break;
    case 2: {
        const bool second = sub0 == 5;
#if SCAN_MFMA
        if (!second) { for (int it = bid; it < N_MS1; it += nblk) ms_item_pass1(p, l, it, lds); }
        else { for (int it = bid; it < N_MS2; it += nblk) ms_item_pass2(p, l, it, lds); }
#else
        if (!second) { for (int it = bid; it < N_SCAN1; it += nblk) scan_item_pass1(p, l, it, lds); }
        else { for (int it = bid; it < N_SCAN2; it += nblk) scan_item_pass2(p, l, it, lds); }
#endif
        unsigned* cnt = (unsigned*)(p.ws + OFF_CTRL + CT_CNT) + 64 * (l * 2 + (second ? 1 : 0));
        int* s_unit = (int*)(lds + LDS_BYTES - 16);
        constexpr int U1X = ATT_U1 / 8;
        const int jbase = second ? U1X : 0, jlim = second ? 256 : U1X;
        if (tid == 0) s_unit[1] = 0;
        for (;;) {
            __syncthreads();
            if (tid == 0) {
                const int myx = (int)(xb_xcc_id() & 7u);
                int unit = -1, qi = s_unit[1];
                while (qi < 8) {
                    const int x = (myx + qi) & 7;
                    const int j = jbase + (int)atomicAdd(cnt + x * 8, 1u);
                    if (j < jlim) { unit = ((j >> 1) << 4) | (x * 2 + (j & 1)); break; }
                    ++qi;
                }
                s_unit[0] = unit; s_unit[1] = qi;
            }
            __syncthreads();
            const int unit = s_unit[0];
            if (unit < 0) break;
            attn_unit(p, l, unit, lds);
        }
        break; }
    case 3:
        for (int it = bid; it < 1024; it += nblk) rwkv_post_tile(p, l, it, lds);
        break;
    case 4:
        for (int tile = vb; tile < 128 * 8; tile += nblk) { int mt, nt; tile_coords(tile, 8, mt, nt); phaseF_tile(p, mt, nt, lds); }
        break;
    case 5:
        for (int it = vb; it < 1024 + 8192; it += nblk) {
            if (it < 1024) { int mt, nt; tile_coords(it, 8, mt, nt); phaseG_tile(p, l, mt, nt, lds); }
            else convert_uv_item(p, l, it - 1024);
        }
        break;
    case 6:
        norm_rows(p, p.out, (const float*)p.in[I_N2G] + (size_t)l * 1024, ada + (size_t)l * 2 * 6144 + 3 * 1024, ada + (size_t)l * 2 * 6144 + 4 * 1024, (bf16_t*)(p.ws + OFF_H));
        break;
    case 7:
        for (int tile = vb; tile < 128 * 16; tile += nblk) { int mt, nt; tile_coords(tile, 16, mt, nt); phaseI_tile(p, mt, nt, lds); }
        break;
    case 8:
        for (int tile = vb; tile < 128 * 16; tile += nblk) { int mt, nt; tile_coords(tile, 16, mt, nt); phaseJ_tile(p, mt, nt, lds); }
        break;
    case 9:
        for (int idx = bid * NTHREADS + tid; idx < NT * 8; idx += nblk * NTHREADS) topk_thread(p, idx);
        if (l + 1 < DEPTH) for (int it = bid; it < NCONV_ITEMS; it += nblk) convert_item(p, l + 1, it, lds);
        break;
    case 10:
        for (int t = gw; t < NT; t += nw) peer_token(p, l, t);
        break;
    }
}

#ifndef PROBE_PH
#define PROBE_PH -1
#endif
#ifndef PROBE_MULT
#define PROBE_MULT 3
#endif
#define PHASE(N) if (p.ph_begin <= N && N < p.ph_end) { unsigned long long pt0 = 0; if (N == PROBE_PH) pt0 = __builtin_amdgcn_s_memrealtime(); run_phase<N>(p, lds); \
    if (N + 1 < p.ph_end) { if (N == 0) cg::this_grid().sync(); else xcd_barrier(xb); } \
    if (N == PROBE_PH) { const unsigned long long pt1 = __builtin_amdgcn_s_memrealtime(); while (__builtin_amdgcn_s_memrealtime() - pt1 < PROBE_MULT * (pt1 - pt0)) __builtin_amdgcn_s_sleep(8); __syncthreads(); } }
extern __shared__ __attribute__((aligned(16))) char dyn_lds[];
__global__ void __launch_bounds__(NTHREADS, 2) mega_kernel(Params p) {
    char* lds = dyn_lds;
    volatile LAS unsigned* xst = (volatile LAS unsigned*)(lds + LDS_BYTES - 32);
    if (threadIdx.x == 0) { xst[0] = 0u; xst[1] = 0u; }
    __syncthreads();
    const XcdBarrier xb = xcd_barrier_post((unsigned*)(p.ws + OFF_CTRL + CT_BAR), xst);
    PHASE(0) PHASE(1) PHASE(2) PHASE(3) PHASE(4) PHASE(5) PHASE(6) PHASE(7) PHASE(8) PHASE(9) PHASE(10) PHASE(11) PHASE(12) PHASE(13)
    PHASE(14) PHASE(15) PHASE(16) PHASE(17) PHASE(18) PHASE(19) PHASE(20) PHASE(21) PHASE(22) PHASE(23) PHASE(24) PHASE(25) PHASE(26) PHASE(27) PHASE(28) PHASE(29)
    static_assert(N_PHASES == 30, "phase list");
}

extern "C" void kernel_launch(void* const* d_in, const int* in_sizes, int n_in, void* d_out, int out_size, void* d_ws, size_t ws_size, hipStream_t stream) {
    static int grid_blocks = 0;
    if (!grid_blocks) {
        int dev = 0, cus = 0, per_cu = 0;
        hipGetDevice(&dev);
        hipDeviceGetAttribute(&cus, hipDeviceAttributeMultiprocessorCount, dev);
        hipFuncSetAttribute((const void*)mega_kernel, hipFuncAttributeMaxDynamicSharedMemorySize, LDS_BYTES);
        hipOccupancyMaxActiveBlocksPerMultiprocessor(&per_cu, mega_kernel, NTHREADS, LDS_BYTES);
        if (per_cu > 2) per_cu = 2;
        if (per_cu < 1) per_cu = 1;
        grid_blocks = cus * per_cu;
        if (ws_size < WS_END) fprintf(stderr, "workspace too small: %zu < %zu\n", ws_size, (size_t)WS_END);
    }
    Params p{};
    for (int i = 0; i < N_IN; ++i) p.in[i] = d_in[i];
    p.out = (float*)d_out; p.ws = (char*)d_ws;
    hipMemsetAsync(d_ws, 0, 32768, stream);
#if MULTI_LAUNCH
    for (int ph = 0; ph < N_PHASES; ++ph) {
        p.ph_begin = ph; p.ph_end = ph + 1;
        hipLaunchKernelGGL(mega_kernel, dim3(grid_blocks), dim3(NTHREADS), LDS_BYTES, stream, p);
    }
#else
    p.ph_begin = 0; p.ph_end = N_PHASES;
    void* args[] = {&p};
    hipError_t e = hipLaunchCooperativeKernel((void*)mega_kernel, dim3(grid_blocks), dim3(NTHREADS), args, LDS_BYTES, stream);
    if (e != hipSuccess) fprintf(stderr, "cooperative launch failed: %s (grid %d)\n", hipGetErrorString(e), grid_blocks);
#endif
}
```

```cpp
#include <hip/hip_runtime.h>
#include <hip/hip_cooperative_groups.h>
#include <cstdio>
#include <cstdint>
namespace cg = cooperative_groups;
#ifndef SCAN_MFMA
#define SCAN_MFMA 1
#endif
#ifndef SCAN_TEST
#define SCAN_TEST 0
#endif

#define DI __device__ __forceinline__
typedef unsigned short bf16_t;
typedef short bf16x8 __attribute__((ext_vector_type(8)));
typedef float f32x2 __attribute__((ext_vector_type(2)));
typedef float f32x4 __attribute__((ext_vector_type(4)));
typedef float f32x16 __attribute__((ext_vector_type(16)));
typedef unsigned u32x2 __attribute__((ext_vector_type(2)));
typedef unsigned u32x4 __attribute__((ext_vector_type(4)));
typedef __bf16 nbf16x2 __attribute__((ext_vector_type(2)));

constexpr int NB = 2, SEQ = 8192, NT = NB * SEQ, DM = 1024, CIN = 11520, DEPTH = 2;
constexpr int NTHREADS = 256;
constexpr size_t MiB = (size_t)1 << 20;
constexpr size_t OFF_CTRL = 0, OFF_ROPE = 1 * MiB, OFF_W = 5 * MiB, OFF_H = 41 * MiB, OFF_Q = 73 * MiB, OFF_K = 105 * MiB,
                 OFF_VT = 137 * MiB, OFF_UC = 169 * MiB, OFF_ZR = 201 * MiB, OFF_ZG = 305 * MiB, OFF_A = 401 * MiB,
                 OFF_LW = 433 * MiB, OFF_YS = 465 * MiB, WS_END = 497 * MiB;
constexpr size_t OFF_CONVP = OFF_H, OFF_ATTP = OFF_UC, OFF_RWKVP = OFF_Q, OFF_MERGED = OFF_K, OFF_PU = OFF_ZR,
                 OFF_PV = OFF_ZR + 32 * MiB, OFF_QP = OFF_ZG, OFF_SCORES = OFF_Q, OFF_EID = OFF_A, OFF_GATE = OFF_A + 8 * MiB;
constexpr size_t W_IN = 0, W_ATTO = (size_t)CIN * 1024 * 2, W_CONVO = W_ATTO + 2 * MiB, W_RWKVO = W_CONVO + 2 * MiB,
                 W_OUT = W_RWKVO + 2 * MiB, W_QP = W_OUT + 2 * MiB, W_KEY1 = W_QP + 4 * MiB, W_KEY2 = W_KEY1 + 32768,
                 W_W2T = W_KEY2 + 32768, W_A2T = W_W2T + 131072, W_G2T = W_A2T + 131072;
static_assert(W_G2T + 262144 <= 36 * MiB, "W region overflow");
constexpr size_t CT_CNT = 0, CT_LAM = 3072, CT_ADA = 65536;
constexpr int RWKV_LD = 3328, ZG_LD = 3072;

enum { I_X = 0, I_C, I_POS, I_WADA, I_BADA, I_N1G, I_WIN, I_LQ1, I_LK1, I_LQ2, I_LK2, I_AHG, I_WATTO, I_CONVW, I_CONVB, I_CLNG, I_CLNB,
       I_WCONVO, I_MU, I_W0, I_W2, I_A0, I_A2, I_G2, I_KK, I_KA, I_RK, I_GNG, I_GNB, I_WRWKVO, I_WOUT, I_N2G, I_WQ, I_KEY1, I_KEY2,
       I_PU, I_PV, I_FG, N_IN };

struct Params {
    const void* in[N_IN];
    float* out;
    char* ws;
    int ph_begin, ph_end;
};

DI unsigned pk2(float lo, float hi) { f32x2 v = {lo, hi}; nbf16x2 b = __builtin_convertvector(v, nbf16x2); return __builtin_bit_cast(unsigned, b); }
DI float bflo(unsigned u) { return __uint_as_float(u << 16); }
DI float bfhi(unsigned u) { return __uint_as_float(u & 0xffff0000u); }
DI float bf2f(bf16_t h) { return __uint_as_float(((unsigned)h) << 16); }
DI bf16_t f2bf(float x) { return (bf16_t)(pk2(x, x) & 0xffffu); }
DI float sigmoidf_(float x) { return 1.0f / (1.0f + __expf(-x)); }
DI float siluf_(float x) { return x / (1.0f + __expf(-x)); }
template <int CTRL> DI float dpp_f(float x) { return __int_as_float(__builtin_amdgcn_update_dpp(0, __float_as_int(x), CTRL, 0xF, 0xF, true)); }
DI float row16_sum(float x) { x += dpp_f<0xB1>(x); x += dpp_f<0x4E>(x); x += dpp_f<0x141>(x); x += dpp_f<0x140>(x); return x; }
DI float row16_max(float x) { x = fmaxf(x, dpp_f<0xB1>(x)); x = fmaxf(x, dpp_f<0x4E>(x)); x = fmaxf(x, dpp_f<0x141>(x)); x = fmaxf(x, dpp_f<0x140>(x)); return x; }
DI float wave_sum(float x) { x = row16_sum(x); x += __shfl_xor(x, 16); x += __shfl_xor(x, 32); return x; }
DI float wave_max(float x) { x = row16_max(x); x = fmaxf(x, __shfl_xor(x, 16)); x = fmaxf(x, __shfl_xor(x, 32)); return x; }
DI void unpack8(u32x4 v, float (&f)[8]) { f[0] = bflo(v.x); f[1] = bfhi(v.x); f[2] = bflo(v.y); f[3] = bfhi(v.y); f[4] = bflo(v.z); f[5] = bfhi(v.z); f[6] = bflo(v.w); f[7] = bfhi(v.w); }
DI void unpack4(u32x2 v, float (&f)[4]) { f[0] = bflo(v.x); f[1] = bfhi(v.x); f[2] = bflo(v.y); f[3] = bfhi(v.y); }
DI u32x2 pack4(float a, float b, float c, float d) { u32x2 r; r.x = pk2(a, b); r.y = pk2(c, d); return r; }

#define MFMA16(a, b, c) __builtin_amdgcn_mfma_f32_16x16x32_bf16((a), (b), (c), 0, 0, 0)
#define MFMA32(a, b, c) __builtin_amdgcn_mfma_f32_32x32x16_bf16((a), (b), (c), 0, 0, 0)

constexpr int GEMM_STAGE = 32768;
#define LDSP __attribute__((address_space(3)))
template <bool NMODE>
DI void gemm_mainloop(f32x4 (&acc)[4][4], const bf16_t* X, size_t ldx, const bf16_t* W, size_t ldw, int K, char* lds) {
    const int tid = threadIdx.x, lane = tid & 63, wid = tid >> 6, wm = wid >> 1, wn = wid & 1;
    const int fr = lane & 15, fq = lane >> 4;
    const int srow = tid >> 3, skc = (tid & 7) ^ ((tid >> 4) & 7);
    const bf16_t* gx = X + (size_t)srow * ldx + skc * 8;
    const bf16_t* gw = W + (size_t)srow * ldw + skc * 8;
    const int nk = K >> 6;
    auto issue = [&](int kt) {
        char* st = lds + (kt & 1) * GEMM_STAGE + tid * 16;
        const int ko = kt * 64;
#pragma unroll
        for (int i = 0; i < 4; ++i) {
            __builtin_amdgcn_global_load_lds((const unsigned*)(gx + (size_t)(32 * i) * ldx + ko), (LDSP unsigned*)(st + i * 4096), 16, 0, 0);
            __builtin_amdgcn_global_load_lds((const unsigned*)(gw + (size_t)(32 * i) * ldw + ko), (LDSP unsigned*)(st + 16384 + i * 4096), 16, 0, 0);
        }
    };
    const int swz = (fr >> 1) & 7;
    asm volatile("s_waitcnt vmcnt(0) lgkmcnt(0)" ::: "memory");
    __syncthreads();
    issue(0);
    for (int kt = 0; kt < nk; ++kt) {
        asm volatile("s_waitcnt vmcnt(0)" ::: "memory");
        __syncthreads();
        if (kt + 1 < nk) issue(kt + 1);
        const char* sx = lds + (kt & 1) * GEMM_STAGE;
        const char* sw = sx + 16384;
#pragma unroll
        for (int ks = 0; ks < 2; ++ks) {
            const int cb = ((ks * 4 + fq) ^ swz) << 4;
            bf16x8 xf[4], wf[4];
#pragma unroll
            for (int i = 0; i < 4; ++i) {
                xf[i] = *(const bf16x8*)(sx + (wm * 64 + i * 16 + fr) * 128 + cb);
                wf[i] = *(const bf16x8*)(sw + (wn * 64 + i * 16 + fr) * 128 + cb);
            }
#pragma unroll
            for (int ti = 0; ti < 4; ++ti)
#pragma unroll
                for (int ni = 0; ni < 4; ++ni)
                    acc[ti][ni] = NMODE ? MFMA16(xf[ti], wf[ni], acc[ti][ni]) : MFMA16(wf[ni], xf[ti], acc[ti][ni]);
        }
    }
    asm volatile("" ::: "memory");
    __builtin_amdgcn_sched_barrier(0);
}
DI void zero_acc(f32x4 (&acc)[4][4]) {
#pragma unroll
    for (int i = 0; i < 4; ++i)
#pragma unroll
        for (int j = 0; j < 4; ++j) acc[i][j] = (f32x4){0.f, 0.f, 0.f, 0.f};
}
DI void tile_coords(int tile, int nN, int& mt, int& nt) { const int per = 16 * nN; const int g = tile / per, r = tile % per; nt = r >> 4; mt = g * 16 + (r & 15); }

DI void ada_item(const Params& p, int item, char* lds) {
    const int l = item / 96, cgp = item % 96, tid = threadIdx.x, lane = tid & 63, wid = tid >> 6;
    const float* c = (const float*)p.in[I_C];
    const float* w = (const float*)p.in[I_WADA] + (size_t)l * 1024 * 6144 + cgp * 64 + lane;
    float a0 = 0.f, a1 = 0.f;
    const int k0 = wid * 256;
#pragma unroll 8
    for (int k = k0; k < k0 + 256; ++k) {
        const float wv = w[(size_t)k * 6144];
        a0 += siluf_(c[k]) * wv; a1 += siluf_(c[1024 + k]) * wv;
    }
    float* red = (float*)lds;
    __syncthreads();
    red[(wid * 2 + 0) * 64 + lane] = a0; red[(wid * 2 + 1) * 64 + lane] = a1;
    __syncthreads();
    if (tid < 128) {
        const int b = tid >> 6, n = cgp * 64 + (tid & 63);
        float s = ((const float*)p.in[I_BADA])[l * 6144 + n];
        for (int w4 = 0; w4 < 4; ++w4) s += red[(w4 * 2 + b) * 64 + (tid & 63)];
        ((float*)(p.ws + OFF_CTRL + CT_ADA))[(l * 2 + b) * 6144 + n] = s;
    }
}
DI void lam_item(const Params& p) {
    if (threadIdx.x < 64) {
        const int lane = threadIdx.x;
        for (int l = 0; l < DEPTH; ++l) {
            float s1 = ((const float*)p.in[I_LQ1])[l * 64 + lane] * ((const float*)p.in[I_LK1])[l * 64 + lane];
            float s2 = ((const float*)p.in[I_LQ2])[l * 64 + lane] * ((const float*)p.in[I_LK2])[l * 64 + lane];
            s1 = wave_sum(s1); s2 = wave_sum(s2);
            const float lam_init = 0.8f - 0.6f * expf(-0.3f * (float)l);
            if (lane == 0) ((float*)(p.ws + OFF_CTRL + CT_LAM))[l] = expf(s1) - expf(s2) + lam_init;
        }
    }
}
DI void rope_item(const Params& p, int item) {
    const int* pos = (const int*)p.in[I_POS];
    float* rc = (float*)(p.ws + OFF_ROPE);
    float* rs = rc + (size_t)NT * 32;
#pragma unroll
    for (int e = 0; e < 8; ++e) {
        const int idx = item * 2048 + e * 256 + threadIdx.x;
        const int t = idx >> 5, i = idx & 31;
        const float inv = powf(10000.0f, -(float)i / 32.0f);
        const float ang = (float)pos[t] * inv;
        float sn, cs; sincosf(ang, &sn, &cs);
        rc[idx] = cs; rs[idx] = sn;
    }
}
DI int win_srcmap(int n) {
    if (n < 3072 || n >= 5120) return n;
    const int q = n - 3072, j = q >> 6, r = q & 63;
    return r < 32 ? 3072 + 32 * j + r : 3072 + 1024 + 32 * j + (r - 32);
}
DI void transpose_tile(const float* src, int N, bf16_t* dst, int k0, int n0, bool perm, char* lds, int dld = 1024) {
    float* t = (float*)lds;
    const int tid = threadIdx.x;
    const int r = tid >> 4, c4 = (tid & 15) * 4;
    int ns = n0 + c4; if (perm) ns = win_srcmap(ns);
    __syncthreads();
#pragma unroll
    for (int i = 0; i < 4; ++i) {
        const int kl = r + 16 * i;
        const f32x4 v = *(const f32x4*)(src + (size_t)(k0 + kl) * N + ns);
        t[(c4 + 0) * 65 + kl] = v[0]; t[(c4 + 1) * 65 + kl] = v[1]; t[(c4 + 2) * 65 + kl] = v[2]; t[(c4 + 3) * 65 + kl] = v[3];
    }
    __syncthreads();
    const int nl = tid >> 2, kq = (tid & 3) * 16;
    u32x4 o0, o1;
    const float* tr = t + nl * 65 + kq;
    o0.x = pk2(tr[0], tr[1]); o0.y = pk2(tr[2], tr[3]); o0.z = pk2(tr[4], tr[5]); o0.w = pk2(tr[6], tr[7]);
    o1.x = pk2(tr[8], tr[9]); o1.y = pk2(tr[10], tr[11]); o1.z = pk2(tr[12], tr[13]); o1.w = pk2(tr[14], tr[15]);
    bf16_t* d = dst + (size_t)(n0 + nl) * dld + k0 + kq;
    *(u32x4*)d = o0; *(u32x4*)(d + 8) = o1;
}
constexpr int NCONV_ITEMS = 2880 + 1024 + 512 + 2 + 32;
DI void convert_item(const Params& p, int l, int item, char* lds) {
    char* wb = p.ws + OFF_W;
    if (item < 2880) { const int kt = item % 16, nt = item / 16; transpose_tile((const float*)p.in[I_WIN] + (size_t)l * 1024 * CIN, CIN, (bf16_t*)(wb + W_IN), kt * 64, nt * 64, true, lds); return; }
    item -= 2880;
    if (item < 1024) {
        const int which = item >> 8, it = item & 255, kt = it & 15, nt = it >> 4;
        const int idx = which == 0 ? I_WATTO : which == 1 ? I_WCONVO : which == 2 ? I_WRWKVO : I_WOUT;
        const size_t off = which == 0 ? W_ATTO : which == 1 ? W_CONVO : which == 2 ? W_RWKVO : W_OUT;
        transpose_tile((const float*)p.in[idx] + (size_t)l * 1024 * 1024, 1024, (bf16_t*)(wb + off), kt * 64, nt * 64, false, lds); return;
    }
    item -= 1024;
    if (item < 512) { const int kt = item & 15, nt = item >> 4; transpose_tile((const float*)p.in[I_WQ] + (size_t)l * 1024 * 2048, 2048, (bf16_t*)(wb + W_QP), kt * 64, nt * 64, false, lds); return; }
    item -= 512;
    if (item >= 2) {
        item -= 2;
        if (item < 16) { transpose_tile((const float*)p.in[I_W2] + (size_t)l * 64 * 1024, 1024, (bf16_t*)(wb + W_W2T), 0, item * 64, false, lds, 64); return; }
        item -= 16;
        if (item < 16) { transpose_tile((const float*)p.in[I_A2] + (size_t)l * 64 * 1024, 1024, (bf16_t*)(wb + W_A2T), 0, item * 64, false, lds, 64); return; }
        return;
    }
    {
        const float* src = (const float*)p.in[item == 0 ? I_KEY1 : I_KEY2] + (size_t)l * 16384;
        bf16_t* dst = (bf16_t*)(wb + (item == 0 ? W_KEY1 : W_KEY2));
        for (int i = threadIdx.x * 4; i < 16384; i += 1024) { const f32x4 v = *(const f32x4*)(src + i); *(u32x2*)(dst + i) = pack4(v[0], v[1], v[2], v[3]); }
    }
}
constexpr size_t OFF_PU8 = OFF_ZR, OFF_PV8 = OFF_ZR + 16 * MiB, OFF_PSU = OFF_ZR + 32 * MiB, OFF_PSV = OFF_PSU + 65536;
DI void convert_uv_item(const Params& p, int l, int item) {
    const int lane = threadIdx.x & 63, rowi = item * 4 + (threadIdx.x >> 6);
    const int arr = rowi >> 14, row = rowi & 16383;
    const float* src = (const float*)p.in[arr == 0 ? I_PU : I_PV] + ((size_t)l * 16384 + row) * 1024;
    unsigned* dst = (unsigned*)(p.ws + (arr == 0 ? OFF_PU8 : OFF_PV8) + (size_t)row * 1024);
    f32x4 v[4]; float am = 0.f;
#pragma unroll
    for (int i = 0; i < 4; ++i) { v[i] = *(const f32x4*)(src + i * 256 + lane * 4); am = fmaxf(am, fmaxf(fmaxf(fabsf(v[i][0]), fabsf(v[i][1])), fmaxf(fabsf(v[i][2]), fabsf(v[i][3])))); }
    am = wave_max(am);
    const float sc = am > 0.f ? am * (1.0f / 127.0f) : 1.0f, isc = am > 0.f ? 127.0f / am : 0.f;
#pragma unroll
    for (int i = 0; i < 4; ++i) {
        unsigned w = 0;
#pragma unroll
        for (int e = 0; e < 4; ++e) { const int q = (int)rintf(v[i][e] * isc) + (arr == 0 ? 0 : 128); w |= ((unsigned)q & 255u) << (8 * e); }
        dst[i * 64 + lane] = w;
    }
    if (lane == 0) ((float*)(p.ws + (arr == 0 ? OFF_PSU : OFF_PSV)))[row] = sc;
}

DI void norm_rows(const Params& p, const float* xin, const float* gain, const float* shv, const float* scv, bf16_t* out) {
    const int lane = threadIdx.x & 63;
    const int gw = blockIdx.x * 4 + (threadIdx.x >> 6), nw = gridDim.x * 4;
    for (int t = gw; t < NT; t += nw) {
        const int b = t >> 13;
        f32x4 v[4]; float ss = 0.f;
#pragma unroll
        for (int i = 0; i < 4; ++i) { v[i] = *(const f32x4*)(xin + (size_t)t * 1024 + i * 256 + lane * 4); ss += v[i][0] * v[i][0] + v[i][1] * v[i][1] + v[i][2] * v[i][2] + v[i][3] * v[i][3]; }
        ss = wave_sum(ss);
        const float rstd = rsqrtf(ss * (1.0f / 1024.0f) + 1e-6f);
#pragma unroll
        for (int i = 0; i < 4; ++i) {
            const int n = i * 256 + lane * 4;
            const f32x4 g = *(const f32x4*)(gain + n), sc = *(const f32x4*)(scv + b * 6144 + n), sh = *(const f32x4*)(shv + b * 6144 + n);
            float o[4];
#pragma unroll
            for (int e = 0; e < 4; ++e) o[e] = v[i][e] * rstd * g[e] * (1.0f + sc[e]) + sh[e];
            *(u32x2*)(out + (size_t)t * 1024 + n) = pack4(o[0], o[1], o[2], o[3]);
        }
    }
}

DI void phaseB_tile(const Params& p, int mt, int nt, char* lds) {
    const int tid = threadIdx.x, lane = tid & 63, wid = tid >> 6, wm = wid >> 1, wn = wid & 1;
    const int fr = lane & 15, fq = lane >> 4;
    const bf16_t* X = (const bf16_t*)(p.ws + OFF_H) + (size_t)mt * 128 * 1024;
    const bf16_t* W = (const bf16_t*)(p.ws + OFF_W + W_IN) + (size_t)nt * 128 * 1024;
    const int n0 = nt * 128, nb = n0 + wn * 64;
    const int m0 = mt * 128 + wm * 64;
    f32x4 acc[4][4]; zero_acc(acc);
    if (n0 >= 2048 && n0 < 3072) {
        gemm_mainloop<true>(acc, X, 1024, W, 1024, 1024, lds);
        bf16_t* VT = (bf16_t*)(p.ws + OFF_VT);
#pragma unroll
        for (int ni = 0; ni < 4; ++ni) {
            const int col = nb - 2048 + ni * 16 + fr, hh = col >> 7, dv = col & 127, d = dv >> 5, rr = dv & 31;
#pragma unroll
            for (int ti = 0; ti < 4; ++ti) {
                const int tok = m0 + ti * 16 + fq * 4;
                const int b = tok >> 13, s = tok & 8191, kt = s >> 6, kl = s & 63, kb = kl >> 5, x = kl & 31;
                const int s_ = (x >> 4) & 1, jhi = (x >> 3) & 1, h_ = (x >> 2) & 1;
                const size_t base = ((size_t)((b * 8 + hh) * 128 + kt)) * 8192 + (size_t)(((((d * 2 + kb) * 2 + s_) * 2 + h_) * 32 + rr) * 8 + jhi * 4);
                *(u32x2*)(VT + base) = pack4(acc[ti][ni][0], acc[ti][ni][1], acc[ti][ni][2], acc[ti][ni][3]);
            }
        }
        return;
    }
    gemm_mainloop<false>(acc, X, 1024, W, 1024, 1024, lds);
    if (n0 < 2048) {
        const bool isK = n0 >= 1024;
        const int nn = nb - (isK ? 1024 : 0), hh = nn >> 7, c = (nn >> 6) & 1;
        const float scl = isK ? 1.0f : 0.125f * 1.4426950408889634f;
        bf16_t* dst = (bf16_t*)(p.ws + (isK ? OFF_K : OFF_Q));
        const float* rc = (const float*)(p.ws + OFF_ROPE);
        const float* rs = rc + (size_t)NT * 32;
#pragma unroll
        for (int ti = 0; ti < 4; ++ti) {
            const int tok = m0 + ti * 16 + fr, b = tok >> 13, s = tok & 8191;
            bf16_t* row = dst + ((size_t)(((b * 8 + hh) * 2 + c)) * SEQ + s) * 64;
#pragma unroll
            for (int ni = 0; ni < 2; ++ni) {
                const int i0 = ni * 16 + fq * 4;
                const f32x4 cs = *(const f32x4*)(rc + (size_t)tok * 32 + i0), sn = *(const f32x4*)(rs + (size_t)tok * 32 + i0);
                float o1[4], o2[4];
#pragma unroll
                for (int r = 0; r < 4; ++r) {
                    const float t1 = acc[ti][ni][r], t2 = acc[ti][ni + 2][r];
                    o1[r] = (t1 * cs[r] - t2 * sn[r]) * scl; o2[r] = (t2 * cs[r] + t1 * sn[r]) * scl;
                }
                *(u32x2*)(row + i0) = pack4(o1[0], o1[1], o1[2], o1[3]);
                *(u32x2*)(row + 32 + i0) = pack4(o2[0], o2[1], o2[2], o2[3]);
            }
        }
    } else if (n0 < 5120) {
        const int j = (nb - 3072) >> 6;
        bf16_t* UC = (bf16_t*)(p.ws + OFF_UC);
#pragma unroll
        for (int ti = 0; ti < 4; ++ti) {
            const int tok = m0 + ti * 16 + fr;
#pragma unroll
            for (int ni = 0; ni < 2; ++ni) {
                const int ch = 32 * j + ni * 16 + fq * 4;
                float o[4];
#pragma unroll
                for (int r = 0; r < 4; ++r) o[r] = acc[ti][ni][r] * sigmoidf_(acc[ti][ni + 2][r]);
                *(u32x2*)(UC + (size_t)tok * 1024 + ch) = pack4(o[0], o[1], o[2], o[3]);
            }
        }
    } else if (n0 < 8448) {
        bf16_t* ZR = (bf16_t*)(p.ws + OFF_ZR);
#pragma unroll
        for (int ti = 0; ti < 4; ++ti) {
            const int tok = m0 + ti * 16 + fr;
#pragma unroll
            for (int ni = 0; ni < 4; ++ni) {
                const int col = nb - 5120 + ni * 16 + fq * 4;
                *(u32x2*)(ZR + (size_t)tok * RWKV_LD + col) = pack4(acc[ti][ni][0], acc[ti][ni][1], acc[ti][ni][2], acc[ti][ni][3]);
            }
        }
    } else {
        bf16_t* ZG = (bf16_t*)(p.ws + OFF_ZG);
#pragma unroll
        for (int ti = 0; ti < 4; ++ti) {
            const int tok = m0 + ti * 16 + fr;
#pragma unroll
            for (int ni = 0; ni < 4; ++ni) {
                const int col = nb - 8448 + ni * 16 + fq * 4;
                *(u32x2*)(ZG + (size_t)tok * ZG_LD + col) = pack4(sigmoidf_(acc[ti][ni][0]), sigmoidf_(acc[ti][ni][1]), sigmoidf_(acc[ti][ni][2]), sigmoidf_(acc[ti][ni][3]));
            }
        }
    }
}

DI void zr_shift8(const bf16_t* ZR, const float* mu, int tok, int col, float (&z)[8]) {
    const u32x4 cv = *(const u32x4*)(ZR + (size_t)tok * RWKV_LD + col);
    u32x4 pv = (u32x4){0u, 0u, 0u, 0u};
    if ((tok & 8191) != 0) pv = *(const u32x4*)(ZR + (size_t)(tok - 1) * RWKV_LD + col);
    float c[8], q[8]; unpack8(cv, c); unpack8(pv, q);
    const f32x4 m0 = *(const f32x4*)(mu + col), m1 = *(const f32x4*)(mu + col + 4);
#pragma unroll
    for (int e = 0; e < 4; ++e) { z[e] = c[e] + m0[e] * (q[e] - c[e]); z[4 + e] = c[4 + e] + m1[e] * (q[4 + e] - c[4 + e]); }
}
DI void zr_shift4(const bf16_t* ZR, const float* mu, int tok, int col, float (&z)[4]) {
    const u32x2 cv = *(const u32x2*)(ZR + (size_t)tok * RWKV_LD + col);
    u32x2 pv = (u32x2){0u, 0u};
    if ((tok & 8191) != 0) pv = *(const u32x2*)(ZR + (size_t)(tok - 1) * RWKV_LD + col);
    float c[4], q[4]; unpack4(cv, c); unpack4(pv, q);
    const f32x4 m0 = *(const f32x4*)(mu + col);
#pragma unroll
    for (int e = 0; e < 4; ++e) z[e] = c[e] + m0[e] * (q[e] - c[e]);
}

constexpr size_t OFF_LORA = 501 * MiB;
constexpr size_t OFF_CF = 509 * MiB;
DI void lora_in_tile(const Params& p, int l, int tile) {
    const int tid = threadIdx.x, tok = tile * 16 + (tid >> 4), c8 = (tid & 15) * 8;
    const bf16_t* ZR = (const bf16_t*)(p.ws + OFF_ZR);
    const float* mu = (const float*)p.in[I_MU] + (size_t)l * RWKV_LD;
    bf16_t* out = (bf16_t*)(p.ws + OFF_LORA) + (size_t)tok * 256;
    float z[8], y[8];
    zr_shift8(ZR, mu, tok, 3072 + c8, z);
#pragma unroll
    for (int e = 0; e < 8; ++e) y[e] = c8 < 64 ? tanhf(z[e]) : z[e];
    { u32x4 w; w.x = pk2(y[0], y[1]); w.y = pk2(y[2], y[3]); w.z = pk2(y[4], y[5]); w.w = pk2(y[6], y[7]); *(u32x4*)(out + c8) = w; }
}
DI void lora_wa_tile(const Params& p, int l, int which, int mt, int nt, char* lds) {
    const int tid = threadIdx.x, lane = tid & 63, wid = tid >> 6, wm = wid >> 1, wn = wid & 1, fr = lane & 15, fq = lane >> 4;
    const int m0 = mt * 128 + wm * 64, nb = nt * 128 + wn * 64;
    f32x4 acc[4][4]; zero_acc(acc);
    gemm_mainloop<false>(acc, (const bf16_t*)(p.ws + OFF_LORA) + (size_t)mt * 128 * 256 + which * 64, 256,
                         (const bf16_t*)(p.ws + OFF_W + (which == 0 ? W_W2T : W_A2T)) + (size_t)nt * 128 * 64, 64, 64, lds);
    const float* bias = (const float*)p.in[which == 0 ? I_W0 : I_A0] + (size_t)l * 1024;
    bf16_t* dst = (bf16_t*)(p.ws + (which == 0 ? OFF_LW : OFF_A));
    const float scl = which == 0 ? -0.6065306597126334f : 1.0f;
#pragma unroll
    for (int ni = 0; ni < 4; ++ni) {
        const int n = nb + ni * 16 + fq * 4;
        const f32x4 bv = *(const f32x4*)(bias + n);
#pragma unroll
        for (int ti = 0; ti < 4; ++ti) {
            const int tok = m0 + ti * 16 + fr;
            float o[4];
#pragma unroll
            for (int r = 0; r < 4; ++r) o[r] = scl * sigmoidf_(acc[ti][ni][r] + bv[r]);
            *(u32x2*)(dst + (size_t)tok * 1024 + n) = pack4(o[0], o[1], o[2], o[3]);
        }
    }
}

DI void conv_tile(const Params& p, int l, int tile, char* lds) {
    const int tid = threadIdx.x, lane = tid & 63, wid = tid >> 6, t0 = tile * 16, s0 = t0 & 8191;
    const bf16_t* UC = (const bf16_t*)(p.ws + OFF_UC);
    bf16_t* out = (bf16_t*)(p.ws + OFF_CONVP);
    float* su = (float*)lds;
    float* red = su + 46 * 256;
    float s1[16], s2[16];
#pragma unroll
    for (int t = 0; t < 16; ++t) { s1[t] = 0.f; s2[t] = 0.f; }
#pragma unroll 1
    for (int ps = 0; ps < 4; ++ps) {
        const int cbase = ps * 256;
        __syncthreads();
        for (int ch = tid; ch < 46 * 32; ch += 256) {
            const int row = ch >> 5, c8 = (ch & 31) * 8;
            u32x4 v = (u32x4){0u, 0u, 0u, 0u};
            if (s0 - 30 + row >= 0) v = *(const u32x4*)(UC + (size_t)(t0 - 30 + row) * 1024 + cbase + c8);
            float f[8]; unpack8(v, f);
            *(f32x4*)(su + row * 256 + c8) = (f32x4){f[0], f[1], f[2], f[3]};
            *(f32x4*)(su + row * 256 + c8 + 4) = (f32x4){f[4], f[5], f[6], f[7]};
        }
        __syncthreads();
        const int c = cbase + tid;
        float w[31];
#pragma unroll
        for (int j = 0; j < 31; ++j) w[j] = ((const float*)p.in[I_CONVW])[(size_t)l * 31 * 1024 + j * 1024 + c];
        const float bias = ((const float*)p.in[I_CONVB])[l * 1024 + c];
        float acc[16];
#pragma unroll
        for (int t = 0; t < 16; ++t) acc[t] = bias;
#pragma unroll
        for (int rr = 0; rr < 46; ++rr) {
            const float uval = su[rr * 256 + tid];
#pragma unroll
            for (int t = 0; t < 16; ++t) if (rr - t >= 0 && rr - t <= 30) acc[t] += w[rr - t] * uval;
        }
#pragma unroll
        for (int t = 0; t < 16; ++t) {
            const bf16_t hb = f2bf(acc[t]); const float yr = bf2f(hb);
            s1[t] += yr; s2[t] += yr * yr;
            out[(size_t)(t0 + t) * 1024 + c] = hb;
        }
    }
    __syncthreads();
#pragma unroll
    for (int t = 0; t < 16; ++t) {
        const float a = wave_sum(s1[t]), b2 = wave_sum(s2[t]);
        if (lane == 0) { red[(wid * 16 + t) * 2] = a; red[(wid * 16 + t) * 2 + 1] = b2; }
    }
    __syncthreads();
#pragma unroll 1
    for (int ps = 0; ps < 4; ++ps) {
        const int c = ps * 256 + tid;
        const float g = ((const float*)p.in[I_CLNG])[l * 1024 + c], bb = ((const float*)p.in[I_CLNB])[l * 1024 + c];
#pragma unroll
        for (int t = 0; t < 16; ++t) {
            const float a = red[t * 2] + red[(16 + t) * 2] + red[(32 + t) * 2] + red[(48 + t) * 2];
            const float b2 = red[t * 2 + 1] + red[(16 + t) * 2 + 1] + red[(32 + t) * 2 + 1] + red[(48 + t) * 2 + 1];
            const float mean = a * (1.0f / 1024.0f), var = fmaxf(b2 * (1.0f / 1024.0f) - mean * mean, 0.f);
            const float y = bf2f(out[(size_t)(t0 + t) * 1024 + c]);
            const float yn = (y - mean) * rsqrtf(var + 1e-5f) * g + bb;
            out[(size_t)(t0 + t) * 1024 + c] = f2bf(siluf_(yn));
        }
    }
}

constexpr int NSEG = 4, SEGLEN = SEQ / NSEG;
constexpr int SCAN_BUF = 5 * 1024 + 512;
constexpr size_t OFF_FS = 497 * MiB;
static_assert((size_t)NB * 16 * NSEG * 2 * 4096 * 4 <= 15 * MiB, "segment state region");
DI float row8_sum(float x) { x += dpp_f<0xB1>(x); x += dpp_f<0x4E>(x); x += dpp_f<0x141>(x); return x; }
enum { SCAN_PASS1 = 0, SCAN_PASS1_DATA = 1, SCAN_FINAL = 2 };
struct StepVec { f32x2 w[4], a[4], b[4], k[4], r[4]; float v; };
DI f32x2 v2lo(f32x4 v) { return __builtin_shufflevector(v, v, 0, 1); }
DI f32x2 v2hi(f32x4 v) { return __builtin_shufflevector(v, v, 2, 3); }
DI void ld4pairs(const float* q, f32x2 (&d)[4]) { const f32x4 x = *(const f32x4*)q, y = *(const f32x4*)(q + 4); d[0] = v2lo(x); d[1] = v2hi(x); d[2] = v2lo(y); d[3] = v2hi(y); }

template <int MODE>
DI void scan_block(const Params& p, int l, int b, int hh, int seg, int half, char* lds) {
    const int tid = threadIdx.x;
    const int il = tid >> 3, cgp = tid & 7;
    const int ts = tid >> 4, jg = tid & 15;
    float* bufs = (float*)lds;
    float* ybuf = bufs + 2 * SCAN_BUF;
    const bf16_t* ZR = (const bf16_t*)(p.ws + OFF_ZR);
    const bf16_t* Ab = (const bf16_t*)(p.ws + OFF_A);
    const bf16_t* Lb = (const bf16_t*)(p.ws + OFF_LW);
    bf16_t* YS = (bf16_t*)(p.ws + OFF_YS);
    float* FS = (float*)(p.ws + OFF_FS) + (size_t)((b * 16 + hh) * NSEG) * 2 * 4096;
    const float* mu = (const float*)p.in[I_MU] + (size_t)l * RWKV_LD;
    const int ncol = hh * 64 + jg * 4;
    const f32x4 kkv = *(const f32x4*)((const float*)p.in[I_KK] + l * 1024 + ncol);
    const f32x4 kav = *(const f32x4*)((const float*)p.in[I_KA] + l * 1024 + ncol);
    const int tokb = b * SEQ + seg * SEGLEN;
    float rr[4], kk[4], vv[4]; u32x2 av, lv;
    auto stage_load = [&](int c) {
        const int tok = tokb + c * 16 + ts;
        if (MODE == SCAN_FINAL) zr_shift4(ZR, mu, tok, ncol, rr);
        zr_shift4(ZR, mu, tok, 1024 + ncol, kk);
        zr_shift4(ZR, mu, tok, 2048 + ncol, vv);
        av = *(const u32x2*)(Ab + (size_t)tok * 1024 + ncol); lv = *(const u32x2*)(Lb + (size_t)tok * 1024 + ncol);
    };
    auto stage_write = [&](float* buf) {
        float a[4], lw[4]; unpack4(av, a); unpack4(lv, lw);
        float kq[4], ss = 0.f;
#pragma unroll
        for (int e = 0; e < 4; ++e) { kq[e] = kk[e] * kkv[e]; ss += kq[e] * kq[e]; }
        ss = row16_sum(ss);
        const float inv = 1.0f / fmaxf(sqrtf(ss), 1e-12f);
        f32x4 W4, K4, A4, B4, R4;
#pragma unroll
        for (int e = 0; e < 4; ++e) {
            const float kf = kq[e] * inv;
            W4[e] = __expf(lw[e]); K4[e] = kk[e] * (1.0f + (a[e] - 1.0f) * kav[e]); A4[e] = -kf; B4[e] = kf * a[e]; R4[e] = MODE == SCAN_FINAL ? rr[e] : 0.f;
        }
        float* bp = buf + ts * 64 + jg * 4;
        *(f32x4*)(bp) = W4; *(f32x4*)(bp + 1024) = K4; *(f32x4*)(bp + 2048) = A4; *(f32x4*)(bp + 3072) = B4;
        if ((jg >> 3) == half) *(f32x4*)(buf + 5120 + ts * 32 + (jg & 7) * 4) = (f32x4){vv[0], vv[1], vv[2], vv[3]};
        if (MODE == SCAN_FINAL) *(f32x4*)(bp + 4096) = R4;
    };
    f32x2 S[4], P[4];
#pragma unroll
    for (int q = 0; q < 4; ++q) {
        S[q] = (f32x2){0.f, 0.f};
        P[q] = (f32x2){((half * 32 + il) == cgp * 8 + 2 * q) ? 1.0f : 0.f, ((half * 32 + il) == cgp * 8 + 2 * q + 1) ? 1.0f : 0.f};
    }
    __syncthreads();
    if (MODE == SCAN_FINAL && seg > 0) {
        float* srow = (float*)lds;
        for (int q = 0; q < seg; ++q) {
            const float* Zq = FS + (size_t)(q * 2 + 0) * 4096 + (size_t)(half * 32 + il) * 64 + cgp * 8;
            const float* Pq = FS + (size_t)(q * 2 + 1) * 4096 + cgp * 8;
            *(f32x4*)(srow + il * 64 + cgp * 8) = (f32x4){S[0].x, S[0].y, S[1].x, S[1].y};
            *(f32x4*)(srow + il * 64 + cgp * 8 + 4) = (f32x4){S[2].x, S[2].y, S[3].x, S[3].y};
            __syncthreads();
            f32x4 n0 = *(const f32x4*)Zq, n1 = *(const f32x4*)(Zq + 4);
            if (q > 0)
#pragma unroll 4
            for (int m = 0; m < 64; ++m) {
                const float sm = srow[il * 64 + m];
                n0 += sm * *(const f32x4*)(Pq + (size_t)m * 64); n1 += sm * *(const f32x4*)(Pq + (size_t)m * 64 + 4);
            }
            __syncthreads();
            S[0] = v2lo(n0); S[1] = v2hi(n0); S[2] = v2lo(n1); S[3] = v2hi(n1);
        }
    }
    stage_load(0); stage_write(bufs);
    __syncthreads();
    constexpr int NCH = SEGLEN / 16;
    for (int c = 0; c < NCH; ++c) {
        const float* buf = bufs + (c & 1) * SCAN_BUF;
        float* yb = ybuf + (c & 1) * 512;
        if (MODE == SCAN_FINAL && c > 0) {
            const float* yp = ybuf + ((c - 1) & 1) * 512;
#pragma unroll
            for (int q = 0; q < 2; ++q) { const int idx = tid + 256 * q; YS[(size_t)(tokb + (c - 1) * 16 + (idx >> 5)) * 1024 + hh * 64 + half * 32 + (idx & 31)] = f2bf(yp[idx]); }
        }
        if (c + 1 < NCH) stage_load(c + 1);
        float ykeep0 = 0.f, ykeep1 = 0.f;
        auto ldstep = [&](int t, StepVec& sv) {
            const float* bp = buf + t * 64 + cgp * 8;
            ld4pairs(bp, sv.w); ld4pairs(bp + 1024, sv.k); ld4pairs(bp + 2048, sv.a); ld4pairs(bp + 3072, sv.b);
            if (MODE == SCAN_FINAL) ld4pairs(bp + 4096, sv.r);
            sv.v = buf[5120 + t * 32 + il];
        };
        StepVec sv[2];
        ldstep(0, sv[0]);
#pragma unroll 2
        for (int t = 0; t < 16; ++t) {
            ldstep(t + 1, sv[(t + 1) & 1]);
            const StepVec& x = sv[t & 1];
            f32x2 d2 = S[0] * x.a[0]; d2 = S[1] * x.a[1] + d2; d2 = S[2] * x.a[2] + d2; d2 = S[3] * x.a[3] + d2;
            float sa = d2.x + d2.y;
            const f32x2 vv2 = (f32x2){x.v, x.v};
            f32x2 tq[4];
#pragma unroll
            for (int e = 0; e < 4; ++e) tq[e] = S[e] * x.w[e] + vv2 * x.k[e];
            sa = row8_sum(sa);
            const f32x2 sa2 = (f32x2){sa, sa};
#pragma unroll
            for (int e = 0; e < 4; ++e) S[e] = tq[e] + sa2 * x.b[e];
            if (MODE == SCAN_PASS1) {
                f32x2 e2 = P[0] * x.a[0]; e2 = P[1] * x.a[1] + e2; e2 = P[2] * x.a[2] + e2; e2 = P[3] * x.a[3] + e2;
                float pa = e2.x + e2.y;
                f32x2 pq[4];
#pragma unroll
                for (int e = 0; e < 4; ++e) pq[e] = P[e] * x.w[e];
                pa = row8_sum(pa);
                const f32x2 pa2 = (f32x2){pa, pa};
#pragma unroll
                for (int e = 0; e < 4; ++e) P[e] = pq[e] + pa2 * x.b[e];
            }
            if (MODE == SCAN_FINAL) {
                f32x2 y2 = S[0] * x.r[0]; y2 = S[1] * x.r[1] + y2; y2 = S[2] * x.r[2] + y2; y2 = S[3] * x.r[3] + y2;
                float y = y2.x + y2.y;
                y = row8_sum(y);
                if (cgp == (t & 7)) { if (t < 8) ykeep0 = y; else ykeep1 = y; }
            }
            __builtin_amdgcn_sched_barrier(0);
        }
        if (MODE == SCAN_FINAL) { yb[cgp * 32 + il] = ykeep0; yb[(cgp + 8) * 32 + il] = ykeep1; }
        if (c + 1 < NCH) stage_write(bufs + ((c + 1) & 1) * SCAN_BUF);
        __syncthreads();
    }
    if (MODE == SCAN_FINAL) {
        const float* yp = ybuf + ((NCH - 1) & 1) * 512;
#pragma unroll
        for (int q = 0; q < 2; ++q) { const int idx = tid + 256 * q; YS[(size_t)(tokb + (NCH - 1) * 16 + (idx >> 5)) * 1024 + hh * 64 + half * 32 + (idx & 31)] = f2bf(yp[idx]); }
    } else {
        float* dz = FS + (size_t)(seg * 2 + 0) * 4096 + (size_t)(half * 32 + il) * 64 + cgp * 8;
        *(f32x4*)dz = (f32x4){S[0].x, S[0].y, S[1].x, S[1].y}; *(f32x4*)(dz + 4) = (f32x4){S[2].x, S[2].y, S[3].x, S[3].y};
        if (MODE == SCAN_PASS1) {
            float* dp = FS + (size_t)(seg * 2 + 1) * 4096 + (size_t)(half * 32 + il) * 64 + cgp * 8;
            *(f32x4*)dp = (f32x4){P[0].x, P[0].y, P[1].x, P[1].y}; *(f32x4*)(dp + 4) = (f32x4){P[2].x, P[2].y, P[3].x, P[3].y};
        }
    }
}
constexpr int N_SCAN1 = 64 * (NSEG - 1), N_SCAN2 = 64 * NSEG;
DI void scan_item_pass1(const Params& p, int l, int it, char* lds) {
    const int half = it & 1, bh = (it >> 1) & 31, seg = (NSEG - 2) - (it >> 6);
    if (seg == 0) scan_block<SCAN_PASS1_DATA>(p, l, bh >> 4, bh & 15, seg, half, lds);
    else scan_block<SCAN_PASS1>(p, l, bh >> 4, bh & 15, seg, half, lds);
}
DI void scan_item_pass2(const Params& p, int l, int it, char* lds) {
    const int half = it & 1, bh = (it >> 1) & 31, seg = it >> 6;
    scan_block<SCAN_FINAL>(p, l, bh >> 4, bh & 15, seg, half, lds);
}

namespace cs {
constexpr int LDA = 72, LDB = 40;
constexpr int O_LW = 0;
constexpr int O_AT = O_LW + 4096;
constexpr int O_RT = O_AT + 16 * LDA * 2;
constexpr int O_BG = O_RT + 16 * LDA * 2;
constexpr int O_KG = O_BG + 16 * LDA * 2;
constexpr int O_BKT = O_KG + 16 * LDA * 2;
constexpr int O_UV = O_BKT + 64 * LDB * 2;
constexpr int O_XA = O_UV + 64 * LDB * 2;
constexpr int O_SA = O_XA + 64 * LDB * 2;
constexpr int O_ABB = O_SA + 64 * LDA * 2;
constexpr int O_AKB = O_ABB + 16 * 17 * 4 + 64;
constexpr int O_BRK = O_AKB + 16 * LDB * 2;
constexpr int O_TT = O_BRK + 16 * LDB * 2;
constexpr int O_G15 = O_TT + 64 * LDB * 2;
constexpr int O_END = O_G15 + 256;
static_assert(O_END <= 60000, "chunked-scan LDS map");
}
constexpr size_t OFF_TTG = 497 * MiB;
DI void scan_T_item(const Params& p, int l, int item, char* lds) {
    using namespace cs;
    const int tid = threadIdx.x, lane = tid & 63, wv = tid >> 6, fr = lane & 15, fq = lane >> 4;
    const int bh = item >> 7, grp = item & 127, b = bh >> 4, hh = bh & 15;
    const int ts = tid >> 4, jg = tid & 15;
    const bf16_t* ZR = (const bf16_t*)(p.ws + OFF_ZR);
    const bf16_t* Ab = (const bf16_t*)(p.ws + OFF_A);
    const bf16_t* Lb = (const bf16_t*)(p.ws + OFF_LW);
    const float* mu = (const float*)p.in[I_MU] + (size_t)l * RWKV_LD;
    const int ncol = hh * 64 + jg * 4;
    const f32x4 kkv = *(const f32x4*)((const float*)p.in[I_KK] + l * 1024 + ncol);
    float* sLW = (float*)lds;
    bf16_t* sA = (bf16_t*)(lds + 16384);
    bf16_t* sB = sA + 4 * 16 * LDA;
    float an[4][4], bn[4][4], lw[4][4];
    __syncthreads();
#pragma unroll
    for (int q = 0; q < 4; ++q) {
        const int tok = b * SEQ + (grp * 4 + q) * 16 + ts;
        float kk[4], a[4];
        zr_shift4(ZR, mu, tok, 1024 + ncol, kk);
        unpack4(*(const u32x2*)(Ab + (size_t)tok * 1024 + ncol), a);
        unpack4(*(const u32x2*)(Lb + (size_t)tok * 1024 + ncol), lw[q]);
        float kq[4], ss = 0.f;
#pragma unroll
        for (int e = 0; e < 4; ++e) { kq[e] = kk[e] * kkv[e]; ss += kq[e] * kq[e]; }
        ss = row16_sum(ss);
        const float inv = 1.0f / fmaxf(sqrtf(ss), 1e-12f);
#pragma unroll
        for (int e = 0; e < 4; ++e) { const float kf = kq[e] * inv; an[q][e] = -kf; bn[q][e] = kf * a[e]; }
        *(f32x4*)(sLW + (q * 16 + ts) * 64 + jg * 4) = (f32x4){lw[q][0], lw[q][1], lw[q][2], lw[q][3]};
    }
    __syncthreads();
#pragma unroll
    for (int q = 0; q < 4; ++q) {
        f32x4 pin = (f32x4){0.f, 0.f, 0.f, 0.f};
#pragma unroll
        for (int t = 0; t < 16; ++t) { const f32x4 x = *(const f32x4*)(sLW + (q * 16 + t) * 64 + jg * 4); if (t <= ts) pin += x; }
        float at4[4], bt4[4];
#pragma unroll
        for (int e = 0; e < 4; ++e) { at4[e] = an[q][e] * __expf(pin[e] - lw[q][e]); bt4[e] = bn[q][e] * __expf(-pin[e]); }
        *(u32x2*)(sA + (q * 16 + ts) * LDA + jg * 4) = pack4(at4[0], at4[1], at4[2], at4[3]);
        *(u32x2*)(sB + (q * 16 + ts) * LDA + jg * 4) = pack4(bt4[0], bt4[1], bt4[2], bt4[3]);
    }
    __syncthreads();
    f32x4 cg = (f32x4){0.f, 0.f, 0.f, 0.f};
#pragma unroll
    for (int ks = 0; ks < 2; ++ks) cg = MFMA16(*(const bf16x8*)(sB + (wv * 16 + fr) * LDA + ks * 32 + fq * 8), *(const bf16x8*)(sA + (wv * 16 + fr) * LDA + ks * 32 + fq * 8), cg);
#pragma unroll
    for (int r = 0; r < 4; ++r) if (fq * 4 + r >= fr) cg[r] = 0.f;
    float Tr[16];
#pragma unroll
    for (int sidx = 15; sidx >= 0; --sidx) {
        float acc = (sidx == fr) ? 1.0f : 0.f;
#pragma unroll
        for (int m = sidx + 1; m < 16; ++m) {
            const float asm_ = __int_as_float(__builtin_amdgcn_readlane(__float_as_int(cg[sidx & 3]), (sidx >> 2) * 16 + m));
            acc += asm_ * Tr[m];
        }
        Tr[sidx] = acc;
    }
    if (fq == 0) {
        bf16_t* dst = (bf16_t*)(p.ws + OFF_TTG) + ((size_t)(bh * 512 + grp * 4 + wv) * 16 + fr) * 16;
        u32x4 w0, w1;
        w0.x = pk2(Tr[0], Tr[1]); w0.y = pk2(Tr[2], Tr[3]); w0.z = pk2(Tr[4], Tr[5]); w0.w = pk2(Tr[6], Tr[7]);
        w1.x = pk2(Tr[8], Tr[9]); w1.y = pk2(Tr[10], Tr[11]); w1.z = pk2(Tr[12], Tr[13]); w1.w = pk2(Tr[14], Tr[15]);
        *(u32x4*)dst = w0; *(u32x4*)(dst + 8) = w1;
    }
}
constexpr int MSEG = 4, MCPS = (SEQ / 16) / MSEG;
constexpr size_t OFF_FS2 = 506 * MiB;
enum { MS_FINAL = 0, MS_DATA1 = 1, MS_IDENT = 2 };
template <int MODE>
DI void scan_mfma_block(const Params& p, int l, int b, int hh, int seg, char* lds) {
    using namespace cs;
    const int tid = threadIdx.x, lane = tid & 63, wv = tid >> 6, fr = lane & 15, fq = lane >> 4;
    const int ts = tid >> 4, jg = tid & 15;
    const bf16_t* ZR = (const bf16_t*)(p.ws + OFF_ZR);
    const bf16_t* Ab = (const bf16_t*)(p.ws + OFF_A);
    const bf16_t* Lb = (const bf16_t*)(p.ws + OFF_LW);
    const bf16_t* TTg = (const bf16_t*)(p.ws + OFF_TTG) + (size_t)((b * 16 + hh) * 512) * 256;
    bf16_t* YS = (bf16_t*)(p.ws + OFF_YS);
    const float* mu = (const float*)p.in[I_MU] + (size_t)l * RWKV_LD;
    const int ncol = hh * 64 + jg * 4;
    const f32x4 kkv = *(const f32x4*)((const float*)p.in[I_KK] + l * 1024 + ncol);
    const f32x4 kav = *(const f32x4*)((const float*)p.in[I_KA] + l * 1024 + ncol);
    float* sLW = (float*)(lds + O_LW);
    bf16_t* sAT = (bf16_t*)(lds + O_AT); bf16_t* sRT = (bf16_t*)(lds + O_RT); bf16_t* sBG = (bf16_t*)(lds + O_BG); bf16_t* sKG = (bf16_t*)(lds + O_KG);
    bf16_t* sBKT = (bf16_t*)(lds + O_BKT);
    bf16_t* sUV = (bf16_t*)(lds + O_UV) + wv * 16 * LDB; bf16_t* sXA = (bf16_t*)(lds + O_XA) + wv * 16 * LDB; bf16_t* sSA = (bf16_t*)(lds + O_SA) + wv * 16 * LDA;
    bf16_t* sAKB = (bf16_t*)(lds + O_AKB); bf16_t* sBRK = (bf16_t*)(lds + O_BRK);
    float* sG15 = (float*)(lds + O_G15);
    __syncthreads();
    for (int i = tid; i < O_END / 4; i += NTHREADS) ((unsigned*)lds)[i] = 0u;
    f32x4 S[4];
#pragma unroll
    for (int cb = 0; cb < 4; ++cb)
#pragma unroll
        for (int r = 0; r < 4; ++r) S[cb][r] = (MODE == MS_IDENT && (wv * 16 + fq * 4 + r) == (cb * 16 + fr)) ? 1.0f : 0.f;
    float* FS = (float*)(p.ws + OFF_FS2) + (size_t)((b * 16 + hh) * (MSEG - 1)) * 2 * 4096;
    if (MODE == MS_FINAL && seg > 0) {
        float* sS = (float*)lds + wv * 1024;
        for (int q = 0; q < seg; ++q) {
            const float* Zq = FS + (size_t)(q * 2 + 0) * 4096;
            const float* Pq = FS + (size_t)(q * 2 + 1) * 4096;
            f32x4 nw[4];
#pragma unroll
            for (int cb = 0; cb < 4; ++cb)
#pragma unroll
                for (int r = 0; r < 4; ++r) nw[cb][r] = Zq[(size_t)(wv * 16 + fq * 4 + r) * 64 + cb * 16 + fr];
            if (q > 0) {
                __syncthreads();
#pragma unroll
                for (int cb = 0; cb < 4; ++cb)
#pragma unroll
                    for (int r = 0; r < 4; ++r) sS[(fq * 4 + r) * 64 + cb * 16 + fr] = S[cb][r];
                __syncthreads();
#pragma unroll 1
                for (int m = 0; m < 64; ++m) {
                    const float p0 = Pq[m * 64 + fr], p1 = Pq[m * 64 + 16 + fr], p2 = Pq[m * 64 + 32 + fr], p3 = Pq[m * 64 + 48 + fr];
#pragma unroll
                    for (int r = 0; r < 4; ++r) { const float sm = sS[(fq * 4 + r) * 64 + m]; nw[0][r] += sm * p0; nw[1][r] += sm * p1; nw[2][r] += sm * p2; nw[3][r] += sm * p3; }
                }
            }
#pragma unroll
            for (int cb = 0; cb < 4; ++cb) S[cb] = nw[cb];
        }
        __syncthreads();
        for (int i = tid; i < 4096; i += NTHREADS) ((unsigned*)lds)[i] = 0u;
        __syncthreads();
#pragma unroll
        for (int cb = 0; cb < 4; ++cb)
#pragma unroll
            for (int r = 0; r < 4; ++r) sSA[(fq * 4 + r) * LDA + cb * 16 + fr] = f2bf(S[cb][r]);
    } else if (MODE == MS_IDENT) {
        __syncthreads();
#pragma unroll
        for (int cb = 0; cb < 4; ++cb)
#pragma unroll
            for (int r = 0; r < 4; ++r) sSA[(fq * 4 + r) * LDA + cb * 16 + fr] = f2bf(S[cb][r]);
    }
    const int tokb = b * SEQ + seg * MCPS * 16;
    float rr[4], kk[4], vv[4]; u32x2 av, lv; u32x4 tq;
    auto stage_load = [&](int c) {
        const int tok = tokb + c * 16 + ts;
        zr_shift4(ZR, mu, tok, ncol, rr); zr_shift4(ZR, mu, tok, 1024 + ncol, kk); zr_shift4(ZR, mu, tok, 2048 + ncol, vv);
        av = *(const u32x2*)(Ab + (size_t)tok * 1024 + ncol); lv = *(const u32x2*)(Lb + (size_t)tok * 1024 + ncol);
        tq = *(const u32x4*)(TTg + (size_t)(seg * MCPS + c) * 256 + fr * 16 + (fq & 1) * 8);
    };
    stage_load(0);
    for (int c = 0; c < MCPS; ++c) {
        float a[4], lw[4]; unpack4(av, a); unpack4(lv, lw);
        float kq[4], ss = 0.f;
#pragma unroll
        for (int e = 0; e < 4; ++e) { kq[e] = kk[e] * kkv[e]; ss += kq[e] * kq[e]; }
        ss = row16_sum(ss);
        const float inv = 1.0f / fmaxf(sqrtf(ss), 1e-12f);
        float kn[4], an[4], bn[4], rn[4], vn[4];
#pragma unroll
        for (int e = 0; e < 4; ++e) { const float kf = kq[e] * inv; kn[e] = kk[e] * (1.0f + (a[e] - 1.0f) * kav[e]); an[e] = -kf; bn[e] = kf * a[e]; rn[e] = rr[e]; vn[e] = vv[e]; }
        const bf16x8 tfrag = fq < 2 ? __builtin_bit_cast(bf16x8, tq) : (bf16x8){0, 0, 0, 0, 0, 0, 0, 0};
        *(f32x4*)(sLW + ts * 64 + jg * 4) = (f32x4){lw[0], lw[1], lw[2], lw[3]};
        if (c + 1 < MCPS) stage_load(c + 1);
        __syncthreads();
        f32x4 pin = (f32x4){0.f, 0.f, 0.f, 0.f}, pall = pin;
#pragma unroll
        for (int t = 0; t < 16; ++t) { const f32x4 x = *(const f32x4*)(sLW + t * 64 + jg * 4); pall += x; if (t <= ts) pin += x; }
        {
            float at4[4], rt4[4], bt4[4], kt4[4];
#pragma unroll
            for (int e = 0; e < 4; ++e) {
                const float g = __expf(pin[e]), gp = __expf(pin[e] - lw[e]), gi = __expf(-pin[e]);
                at4[e] = an[e] * gp; rt4[e] = rn[e] * g; bt4[e] = bn[e] * gi; kt4[e] = kn[e] * gi;
            }
            *(u32x2*)(sAT + ts * LDA + jg * 4) = pack4(at4[0], at4[1], at4[2], at4[3]);
            *(u32x2*)(sRT + ts * LDA + jg * 4) = pack4(rt4[0], rt4[1], rt4[2], rt4[3]);
            *(u32x2*)(sBG + ts * LDA + jg * 4) = pack4(bt4[0], bt4[1], bt4[2], bt4[3]);
            *(u32x2*)(sKG + ts * LDA + jg * 4) = pack4(kt4[0], kt4[1], kt4[2], kt4[3]);
#pragma unroll
            for (int e = 0; e < 4; ++e) {
                sBKT[(jg * 4 + e) * LDB + ts] = f2bf(bt4[e]); sBKT[(jg * 4 + e) * LDB + 16 + ts] = f2bf(kt4[e]);
                if (MODE != MS_IDENT) ((bf16_t*)(lds + O_UV))[((jg >> 2) * 16 + (jg & 3) * 4 + e) * LDB + 16 + ts] = f2bf(vn[e]);
            }
            if (ts == 15) *(f32x4*)(sG15 + jg * 4) = (f32x4){__expf(pall[0]), __expf(pall[1]), __expf(pall[2]), __expf(pall[3])};
        }
        __syncthreads();
        if (wv != 0) {
            const bf16_t* P = (wv & 1) ? sKG : sBG;
            const bf16_t* Q = (wv & 2) ? sRT : sAT;
            f32x4 cg = (f32x4){0.f, 0.f, 0.f, 0.f};
#pragma unroll
            for (int ks = 0; ks < 2; ++ks) cg = MFMA16(*(const bf16x8*)(P + fr * LDA + ks * 32 + fq * 8), *(const bf16x8*)(Q + fr * LDA + ks * 32 + fq * 8), cg);
#pragma unroll
            for (int r = 0; r < 4; ++r) { const int sidx = fq * 4 + r; const bool keep = (wv & 2) ? (sidx <= fr) : (sidx < fr); if (!keep) cg[r] = 0.f; }
            if (wv == 1) *(u32x2*)(sAKB + fr * LDB + 16 + fq * 4) = pack4(cg[0], cg[1], cg[2], cg[3]);
            else if (wv == 2) *(u32x2*)(sBRK + fr * LDB + fq * 4) = pack4(cg[0], cg[1], cg[2], cg[3]);
            else *(u32x2*)(sBRK + fr * LDB + 16 + fq * 4) = pack4(cg[0], cg[1], cg[2], cg[3]);
        }
        __syncthreads();
        f32x4 x1 = (f32x4){0.f, 0.f, 0.f, 0.f}, yv = x1;
        {
            const bf16x8 s0 = *(const bf16x8*)(sSA + fr * LDA + fq * 8), s1 = *(const bf16x8*)(sSA + fr * LDA + 32 + fq * 8);
            const bf16x8 uv = *(const bf16x8*)(sUV + fr * LDB + fq * 8);
            x1 = MFMA16(s0, *(const bf16x8*)(sAT + fr * LDA + fq * 8), x1);
            x1 = MFMA16(s1, *(const bf16x8*)(sAT + fr * LDA + 32 + fq * 8), x1);
            x1 = MFMA16(uv, *(const bf16x8*)(sAKB + fr * LDB + fq * 8), x1);
            yv = MFMA16(s0, *(const bf16x8*)(sRT + fr * LDA + fq * 8), yv);
            yv = MFMA16(s1, *(const bf16x8*)(sRT + fr * LDA + 32 + fq * 8), yv);
        }
#pragma unroll
        for (int r = 0; r < 4; ++r) sXA[(fq * 4 + r) * LDB + fr] = f2bf(x1[r]);
        asm volatile("s_waitcnt lgkmcnt(0)" ::: "memory");
        f32x4 u = (f32x4){0.f, 0.f, 0.f, 0.f};
        u = MFMA16(*(const bf16x8*)(sXA + fr * LDB + fq * 8), tfrag, u);
#pragma unroll
        for (int r = 0; r < 4; ++r) sUV[(fq * 4 + r) * LDB + fr] = f2bf(u[r]);
        asm volatile("s_waitcnt lgkmcnt(0)" ::: "memory");
        {
            const bf16x8 uv = *(const bf16x8*)(sUV + fr * LDB + fq * 8);
            yv = MFMA16(uv, *(const bf16x8*)(sBRK + fr * LDB + fq * 8), yv);
#pragma unroll
            for (int cb = 0; cb < 4; ++cb) S[cb] = MFMA16(uv, *(const bf16x8*)(sBKT + (cb * 16 + fr) * LDB + fq * 8), S[cb]);
        }
        if (MODE == MS_FINAL) *(u32x2*)(YS + (size_t)(tokb + c * 16 + fr) * 1024 + hh * 64 + wv * 16 + fq * 4) = pack4(yv[0], yv[1], yv[2], yv[3]);
#pragma unroll
        for (int cb = 0; cb < 4; ++cb) {
            const float g15 = sG15[cb * 16 + fr];
#pragma unroll
            for (int r = 0; r < 4; ++r) { S[cb][r] *= g15; sSA[(fq * 4 + r) * LDA + cb * 16 + fr] = f2bf(S[cb][r]); }
        }
    }
    if (MODE != MS_FINAL) {
        float* dst = FS + (size_t)(seg * 2 + (MODE == MS_IDENT ? 1 : 0)) * 4096;
#pragma unroll
        for (int cb = 0; cb < 4; ++cb)
#pragma unroll
            for (int r = 0; r < 4; ++r) dst[(size_t)(wv * 16 + fq * 4 + r) * 64 + cb * 16 + fr] = S[cb][r];
    }
}
constexpr int N_MS1 = 32 * (1 + 2 * (MSEG - 2)), N_MS2 = 32 * MSEG;
DI void ms_item_pass1(const Params& p, int l, int it, char* lds) {
    const int bh = it & 31, k = it >> 5;
    if (k & 1) scan_mfma_block<MS_IDENT>(p, l, bh >> 4, bh & 15, (k + 1) >> 1, lds);
    else scan_mfma_block<MS_DATA1>(p, l, bh >> 4, bh & 15, k >> 1, lds);
}
DI void ms_item_pass2(const Params& p, int l, int it, char* lds) {
    const int bh = it & 31, seg = it >> 5;
    scan_mfma_block<MS_FINAL>(p, l, bh >> 4, bh & 15, seg, lds);
}

constexpr int ATT_LDK = 72;
DI void attn_unit(const Params& p, int l, int unit, char* lds) {
    const int tid = threadIdx.x, lane = tid & 63, wid = tid >> 6, c = wid >> 1, qs = wid & 1, r32 = lane & 31, h = lane >> 5;
    const int qb = 127 - (unit >> 4), bh = unit & 15, hh = bh & 7, b = bh >> 3;
    const bf16_t* Qg = (const bf16_t*)(p.ws + OFF_Q);
    const bf16_t* Kg = (const bf16_t*)(p.ws + OFF_K);
    const bf16_t* VTg = (const bf16_t*)(p.ws + OFF_VT) + (size_t)bh * 128 * 8192;
    const int query = qb * 64 + qs * 32 + r32;
    bf16x8 qf[4];
#pragma unroll
    for (int ks = 0; ks < 4; ++ks) qf[ks] = *(const bf16x8*)(Qg + ((size_t)(bh * 2 + c) * SEQ + query) * 64 + ks * 16 + h * 8);
    auto issue = [&](int kt) {
        char* st = lds + (kt & 1) * 32768 + tid * 16;
#pragma unroll
        for (int i = 0; i < 4; ++i) {
            const int bb = tid * 16 + i * 4096, cm = bb >> 13, row = (bb >> 7) & 63, kc = ((bb >> 4) & 7) ^ ((row >> 1) & 7);
            __builtin_amdgcn_global_load_lds((const unsigned*)(Kg + ((size_t)(bh * 2 + cm) * SEQ + kt * 64 + row) * 64 + kc * 8), (LDSP unsigned*)(st + i * 4096), 16, 0, 0);
            __builtin_amdgcn_global_load_lds((const unsigned*)(VTg + (size_t)kt * 8192 + (tid + 256 * i) * 8), (LDSP unsigned*)(st + 16384 + i * 4096), 16, 0, 0);
        }
    };
    f32x16 O[4];
#pragma unroll
    for (int d = 0; d < 4; ++d)
#pragma unroll
        for (int e = 0; e < 16; ++e) O[d][e] = 0.f;
    float m_run = -INFINITY, lsum = 0.f;
    const int kswz = (r32 >> 1) & 7;
    issue(0);
    for (int kt = 0; kt <= qb; ++kt) {
        asm volatile("s_waitcnt vmcnt(0)" ::: "memory");
        __syncthreads();
        if (kt < qb) issue(kt + 1);
        const char* sKb = lds + (kt & 1) * 32768;
        const bf16_t* sVT = (const bf16_t*)(sKb + 16384);
        f32x16 st[2];
#pragma unroll
        for (int kb = 0; kb < 2; ++kb) {
#pragma unroll
            for (int e = 0; e < 16; ++e) st[kb][e] = 0.f;
#pragma unroll
            for (int ks = 0; ks < 4; ++ks) {
                const bf16x8 kf = *(const bf16x8*)(sKb + (c * 64 + kb * 32 + r32) * 128 + (((ks * 2 + h) ^ kswz) << 4));
                st[kb] = MFMA32(kf, qf[ks], st[kb]);
            }
        }
        if (kt == qb) {
            const int ql = qs * 32 + r32;
#pragma unroll
            for (int kb = 0; kb < 2; ++kb)
#pragma unroll
                for (int e = 0; e < 16; ++e) { const int keyl = kb * 32 + (e & 3) + 8 * (e >> 2) + 4 * h; if (keyl > ql) st[kb][e] = -INFINITY; }
        }
        float mx = st[0][0];
#pragma unroll
        for (int kb = 0; kb < 2; ++kb)
#pragma unroll
            for (int e = 0; e < 16; ++e) mx = fmaxf(mx, st[kb][e]);
        mx = fmaxf(mx, __shfl_xor(mx, 32));
        if (__any(mx > m_run + 8.0f)) {
            const float mnew = fmaxf(m_run, mx);
            const float alpha = __builtin_amdgcn_exp2f(m_run - mnew);
            m_run = mnew;
            lsum *= alpha;
#pragma unroll
            for (int d = 0; d < 4; ++d)
#pragma unroll
                for (int e = 0; e < 16; ++e) O[d][e] *= alpha;
        }
        float ps = 0.f;
#pragma unroll
        for (int kb = 0; kb < 2; ++kb)
#pragma unroll
            for (int e = 0; e < 16; ++e) { st[kb][e] = __builtin_amdgcn_exp2f(st[kb][e] - m_run); ps += st[kb][e]; }
        lsum += ps;
        bf16x8 pf[2][2];
#pragma unroll
        for (int kb = 0; kb < 2; ++kb)
#pragma unroll
            for (int s = 0; s < 2; ++s) {
                u32x4 pk;
                pk.x = pk2(st[kb][8 * s + 0], st[kb][8 * s + 1]); pk.y = pk2(st[kb][8 * s + 2], st[kb][8 * s + 3]);
                pk.z = pk2(st[kb][8 * s + 4], st[kb][8 * s + 5]); pk.w = pk2(st[kb][8 * s + 6], st[kb][8 * s + 7]);
                pf[kb][s] = __builtin_bit_cast(bf16x8, pk);
            }
#pragma unroll
        for (int d = 0; d < 4; ++d)
#pragma unroll
            for (int kb = 0; kb < 2; ++kb)
#pragma unroll
                for (int s = 0; s < 2; ++s) {
                    const bf16x8 vf = *(const bf16x8*)(sVT + (((d * 2 + kb) * 2 + s) * 64 + lane) * 8);
                    O[d] = MFMA32(vf, pf[kb][s], O[d]);
                }
    }
    const float ltot = lsum + __shfl_xor(lsum, 32);
    const float inv = 1.0f / ltot;
    float* xo = (float*)lds;
    __syncthreads();
    if (c == 1) {
#pragma unroll
        for (int d = 0; d < 4; ++d)
#pragma unroll
            for (int e = 0; e < 16; ++e) xo[(qs * 64 + d * 16 + e) * 64 + lane] = O[d][e] * inv;
    }
    __syncthreads();
    if (c == 0) {
        const float lam = ((const float*)(p.ws + OFF_CTRL + CT_LAM))[l];
        const float lam_init = 0.8f - 0.6f * expf(-0.3f * (float)l);
        float ss = 0.f;
#pragma unroll
        for (int d = 0; d < 4; ++d)
#pragma unroll
            for (int e = 0; e < 16; ++e) { const float o = O[d][e] * inv - lam * xo[(qs * 64 + d * 16 + e) * 64 + lane]; O[d][e] = o; ss += o * o; }
        ss += __shfl_xor(ss, 32);
        const float rstd = rsqrtf(ss * (1.0f / 128.0f) + 1e-6f) * (1.0f - lam_init);
        bf16_t* outp = (bf16_t*)(p.ws + OFF_ATTP) + (size_t)(b * SEQ + query) * 1024 + hh * 128;
        const float* hg = (const float*)p.in[I_AHG] + (size_t)(l * 8 + hh) * 128;
#pragma unroll
        for (int d = 0; d < 4; ++d)
#pragma unroll
            for (int g4 = 0; g4 < 4; ++g4) {
                const int dv0 = d * 32 + 8 * g4 + 4 * h;
                const f32x4 g = *(const f32x4*)(hg + dv0);
                *(u32x2*)(outp + dv0) = pack4(O[d][g4 * 4 + 0] * rstd * g[0], O[d][g4 * 4 + 1] * rstd * g[1], O[d][g4 * 4 + 2] * rstd * g[2], O[d][g4 * 4 + 3] * rstd * g[3]);
            }
    }
}

DI void rwkv_post_tile(const Params& p, int l, int tile, char* lds) {
    const int tid = threadIdx.x, t0 = tile * 16, n4 = tid * 4;
    const bf16_t* ZR = (const bf16_t*)(p.ws + OFF_ZR);
    const bf16_t* Ab = (const bf16_t*)(p.ws + OFF_A);
    const bf16_t* YS = (const bf16_t*)(p.ws + OFF_YS);
    const float* mu = (const float*)p.in[I_MU] + (size_t)l * RWKV_LD;
    float* sg = (float*)lds;
    __syncthreads();
    {
        const int tk = tid >> 4, c8 = (tid & 15) * 8;
        float z[8]; zr_shift8(ZR, mu, t0 + tk, 3200 + c8, z);
#pragma unroll
        for (int e = 0; e < 8; ++e) sg[tk * 128 + c8 + e] = sigmoidf_(z[e]);
    }
    __syncthreads();
    f32x4 gacc[16];
#pragma unroll
    for (int t = 0; t < 16; ++t) gacc[t] = (f32x4){0.f, 0.f, 0.f, 0.f};
    const float* g2 = (const float*)p.in[I_G2] + (size_t)l * 128 * 1024 + n4;
#pragma unroll 2
    for (int k = 0; k < 128; k += 4) {
        const f32x4 w0 = *(const f32x4*)(g2 + (size_t)(k + 0) * 1024), w1 = *(const f32x4*)(g2 + (size_t)(k + 1) * 1024),
                    w2 = *(const f32x4*)(g2 + (size_t)(k + 2) * 1024), w3 = *(const f32x4*)(g2 + (size_t)(k + 3) * 1024);
#pragma unroll
        for (int t = 0; t < 16; ++t) {
            const f32x4 a = *(const f32x4*)(sg + t * 128 + k);
            gacc[t] += a[0] * w0 + a[1] * w1 + a[2] * w2 + a[3] * w3;
        }
    }
    const f32x4 kav = *(const f32x4*)((const float*)p.in[I_KA] + l * 1024 + n4);
    const f32x4 rkv = *(const f32x4*)((const float*)p.in[I_RK] + l * 1024 + n4);
    const f32x4 gng = *(const f32x4*)((const float*)p.in[I_GNG] + l * 1024 + n4);
    const f32x4 gnb = *(const f32x4*)((const float*)p.in[I_GNB] + l * 1024 + n4);
    bf16_t* out = (bf16_t*)(p.ws + OFF_RWKVP);
#pragma unroll
    for (int t = 0; t < 16; ++t) {
        const int tok = t0 + t;
        float r[4], k[4], v[4], a[4], y[4];
        zr_shift4(ZR, mu, tok, n4, r); zr_shift4(ZR, mu, tok, 1024 + n4, k); zr_shift4(ZR, mu, tok, 2048 + n4, v);
        unpack4(*(const u32x2*)(Ab + (size_t)tok * 1024 + n4), a);
        unpack4(*(const u32x2*)(YS + (size_t)tok * 1024 + n4), y);
        float cf = 0.f, s1 = 0.f, s2 = 0.f;
#pragma unroll
        for (int e = 0; e < 4; ++e) { const float kn = k[e] * (1.0f + (a[e] - 1.0f) * kav[e]); cf += r[e] * kn * rkv[e]; s1 += y[e]; s2 += y[e] * y[e]; }
        cf = row16_sum(cf); s1 = row16_sum(s1); s2 = row16_sum(s2);
        const float mean = s1 * (1.0f / 64.0f), var = fmaxf(s2 * (1.0f / 64.0f) - mean * mean, 0.f), rstd = rsqrtf(var + 64e-5f);
        float o[4];
#pragma unroll
        for (int e = 0; e < 4; ++e) o[e] = ((y[e] - mean) * rstd * gng[e] + gnb[e] + cf * v[e]) * gacc[t][e];
        *(u32x2*)(out + (size_t)tok * 1024 + n4) = pack4(o[0], o[1], o[2], o[3]);
    }
}

DI void phaseF_tile(const Params& p, int mt, int nt, char* lds) {
    const int tid = threadIdx.x, lane = tid & 63, wid = tid >> 6, wm = wid >> 1, wn = wid & 1, fr = lane & 15, fq = lane >> 4;
    const int m0 = mt * 128 + wm * 64, nb = nt * 128 + wn * 64;
    const bf16_t* ZG = (const bf16_t*)(p.ws + OFF_ZG);
    f32x4 sum[4][4]; zero_acc(sum);
#pragma unroll 1
    for (int br = 0; br < 3; ++br) {
        const size_t xoff = br == 0 ? OFF_ATTP : br == 1 ? OFF_CONVP : OFF_RWKVP;
        const size_t woff = br == 0 ? W_ATTO : br == 1 ? W_CONVO : W_RWKVO;
        f32x4 acc[4][4]; zero_acc(acc);
        gemm_mainloop<false>(acc, (const bf16_t*)(p.ws + xoff) + (size_t)mt * 128 * 1024, 1024, (const bf16_t*)(p.ws + OFF_W + woff) + (size_t)nt * 128 * 1024, 1024, 1024, lds);
#pragma unroll
        for (int ti = 0; ti < 4; ++ti) {
            const int tok = m0 + ti * 16 + fr;
#pragma unroll
            for (int ni = 0; ni < 4; ++ni) {
                float g[4]; unpack4(*(const u32x2*)(ZG + (size_t)tok * ZG_LD + br * 1024 + nb + ni * 16 + fq * 4), g);
#pragma unroll
                for (int r = 0; r < 4; ++r) sum[ti][ni][r] += g[r] * acc[ti][ni][r];
            }
        }
    }
    bf16_t* out = (bf16_t*)(p.ws + OFF_MERGED);
#pragma unroll
    for (int ti = 0; ti < 4; ++ti) {
        const int tok = m0 + ti * 16 + fr;
#pragma unroll
        for (int ni = 0; ni < 4; ++ni)
            *(u32x2*)(out + (size_t)tok * 1024 + nb + ni * 16 + fq * 4) = pack4(sum[ti][ni][0], sum[ti][ni][1], sum[ti][ni][2], sum[ti][ni][3]);
    }
}
DI void phaseG_tile(const Params& p, int l, int mt, int nt, char* lds) {
    const int tid = threadIdx.x, lane = tid & 63, wid = tid >> 6, wm = wid >> 1, wn = wid & 1, fr = lane & 15, fq = lane >> 4;
    const int m0 = mt * 128 + wm * 64, nb = nt * 128 + wn * 64;
    f32x4 acc[4][4]; zero_acc(acc);
    gemm_mainloop<false>(acc, (const bf16_t*)(p.ws + OFF_MERGED) + (size_t)mt * 128 * 1024, 1024, (const bf16_t*)(p.ws + OFF_W + W_OUT) + (size_t)nt * 128 * 1024, 1024, 1024, lds);
    const float* xin = l == 0 ? (const float*)p.in[I_X] : p.out;
    const float* ada = (const float*)(p.ws + OFF_CTRL + CT_ADA) + (size_t)l * 2 * 6144;
#pragma unroll
    for (int ti = 0; ti < 4; ++ti) {
        const int tok = m0 + ti * 16 + fr, b = tok >> 13;
#pragma unroll
        for (int ni = 0; ni < 4; ++ni) {
            const int n = nb + ni * 16 + fq * 4;
            const f32x4 xv = *(const f32x4*)(xin + (size_t)tok * 1024 + n), gt = *(const f32x4*)(ada + b * 6144 + 2 * 1024 + n);
            *(f32x4*)(p.out + (size_t)tok * 1024 + n) = xv + (1.0f + gt) * acc[ti][ni];
        }
    }
}
DI void phaseI_tile(const Params& p, int mt, int nt, char* lds) {
    const int tid = threadIdx.x, lane = tid & 63, wid = tid >> 6, wm = wid >> 1, wn = wid & 1, fr = lane & 15, fq = lane >> 4;
    const int m0 = mt * 128 + wm * 64, nb = nt * 128 + wn * 64;
    f32x4 acc[4][4]; zero_acc(acc);
    gemm_mainloop<false>(acc, (const bf16_t*)(p.ws + OFF_H) + (size_t)mt * 128 * 1024, 1024, (const bf16_t*)(p.ws + OFF_W + W_QP) + (size_t)nt * 128 * 1024, 1024, 1024, lds);
    bf16_t* out = (bf16_t*)(p.ws + OFF_QP);
#pragma unroll
    for (int ti = 0; ti < 4; ++ti) {
        const int tok = m0 + ti * 16 + fr;
#pragma unroll
        for (int ni = 0; ni < 4; ++ni)
            *(u32x2*)(out + (size_t)tok * 2048 + nb + ni * 16 + fq * 4) = pack4(acc[ti][ni][0], acc[ti][ni][1], acc[ti][ni][2], acc[ti][ni][3]);
    }
}
DI void phaseJ_tile(const Params& p, int mt, int g, char* lds) {
    const int tid = threadIdx.x, lane = tid & 63, wid = tid >> 6, wm = wid >> 1, wn = wid & 1, fr = lane & 15, fq = lane >> 4;
    const int m0 = mt * 128 + wm * 64, nb = wn * 64;
    f32x4 acc[4][4]; zero_acc(acc);
    gemm_mainloop<true>(acc, (const bf16_t*)(p.ws + OFF_QP) + (size_t)mt * 128 * 2048 + g * 128, 2048, (const bf16_t*)(p.ws + OFF_W + ((g & 1) ? W_KEY2 : W_KEY1)), 128, 128, lds);
    float* out = (float*)(p.ws + OFF_SCORES);
#pragma unroll
    for (int ni = 0; ni < 4; ++ni) {
        const int n = nb + ni * 16 + fr;
#pragma unroll
        for (int ti = 0; ti < 4; ++ti) *(f32x4*)(out + (size_t)(g * 128 + n) * NT + m0 + ti * 16 + fq * 4) = acc[ti][ni];
    }
}

DI void phaseIJ_tile(const Params& p, int mt, int g, char* lds) {
    const int tid = threadIdx.x, lane = tid & 63, wid = tid >> 6, wm = wid >> 1, wn = wid & 1, fr = lane & 15, fq = lane >> 4;
    f32x4 acc[4][4]; zero_acc(acc);
    gemm_mainloop<false>(acc, (const bf16_t*)(p.ws + OFF_H) + (size_t)mt * 128 * 1024, 1024, (const bf16_t*)(p.ws + OFF_W + W_QP) + (size_t)g * 128 * 1024, 1024, 1024, lds);
    const int swz = (fr >> 1) & 7;
    __syncthreads();
#pragma unroll
    for (int ti = 0; ti < 4; ++ti) {
        const int row = wm * 64 + ti * 16 + fr;
#pragma unroll
        for (int ni = 0; ni < 4; ++ni)
            *(u32x2*)(lds + wn * GEMM_STAGE + row * 128 + (((ni * 2 + (fq >> 1)) ^ swz) << 4) + (fq & 1) * 8) = pack4(acc[ti][ni][0], acc[ti][ni][1], acc[ti][ni][2], acc[ti][ni][3]);
    }
    {
        const bf16_t* gw = (const bf16_t*)(p.ws + OFF_W + ((g & 1) ? W_KEY2 : W_KEY1)) + (size_t)(tid >> 3) * 128 + (((tid & 7) ^ ((tid >> 4) & 7)) * 8);
#pragma unroll
        for (int st = 0; st < 2; ++st)
#pragma unroll
            for (int i = 0; i < 4; ++i)
                __builtin_amdgcn_global_load_lds((const unsigned*)(gw + (size_t)(32 * i) * 128 + st * 64), (LDSP unsigned*)(lds + st * GEMM_STAGE + 16384 + tid * 16 + i * 4096), 16, 0, 0);
    }
    asm volatile("s_waitcnt vmcnt(0) lgkmcnt(0)" ::: "memory");
    __syncthreads();
    f32x4 sc[4][4]; zero_acc(sc);
#pragma unroll
    for (int kt = 0; kt < 2; ++kt) {
        const char* sx = lds + kt * GEMM_STAGE;
        const char* sw = sx + 16384;
#pragma unroll
        for (int ks = 0; ks < 2; ++ks) {
            const int cb = ((ks * 4 + fq) ^ swz) << 4;
            bf16x8 xf[4], wf[4];
#pragma unroll
            for (int i = 0; i < 4; ++i) {
                xf[i] = *(const bf16x8*)(sx + (wm * 64 + i * 16 + fr) * 128 + cb);
                wf[i] = *(const bf16x8*)(sw + (wn * 64 + i * 16 + fr) * 128 + cb);
            }
#pragma unroll
            for (int ti = 0; ti < 4; ++ti)
#pragma unroll
                for (int ni = 0; ni < 4; ++ni) sc[ti][ni] = MFMA16(xf[ti], wf[ni], sc[ti][ni]);
        }
    }
    asm volatile("" ::: "memory");
    __builtin_amdgcn_sched_barrier(0);
    const int m0 = mt * 128 + wm * 64, nb = wn * 64;
    float* out = (float*)(p.ws + OFF_SCORES);
#pragma unroll
    for (int ni = 0; ni < 4; ++ni) {
        const int n = nb + ni * 16 + fr;
#pragma unroll
        for (int ti = 0; ti < 4; ++ti) *(f32x4*)(out + (size_t)(g * 128 + n) * NT + m0 + ti * 16 + fq * 4) = sc[ti][ni];
    }
}

DI void ins16(float (&a)[16], float x) {
#pragma unroll
    for (int i = 0; i < 16; ++i) { const float t = fmaxf(a[i], x); x = fminf(a[i], x); a[i] = t; }
}
DI void topk_thread(const Params& p, int idx) {
    const int hd = idx >> 14, t = idx & (NT - 1);
    const float* s1 = (const float*)(p.ws + OFF_SCORES) + (size_t)(hd * 256) * NT + t;
    const float* s2 = s1 + (size_t)128 * NT;
    float a[16], b[16], c[16];
#pragma unroll
    for (int i = 0; i < 16; ++i) { a[i] = -INFINITY; b[i] = -INFINITY; c[i] = -INFINITY; }
#pragma unroll 8
    for (int n = 0; n < 128; ++n) {
        const float x1 = __uint_as_float((__float_as_uint(s1[(size_t)n * NT]) & 0xFFFFFF80u) | (unsigned)(127 - n));
        const float x2 = __uint_as_float((__float_as_uint(s2[(size_t)n * NT]) & 0xFFFFFF80u) | (unsigned)(127 - n));
        ins16(a, x1); ins16(b, x2);
    }
    float v1[16], v2[16]; int i1[16], i2[16];
#pragma unroll
    for (int i = 0; i < 16; ++i) {
        const unsigned ua = __float_as_uint(a[i]), ub = __float_as_uint(b[i]);
        v1[i] = __uint_as_float(ua & 0xFFFFFF80u); i1[i] = 127 - (int)(ua & 127u);
        v2[i] = __uint_as_float(ub & 0xFFFFFF80u); i2[i] = 127 - (int)(ub & 127u);
    }
#pragma unroll
    for (int i = 0; i < 16; ++i)
#pragma unroll
        for (int j = 0; j < 16; ++j)
            if ((i + 1) * (j + 1) <= 16) ins16(c, __uint_as_float((__float_as_uint(v1[i] + v2[j]) & 0xFFFFFF00u) | (unsigned)(255 - (i * 16 + j))));
    float tv[16]; int eid[16];
#pragma unroll
    for (int r = 0; r < 16; ++r) {
        const unsigned u = __float_as_uint(c[r]);
        tv[r] = __uint_as_float(u & 0xFFFFFF00u);
        const int flat = 255 - (int)(u & 255u), ii = flat >> 4, jj = flat & 15;
        int e1 = 0, e2 = 0;
#pragma unroll
        for (int i = 0; i < 16; ++i) { e1 = (ii == i) ? i1[i] : e1; e2 = (jj == i) ? i2[i] : e2; }
        eid[r] = e1 * 128 + e2;
    }
    float sm = 0.f;
    const float mx = tv[0];
#pragma unroll
    for (int r = 0; r < 16; ++r) { tv[r] = __expf(tv[r] - mx); sm += tv[r]; }
    const float inv = 1.0f / sm;
    int* ep = (int*)(p.ws + OFF_EID) + (size_t)t * 128 + hd * 16;
    float* gp = (float*)(p.ws + OFF_GATE) + (size_t)t * 128 + hd * 16;
#pragma unroll
    for (int q = 0; q < 4; ++q) {
        *(u32x4*)(ep + q * 4) = (u32x4){(unsigned)eid[q * 4], (unsigned)eid[q * 4 + 1], (unsigned)eid[q * 4 + 2], (unsigned)eid[q * 4 + 3]};
        *(f32x4*)(gp + q * 4) = (f32x4){tv[q * 4] * inv, tv[q * 4 + 1] * inv, tv[q * 4 + 2] * inv, tv[q * 4 + 3] * inv};
    }
}

DI void cvt_u8x4(unsigned w, float (&f)[4]) { f[0] = (float)(w & 255u); f[1] = (float)((w >> 8) & 255u); f[2] = (float)((w >> 16) & 255u); f[3] = (float)(w >> 24); }
DI float gelu_zs(float v) {
    const float av = fabsf(v), t = __builtin_amdgcn_rcpf(av * 0.2316418882f + 1.0f);
    float q = t * 0.5307027145f + (-0.7265760135f); q = q * t + 0.7107068705f; q = q * t + (-0.142248368f); q = q * t + 0.127414796f; q = q * t;
    const float e = __builtin_amdgcn_exp2f(v * v * (-0.72134752044f));
    const float m = v * (q * e);
    return v < 0.f ? m : v - m;
}
DI void peer_token(const Params& p, int l, int t) {
    const int lane = threadIdx.x & 63, b = t >> 13;
    const unsigned char* U = (const unsigned char*)(p.ws + OFF_PU8);
    const unsigned char* V = (const unsigned char*)(p.ws + OFF_PV8);
    const float* SU = (const float*)(p.ws + OFF_PSU);
    const float* SV = (const float*)(p.ws + OFF_PSV);
    bf16_t* H = (bf16_t*)(p.ws + OFF_H);
    int hq[4]; float sh;
    {
        float hv[16]; float f[8];
        unpack8(*(const u32x4*)(H + (size_t)t * 1024 + lane * 16), f); for (int e = 0; e < 8; ++e) hv[e] = f[e];
        unpack8(*(const u32x4*)(H + (size_t)t * 1024 + lane * 16 + 8), f); for (int e = 0; e < 8; ++e) hv[8 + e] = f[e];
        float am = 0.f;
#pragma unroll
        for (int e = 0; e < 16; ++e) am = fmaxf(am, fabsf(hv[e]));
        am = wave_max(am);
        sh = am > 0.f ? am * (1.0f / 127.0f) : 1.0f;
        const float ish = am > 0.f ? 127.0f / am : 0.f;
#pragma unroll
        for (int q = 0; q < 4; ++q) {
            unsigned w = 0;
#pragma unroll
            for (int e = 0; e < 4; ++e) w |= ((unsigned)(int)rintf(hv[q * 4 + e] * ish) & 255u) << (8 * e);
            hq[q] = (int)w;
        }
    }
    const int* eidp = (const int*)(p.ws + OFF_EID) + (size_t)t * 128;
    const float* gatep = (const float*)(p.ws + OFF_GATE) + (size_t)t * 128;
    const int id0 = eidp[lane], id1 = eidp[64 + lane];
    const float g0 = gatep[lane], g1 = gatep[64 + lane];
    const float su0 = SU[id0] * sh, su1 = SU[id1] * sh, gs0 = g0 * SV[id0], gs1 = g1 * SV[id1];
    float acc[16], csum = 0.f;
#pragma unroll
    for (int e = 0; e < 16; ++e) acc[e] = 0.f;
    const int eidx = lane >> 3;
    const bool hi32 = (lane & 32) != 0, hi16 = (lane & 16) != 0, hi8 = (lane & 8) != 0;
#pragma unroll 1
    for (int g = 0; g < 16; ++g) {
        const int jbase = (g & 7) * 8;
        const int idr = (g & 8) ? id1 : id0; const float sur = (g & 8) ? su1 : su0, gsr = (g & 8) ? gs1 : gs0;
        u32x4 uq[8], vq[8];
#pragma unroll
        for (int e = 0; e < 8; ++e) {
            const int id = __builtin_amdgcn_readlane(idr, jbase + e);
            uq[e] = *(const u32x4*)(U + (size_t)id * 1024 + lane * 16);
            vq[e] = *(const u32x4*)(V + (size_t)id * 1024 + lane * 16);
        }
        float d[8];
#pragma unroll
        for (int e = 0; e < 8; ++e) {
            int sdot = __builtin_amdgcn_sdot4((int)uq[e].x, hq[0], 0, false);
            sdot = __builtin_amdgcn_sdot4((int)uq[e].y, hq[1], sdot, false);
            sdot = __builtin_amdgcn_sdot4((int)uq[e].z, hq[2], sdot, false);
            sdot = __builtin_amdgcn_sdot4((int)uq[e].w, hq[3], sdot, false);
            d[e] = (float)sdot;
        }
        float r4[4], r2[2];
#pragma unroll
        for (int i = 0; i < 4; ++i) { const float keep = hi32 ? d[4 + i] : d[i], send = hi32 ? d[i] : d[4 + i]; r4[i] = keep + __shfl_xor(send, 32); }
#pragma unroll
        for (int i = 0; i < 2; ++i) { const float keep = hi16 ? r4[2 + i] : r4[i], send = hi16 ? r4[i] : r4[2 + i]; r2[i] = keep + __shfl_xor(send, 16); }
        float r1;
        { const float keep = hi8 ? r2[1] : r2[0], send = hi8 ? r2[0] : r2[1]; r1 = keep + __shfl_xor(send, 8); }
        r1 = row8_sum(r1);
        const float dotv = r1 * __shfl(sur, jbase + eidx);
        const float ccl = gelu_zs(dotv) * __shfl(gsr, jbase + eidx);
#pragma unroll
        for (int e = 0; e < 8; ++e) {
            const float cc = __int_as_float(__builtin_amdgcn_readlane(__float_as_int(ccl), e * 8));
            csum += cc;
            float f[4];
            cvt_u8x4(vq[e].x, f); acc[0] += cc * f[0]; acc[1] += cc * f[1]; acc[2] += cc * f[2]; acc[3] += cc * f[3];
            cvt_u8x4(vq[e].y, f); acc[4] += cc * f[0]; acc[5] += cc * f[1]; acc[6] += cc * f[2]; acc[7] += cc * f[3];
            cvt_u8x4(vq[e].z, f); acc[8] += cc * f[0]; acc[9] += cc * f[1]; acc[10] += cc * f[2]; acc[11] += cc * f[3];
            cvt_u8x4(vq[e].w, f); acc[12] += cc * f[0]; acc[13] += cc * f[1]; acc[14] += cc * f[2]; acc[15] += cc * f[3];
        }
    }
#pragma unroll
    for (int e = 0; e < 16; ++e) acc[e] -= 128.0f * csum;
    const float* ada = (const float*)(p.ws + OFF_CTRL + CT_ADA) + (size_t)(l * 2 + b) * 6144;
    float xv[16], ss = 0.f;
#pragma unroll
    for (int q = 0; q < 4; ++q) {
        const int n = lane * 16 + q * 4;
        const f32x4 x1 = *(const f32x4*)(p.out + (size_t)t * 1024 + n), gt = *(const f32x4*)(ada + 5 * 1024 + n);
#pragma unroll
        for (int e = 0; e < 4; ++e) { const float x2 = x1[e] + (1.0f + gt[e]) * acc[q * 4 + e]; xv[q * 4 + e] = x2; ss += x2 * x2; }
    }
    ss = wave_sum(ss);
    const float rstd = rsqrtf(ss * (1.0f / 1024.0f) + 1e-6f);
    if (l + 1 < DEPTH) {
        const float* ada2 = (const float*)(p.ws + OFF_CTRL + CT_ADA) + (size_t)((l + 1) * 2 + b) * 6144;
        const float* g1n = (const float*)p.in[I_N1G] + (size_t)(l + 1) * 1024;
        float o[16];
#pragma unroll
        for (int q = 0; q < 4; ++q) {
            const int n = lane * 16 + q * 4;
            const f32x4 g = *(const f32x4*)(g1n + n), sh = *(const f32x4*)(ada2 + n), sc = *(const f32x4*)(ada2 + 1024 + n);
            *(f32x4*)(p.out + (size_t)t * 1024 + n) = (f32x4){xv[q * 4], xv[q * 4 + 1], xv[q * 4 + 2], xv[q * 4 + 3]};
#pragma unroll
            for (int e = 0; e < 4; ++e) o[q * 4 + e] = xv[q * 4 + e] * rstd * g[e] * (1.0f + sc[e]) + sh[e];
        }
        u32x4 w0, w1;
        w0.x = pk2(o[0], o[1]); w0.y = pk2(o[2], o[3]); w0.z = pk2(o[4], o[5]); w0.w = pk2(o[6], o[7]);
        w1.x = pk2(o[8], o[9]); w1.y = pk2(o[10], o[11]); w1.z = pk2(o[12], o[13]); w1.w = pk2(o[14], o[15]);
        *(u32x4*)(H + (size_t)t * 1024 + lane * 16) = w0; *(u32x4*)(H + (size_t)t * 1024 + lane * 16 + 8) = w1;
    } else {
        const float* fg = (const float*)p.in[I_FG];
#pragma unroll
        for (int q = 0; q < 4; ++q) {
            const int n = lane * 16 + q * 4;
            const f32x4 g = *(const f32x4*)(fg + n);
            f32x4 o;
#pragma unroll
            for (int e = 0; e < 4; ++e) o[e] = xv[q * 4 + e] * rstd * g[e];
            *(f32x4*)(p.out + (size_t)t * 1024 + n) = o;
        }
    }
}

#define XB_TMO      128
#define XB_XCNT(j)  (256  + 64 * (j))
#define XB_XSUB(j)  (1280 + 64 * (j))
#define XB_XGEN(j)  (2304 + 64 * (j))
#define XB_TOP      3328
#define XB_TOPGEN   3392
#define XCD_BAR_WORDS 3456
#define XB_SPIN_CAP (1u << 18)
#define LAS __attribute__((address_space(3)))
DI unsigned xb_ld(unsigned* q)              { return __hip_atomic_load(q, __ATOMIC_RELAXED, __HIP_MEMORY_SCOPE_AGENT); }
DI unsigned xb_add(unsigned* q, unsigned v) { return __hip_atomic_fetch_add(q, v, __ATOMIC_RELAXED, __HIP_MEMORY_SCOPE_AGENT); }
DI unsigned xb_xcc_id() { return (unsigned)__builtin_amdgcn_s_getreg((3 << 11) | 20) & 0xFu; }
#define XB_SPIN(cond, bar) do { unsigned _sp = 0; while (cond) { __builtin_amdgcn_s_sleep(1); \
    if ((++_sp & 255u) == 0u) { if (xb_ld(&(bar)[XB_TMO])) break; if (_sp > XB_SPIN_CAP) { atomicAdd(&(bar)[XB_TMO], 1u); break; } } } } while (0)
struct XcdBarrier { unsigned* bar; unsigned x; volatile LAS unsigned* st; };
DI XcdBarrier xcd_barrier_post(unsigned* bar, volatile LAS unsigned* st) {
    XcdBarrier b; b.bar = bar; b.x = xb_xcc_id(); b.st = st;
    if (threadIdx.x == 0) (void)xb_add(&bar[XB_XCNT(b.x)], 1u);
    return b;
}
DI void xcd_barrier_complete(unsigned* bar, unsigned x, unsigned& nloc, unsigned& nx) {
    const unsigned G = gridDim.x * gridDim.y * gridDim.z;
    unsigned sum, cnt, mine, sp = 0u;
    for (;;) {
        sum = 0u; cnt = 0u; mine = 0u;
#pragma unroll
        for (unsigned j = 0; j < 16; ++j) { const unsigned c = xb_ld(&bar[XB_XCNT(j)]); sum += c; cnt += (c > 0u) ? 1u : 0u; mine = (j == x) ? c : mine; }
        if (sum == G) break;
        __builtin_amdgcn_s_sleep(1);
        if ((++sp & 255u) == 0u) { if (xb_ld(&bar[XB_TMO])) break; if (sp > XB_SPIN_CAP) { atomicAdd(&bar[XB_TMO], 1u); break; } }
    }
    nloc = mine > 0u ? mine : 1u; nx = cnt > 0u ? cnt : 1u;
}
DI void xcd_barrier(const XcdBarrier& b) {
    asm volatile("s_waitcnt vmcnt(0)" ::: "memory");
    __syncthreads();
    if (threadIdx.x == 0) {
        unsigned* bar = b.bar;
        __builtin_amdgcn_s_waitcnt(0);
        unsigned nloc = b.st[0], nx = b.st[1];
        if (nloc == 0u) { xcd_barrier_complete(bar, b.x, nloc, nx); b.st[0] = nloc; b.st[1] = nx; }
        const unsigned old = xb_add(&bar[XB_XSUB(b.x)], 1u);
        const unsigned gen = old / nloc;
        if (old + 1u == (gen + 1u) * nloc) {
            __builtin_amdgcn_fence(__ATOMIC_RELEASE, "agent");
            asm volatile("s_waitcnt vmcnt(0)" ::: "memory");
            const unsigned og = xb_add(&bar[XB_TOP], 1u);
            const unsigned tg = og / nx;
            if (og + 1u == (tg + 1u) * nx) xb_add(&bar[XB_TOPGEN], 1u);
            else XB_SPIN(xb_ld(&bar[XB_TOPGEN]) == tg, bar);
            __builtin_amdgcn_fence(__ATOMIC_ACQUIRE, "agent");
            xb_add(&bar[XB_XGEN(b.x)], 1u);
            asm volatile("s_waitcnt vmcnt(0)" ::: "memory");
        } else {
            XB_SPIN(xb_ld(&bar[XB_XGEN(b.x)]) == gen, bar);
            __builtin_amdgcn_fence(__ATOMIC_ACQUIRE, "agent");
            asm volatile("s_waitcnt vmcnt(0)" ::: "memory");
        }
    }
    __syncthreads();
}
constexpr size_t CT_BAR = 16384;

constexpr int LDS_BYTES = 2 * GEMM_STAGE + 64;
constexpr int N_PHASES = 2 + 13 * DEPTH;
constexpr int ATT_U1 = 624;
constexpr int ATT_U0 = 256;
DI void attn_queue(const Params& p, int l, char* lds, int part, int jbase, int jlim) {
    const int tid = threadIdx.x;
    unsigned* cnt = (unsigned*)(p.ws + OFF_CTRL + CT_CNT) + 64 * (l * 3 + part);
    int* s_unit = (int*)(lds + LDS_BYTES - 16);
    if (tid == 0) s_unit[1] = 0;
    for (;;) {
        __syncthreads();
        if (tid == 0) {
            const int myx = (int)(xb_xcc_id() & 7u);
            int unit = -1, qi = s_unit[1];
            while (qi < 8) {
                const int x = (myx + qi) & 7;
                const int j = jbase + (int)atomicAdd(cnt + x * 8, 1u);
                if (j < jlim) { unit = ((j >> 1) << 4) | (x * 2 + (j & 1)); break; }
                ++qi;
            }
            s_unit[0] = unit; s_unit[1] = qi;
        }
        __syncthreads();
        const int unit = s_unit[0];
        if (unit < 0) break;
        attn_unit(p, l, unit, lds);
    }
}

#ifndef MULTI_LAUNCH
#define MULTI_LAUNCH 0
#endif

template <int ph> DI void run_phase(const Params& p, char* lds) {
    const int bid = blockIdx.x, nblk = gridDim.x, tid = threadIdx.x;
    const int gw = bid * 4 + (tid >> 6), nw = nblk * 4;
    const int vb = (nblk == 512) ? (bid % 8) * 64 + ((bid / 8) % 32) * 2 + (bid / 256) : (nblk % 8 == 0) ? (bid % 8) * (nblk / 8) + bid / 8 : bid;
    float* ada = (float*)(p.ws + OFF_CTRL + CT_ADA);
    if (ph == 0) {
        const int total = 192 + 1 + 256 + NCONV_ITEMS / 2;
        for (int it = bid; it < total; it += nblk) {
            if (it < 192) ada_item(p, it, lds);
            else if (it == 192) lam_item(p);
            else if (it < 449) rope_item(p, it - 193);
            else convert_item(p, 0, it - 449, lds);
        }
        return;
    }
    if (ph == 1) {
        norm_rows(p, (const float*)p.in[I_X], (const float*)p.in[I_N1G], ada, ada + 1024, (bf16_t*)(p.ws + OFF_H));
        for (int it = NCONV_ITEMS / 2 + bid; it < NCONV_ITEMS; it += nblk) convert_item(p, 0, it, lds);
        return;
    }
    constexpr int l = (ph - 2) / 13, sub0 = (ph - 2) % 13, sub = sub0 <= 1 ? sub0 : sub0 == 2 ? 100 : sub0 == 3 ? 101 : sub0 <= 5 ? 2 : sub0 <= 10 ? sub0 - 3 : sub0 - 2;
    switch (sub) {
    case 0:
        for (int tile = vb; tile < 128 * 90; tile += nblk) { int mt, nt; tile_coords(tile, 90, mt, nt); phaseB_tile(p, mt, nt, lds); }
        break;
    case 1:
        for (int it = bid; it < 2048; it += nblk) { if (it < 1024) conv_tile(p, l, it, lds); else lora_in_tile(p, l, it - 1024); }
        break;
    case 101:
        for (int it = bid; it < 4096; it += nblk) scan_T_item(p, l, it, lds);
        attn_queue(p, l, lds, 2, 256 - ATT_U0 / 8, 256);
        break;
    case 100:
        for (int tile = vb; tile < 2048; tile += nblk) { int mt, nt; tile_coords(tile & 1023, 8, mt, nt); lora_wa_tile(p, l, tile >> 10, mt, nt, lds); }
        break;
    case 2: {
        const bool second = sub0 == 5;
#if SCAN_MFMA
        if (!second) { for (int it = bid; it < N_MS1; it += nblk) ms_item_pass1(p, l, it, lds); }
        else { for (int it = bid; it < N_MS2; it += nblk) ms_item_pass2(p, l, it, lds); }
#else
        if (!second) { for (int it = bid; it < N_SCAN1; it += nblk) scan_item_pass1(p, l, it, lds); }
        else { for (int it = bid; it < N_SCAN2; it += nblk) scan_item_pass2(p, l, it, lds); }
#endif
        attn_queue(p, l, lds, second ? 1 : 0, second ? ATT_U1 / 8 : 0, second ? 256 - ATT_U0 / 8 : ATT_U1 / 8);
        break; }
    case 3:
        for (int it = bid; it < 1024; it += nblk) rwkv_post_tile(p, l, it, lds);
        break;
    case 4:
        for (int tile = vb; tile < 128 * 8; tile += nblk) { int mt, nt; tile_coords(tile, 8, mt, nt); phaseF_tile(p, mt, nt, lds); }
        break;
    case 5:
        for (int it = vb; it < 1024 + 8192; it += nblk) {
            if (it < 1024) { int mt, nt; tile_coords(it, 8, mt, nt); phaseG_tile(p, l, mt, nt, lds); }
            else convert_uv_item(p, l, it - 1024);
        }
        break;
    case 6:
        norm_rows(p, p.out, (const float*)p.in[I_N2G] + (size_t)l * 1024, ada + (size_t)l * 2 * 6144 + 3 * 1024, ada + (size_t)l * 2 * 6144 + 4 * 1024, (bf16_t*)(p.ws + OFF_H));
        break;
    case 7:
        for (int tile = vb; tile < 128 * 16; tile += nblk) { int mt, nt; tile_coords(tile, 16, mt, nt); phaseIJ_tile(p, mt, nt, lds); }
        break;
    case 8:
        break;
    case 9:
        for (int idx = bid * NTHREADS + tid; idx < NT * 8; idx += nblk * NTHREADS) topk_thread(p, idx);
        if (l + 1 < DEPTH) for (int it = bid; it < NCONV_ITEMS; it += nblk) convert_item(p, l + 1, it, lds);
        break;
    case 10:
        for (int t = gw; t < NT; t += nw) peer_token(p, l, t);
        break;
    }
}

#ifndef PROBE_PH
#define PROBE_PH -1
#endif
#ifndef PROBE_MULT
#define PROBE_MULT 3
#endif
#define PHASE(N) if (p.ph_begin <= N && N < p.ph_end) { unsigned long long pt0 = 0; if (N == PROBE_PH) pt0 = __builtin_amdgcn_s_memrealtime(); run_phase<N>(p, lds); \
    if (N + 1 < p.ph_end) { if (N == 0) cg::this_grid().sync(); else xcd_barrier(xb); } \
    if (N == PROBE_PH) { const unsigned long long pt1 = __builtin_amdgcn_s_memrealtime(); while (__builtin_amdgcn_s_memrealtime() - pt1 < PROBE_MULT * (pt1 - pt0)) __builtin_amdgcn_s_sleep(8); __syncthreads(); } }
extern __shared__ __attribute__((aligned(16))) char dyn_lds[];
__global__ void __launch_bounds__(NTHREADS, 2) mega_kernel(Params p) {
    char* lds = dyn_lds;
    volatile LAS unsigned* xst = (volatile LAS unsigned*)(lds + LDS_BYTES - 32);
    if (threadIdx.x == 0) { xst[0] = 0u; xst[1] = 0u; }
    __syncthreads();
    const XcdBarrier xb = xcd_barrier_post((unsigned*)(p.ws + OFF_CTRL + CT_BAR), xst);
    PHASE(0) PHASE(1) PHASE(2) PHASE(3) PHASE(4) PHASE(5) PHASE(6) PHASE(7) PHASE(8) PHASE(9) PHASE(10) PHASE(11) PHASE(12) PHASE(13)
    PHASE(14) PHASE(15) PHASE(16) PHASE(17) PHASE(18) PHASE(19) PHASE(20) PHASE(21) PHASE(22) PHASE(23) PHASE(24) PHASE(25) PHASE(26) PHASE(27)
    static_assert(N_PHASES == 28, "phase list");
}

extern "C" void kernel_launch(void* const* d_in, const int* in_sizes, int n_in, void* d_out, int out_size, void* d_ws, size_t ws_size, hipStream_t stream) {
    static int grid_blocks = 0;
    if (!grid_blocks) {
        int dev = 0, cus = 0, per_cu = 0;
        hipGetDevice(&dev);
        hipDeviceGetAttribute(&cus, hipDeviceAttributeMultiprocessorCount, dev);
        hipFuncSetAttribute((const void*)mega_kernel, hipFuncAttributeMaxDynamicSharedMemorySize, LDS_BYTES);
        hipOccupancyMaxActiveBlocksPerMultiprocessor(&per_cu, mega_kernel, NTHREADS, LDS_BYTES);
        if (per_cu > 2) per_cu = 2;
        if (per_cu < 1) per_cu = 1;
        grid_blocks = cus * per_cu;
        if (ws_size < WS_END) fprintf(stderr, "workspace too small: %zu < %zu\n", ws_size, (size_t)WS_END);
    }
    Params p{};
    for (int i = 0; i < N_IN; ++i) p.in[i] = d_in[i];
    p.out = (float*)d_out; p.ws = (char*)d_ws;
    hipMemsetAsync(d_ws, 0, 32768, stream);
#if MULTI_LAUNCH
    for (int ph = 0; ph < N_PHASES; ++ph) {
        p.ph_begin = ph; p.ph_end = ph + 1;
        hipLaunchKernelGGL(mega_kernel, dim3(grid_blocks), dim3(NTHREADS), LDS_BYTES, stream, p);
    }
#else
    p.ph_begin = 0; p.ph_end = N_PHASES;
    void* args[] = {&p};
    hipError_t e = hipLaunchCooperativeKernel((void*)mega_kernel, dim3(grid_blocks), dim3(NTHREADS), args, LDS_BYTES, stream);
    if (e != hipSuccess) fprintf(stderr, "cooperative launch failed: %s (grid %d)\n", hipGetErrorString(e), grid_blocks);
#endif
}
```

```cpp
#include <hip/hip_runtime.h>
#include <hip/hip_cooperative_groups.h>
#include <cstdio>
#include <cstdint>
namespace cg = cooperative_groups;
#ifndef SCAN_MFMA
#define SCAN_MFMA 1
#endif
#ifndef SCAN_TEST
#define SCAN_TEST 0
#endif

#define DI __device__ __forceinline__
typedef unsigned short bf16_t;
typedef short bf16x8 __attribute__((ext_vector_type(8)));
typedef float f32x2 __attribute__((ext_vector_type(2)));
typedef float f32x4 __attribute__((ext_vector_type(4)));
typedef float f32x16 __attribute__((ext_vector_type(16)));
typedef unsigned u32x2 __attribute__((ext_vector_type(2)));
typedef unsigned u32x4 __attribute__((ext_vector_type(4)));
typedef __bf16 nbf16x2 __attribute__((ext_vector_type(2)));

constexpr int NB = 2, SEQ = 8192, NT = NB * SEQ, DM = 1024, CIN = 11520, DEPTH = 2;
constexpr int NTHREADS = 256;
constexpr size_t MiB = (size_t)1 << 20;
constexpr size_t OFF_CTRL = 0, OFF_ROPE = 1 * MiB, OFF_W = 5 * MiB, OFF_H = 41 * MiB, OFF_Q = 73 * MiB, OFF_K = 105 * MiB,
                 OFF_VT = 137 * MiB, OFF_UC = 169 * MiB, OFF_ZR = 201 * MiB, OFF_ZG = 305 * MiB, OFF_A = 401 * MiB,
                 OFF_LW = 433 * MiB, OFF_YS = 465 * MiB, WS_END = 497 * MiB;
constexpr size_t OFF_CONVP = OFF_H, OFF_ATTP = OFF_UC, OFF_RWKVP = OFF_Q, OFF_MERGED = OFF_K, OFF_PU = OFF_ZR,
                 OFF_PV = OFF_ZR + 32 * MiB, OFF_QP = OFF_ZG, OFF_SCORES = OFF_Q, OFF_EID = OFF_A, OFF_GATE = OFF_A + 8 * MiB;
constexpr size_t W_IN = 0, W_ATTO = (size_t)CIN * 1024 * 2, W_CONVO = W_ATTO + 2 * MiB, W_RWKVO = W_CONVO + 2 * MiB,
                 W_OUT = W_RWKVO + 2 * MiB, W_QP = W_OUT + 2 * MiB, W_KEY1 = W_QP + 4 * MiB, W_KEY2 = W_KEY1 + 32768,
                 W_W2T = W_KEY2 + 32768, W_A2T = W_W2T + 131072, W_G2T = W_A2T + 131072;
static_assert(W_G2T + 262144 <= 36 * MiB, "W region overflow");
constexpr size_t CT_CNT = 0, CT_LAM = 3072, CT_ADA = 65536;
constexpr int RWKV_LD = 3328, ZG_LD = 3072;

enum { I_X = 0, I_C, I_POS, I_WADA, I_BADA, I_N1G, I_WIN, I_LQ1, I_LK1, I_LQ2, I_LK2, I_AHG, I_WATTO, I_CONVW, I_CONVB, I_CLNG, I_CLNB,
       I_WCONVO, I_MU, I_W0, I_W2, I_A0, I_A2, I_G2, I_KK, I_KA, I_RK, I_GNG, I_GNB, I_WRWKVO, I_WOUT, I_N2G, I_WQ, I_KEY1, I_KEY2,
       I_PU, I_PV, I_FG, N_IN };

struct Params {
    const void* in[N_IN];
    float* out;
    char* ws;
    int ph_begin, ph_end;
};

DI unsigned pk2(float lo, float hi) { f32x2 v = {lo, hi}; nbf16x2 b = __builtin_convertvector(v, nbf16x2); return __builtin_bit_cast(unsigned, b); }
DI float bflo(unsigned u) { return __uint_as_float(u << 16); }
DI float bfhi(unsigned u) { return __uint_as_float(u & 0xffff0000u); }
DI float bf2f(bf16_t h) { return __uint_as_float(((unsigned)h) << 16); }
DI bf16_t f2bf(float x) { return (bf16_t)(pk2(x, x) & 0xffffu); }
DI float sigmoidf_(float x) { return 1.0f / (1.0f + __expf(-x)); }
DI float siluf_(float x) { return x / (1.0f + __expf(-x)); }
template <int CTRL> DI float dpp_f(float x) { return __int_as_float(__builtin_amdgcn_update_dpp(0, __float_as_int(x), CTRL, 0xF, 0xF, true)); }
DI float row16_sum(float x) { x += dpp_f<0xB1>(x); x += dpp_f<0x4E>(x); x += dpp_f<0x141>(x); x += dpp_f<0x140>(x); return x; }
DI float row16_max(float x) { x = fmaxf(x, dpp_f<0xB1>(x)); x = fmaxf(x, dpp_f<0x4E>(x)); x = fmaxf(x, dpp_f<0x141>(x)); x = fmaxf(x, dpp_f<0x140>(x)); return x; }
DI float wave_sum(float x) { x = row16_sum(x); x += __shfl_xor(x, 16); x += __shfl_xor(x, 32); return x; }
DI float wave_max(float x) { x = row16_max(x); x = fmaxf(x, __shfl_xor(x, 16)); x = fmaxf(x, __shfl_xor(x, 32)); return x; }
DI void unpack8(u32x4 v, float (&f)[8]) { f[0] = bflo(v.x); f[1] = bfhi(v.x); f[2] = bflo(v.y); f[3] = bfhi(v.y); f[4] = bflo(v.z); f[5] = bfhi(v.z); f[6] = bflo(v.w); f[7] = bfhi(v.w); }
DI void unpack4(u32x2 v, float (&f)[4]) { f[0] = bflo(v.x); f[1] = bfhi(v.x); f[2] = bflo(v.y); f[3] = bfhi(v.y); }
DI u32x2 pack4(float a, float b, float c, float d) { u32x2 r; r.x = pk2(a, b); r.y = pk2(c, d); return r; }

#define MFMA16(a, b, c) __builtin_amdgcn_mfma_f32_16x16x32_bf16((a), (b), (c), 0, 0, 0)
#define MFMA32(a, b, c) __builtin_amdgcn_mfma_f32_32x32x16_bf16((a), (b), (c), 0, 0, 0)

constexpr int GEMM_STAGE = 32768;
#define LDSP __attribute__((address_space(3)))
template <bool NMODE>
DI void gemm_mainloop(f32x4 (&acc)[4][4], const bf16_t* X, size_t ldx, const bf16_t* W, size_t ldw, int K, char* lds) {
    const int tid = threadIdx.x, lane = tid & 63, wid = tid >> 6, wm = wid >> 1, wn = wid & 1;
    const int fr = lane & 15, fq = lane >> 4;
    const int srow = tid >> 3, skc = (tid & 7) ^ ((tid >> 4) & 7);
    const bf16_t* gx = X + (size_t)srow * ldx + skc * 8;
    const bf16_t* gw = W + (size_t)srow * ldw + skc * 8;
    const int nk = K >> 6;
    auto issue = [&](int kt) {
        char* st = lds + (kt & 1) * GEMM_STAGE + tid * 16;
        const int ko = kt * 64;
#pragma unroll
        for (int i = 0; i < 4; ++i) {
            __builtin_amdgcn_global_load_lds((const unsigned*)(gx + (size_t)(32 * i) * ldx + ko), (LDSP unsigned*)(st + i * 4096), 16, 0, 0);
            __builtin_amdgcn_global_load_lds((const unsigned*)(gw + (size_t)(32 * i) * ldw + ko), (LDSP unsigned*)(st + 16384 + i * 4096), 16, 0, 0);
        }
    };
    const int swz = (fr >> 1) & 7;
    asm volatile("s_waitcnt vmcnt(0) lgkmcnt(0)" ::: "memory");
    __syncthreads();
    issue(0);
    for (int kt = 0; kt < nk; ++kt) {
        asm volatile("s_waitcnt vmcnt(0)" ::: "memory");
        __syncthreads();
        if (kt + 1 < nk) issue(kt + 1);
        const char* sx = lds + (kt & 1) * GEMM_STAGE;
        const char* sw = sx + 16384;
#pragma unroll
        for (int ks = 0; ks < 2; ++ks) {
            const int cb = ((ks * 4 + fq) ^ swz) << 4;
            bf16x8 xf[4], wf[4];
#pragma unroll
            for (int i = 0; i < 4; ++i) {
                xf[i] = *(const bf16x8*)(sx + (wm * 64 + i * 16 + fr) * 128 + cb);
                wf[i] = *(const bf16x8*)(sw + (wn * 64 + i * 16 + fr) * 128 + cb);
            }
#pragma unroll
            for (int ti = 0; ti < 4; ++ti)
#pragma unroll
                for (int ni = 0; ni < 4; ++ni)
                    acc[ti][ni] = NMODE ? MFMA16(xf[ti], wf[ni], acc[ti][ni]) : MFMA16(wf[ni], xf[ti], acc[ti][ni]);
        }
    }
    asm volatile("" ::: "memory");
    __builtin_amdgcn_sched_barrier(0);
}
DI void zero_acc(f32x4 (&acc)[4][4]) {
#pragma unroll
    for (int i = 0; i < 4; ++i)
#pragma unroll
        for (int j = 0; j < 4; ++j) acc[i][j] = (f32x4){0.f, 0.f, 0.f, 0.f};
}
DI void tile_coords(int tile, int nN, int& mt, int& nt) { const int per = 16 * nN; const int g = tile / per, r = tile % per; nt = r >> 4; mt = g * 16 + (r & 15); }

DI void ada_item(const Params& p, int item, char* lds) {
    const int l = item / 96, cgp = item % 96, tid = threadIdx.x, lane = tid & 63, wid = tid >> 6;
    const float* c = (const float*)p.in[I_C];
    const float* w = (const float*)p.in[I_WADA] + (size_t)l * 1024 * 6144 + cgp * 64 + lane;
    float a0 = 0.f, a1 = 0.f;
    const int k0 = wid * 256;
#pragma unroll 8
    for (int k = k0; k < k0 + 256; ++k) {
        const float wv = w[(size_t)k * 6144];
        a0 += siluf_(c[k]) * wv; a1 += siluf_(c[1024 + k]) * wv;
    }
    float* red = (float*)lds;
    __syncthreads();
    red[(wid * 2 + 0) * 64 + lane] = a0; red[(wid * 2 + 1) * 64 + lane] = a1;
    __syncthreads();
    if (tid < 128) {
        const int b = tid >> 6, n = cgp * 64 + (tid & 63);
        float s = ((const float*)p.in[I_BADA])[l * 6144 + n];
        for (int w4 = 0; w4 < 4; ++w4) s += red[(w4 * 2 + b) * 64 + (tid & 63)];
        ((float*)(p.ws + OFF_CTRL + CT_ADA))[(l * 2 + b) * 6144 + n] = s;
    }
}
DI void lam_item(const Params& p) {
    if (threadIdx.x < 64) {
        const int lane = threadIdx.x;
        for (int l = 0; l < DEPTH; ++l) {
            float s1 = ((const float*)p.in[I_LQ1])[l * 64 + lane] * ((const float*)p.in[I_LK1])[l * 64 + lane];
            float s2 = ((const float*)p.in[I_LQ2])[l * 64 + lane] * ((const float*)p.in[I_LK2])[l * 64 + lane];
            s1 = wave_sum(s1); s2 = wave_sum(s2);
            const float lam_init = 0.8f - 0.6f * expf(-0.3f * (float)l);
            if (lane == 0) ((float*)(p.ws + OFF_CTRL + CT_LAM))[l] = expf(s1) - expf(s2) + lam_init;
        }
    }
}
DI void rope_item(const Params& p, int item) {
    const int* pos = (const int*)p.in[I_POS];
    float* rc = (float*)(p.ws + OFF_ROPE);
    float* rs = rc + (size_t)NT * 32;
#pragma unroll
    for (int e = 0; e < 8; ++e) {
        const int idx = item * 2048 + e * 256 + threadIdx.x;
        const int t = idx >> 5, i = idx & 31;
        const float inv = powf(10000.0f, -(float)i / 32.0f);
        const float ang = (float)pos[t] * inv;
        float sn, cs; sincosf(ang, &sn, &cs);
        rc[idx] = cs; rs[idx] = sn;
    }
}
DI int win_srcmap(int n) {
    if (n < 3072 || n >= 5120) return n;
    const int q = n - 3072, j = q >> 6, r = q & 63;
    return r < 32 ? 3072 + 32 * j + r : 3072 + 1024 + 32 * j + (r - 32);
}
DI void transpose_tile(const float* src, int N, bf16_t* dst, int k0, int n0, bool perm, char* lds, int dld = 1024) {
    float* t = (float*)lds;
    const int tid = threadIdx.x;
    const int r = tid >> 4, c4 = (tid & 15) * 4;
    int ns = n0 + c4; if (perm) ns = win_srcmap(ns);
    __syncthreads();
#pragma unroll
    for (int i = 0; i < 4; ++i) {
        const int kl = r + 16 * i;
        const f32x4 v = *(const f32x4*)(src + (size_t)(k0 + kl) * N + ns);
        t[(c4 + 0) * 65 + kl] = v[0]; t[(c4 + 1) * 65 + kl] = v[1]; t[(c4 + 2) * 65 + kl] = v[2]; t[(c4 + 3) * 65 + kl] = v[3];
    }
    __syncthreads();
    const int nl = tid >> 2, kq = (tid & 3) * 16;
    u32x4 o0, o1;
    const float* tr = t + nl * 65 + kq;
    o0.x = pk2(tr[0], tr[1]); o0.y = pk2(tr[2], tr[3]); o0.z = pk2(tr[4], tr[5]); o0.w = pk2(tr[6], tr[7]);
    o1.x = pk2(tr[8], tr[9]); o1.y = pk2(tr[10], tr[11]); o1.z = pk2(tr[12], tr[13]); o1.w = pk2(tr[14], tr[15]);
    bf16_t* d = dst + (size_t)(n0 + nl) * dld + k0 + kq;
    *(u32x4*)d = o0; *(u32x4*)(d + 8) = o1;
}
constexpr int NCONV_ITEMS = 2880 + 1024 + 512 + 2 + 32;
DI void convert_item(const Params& p, int l, int item, char* lds) {
    char* wb = p.ws + OFF_W;
    if (item < 2880) { const int kt = item % 16, nt = item / 16; transpose_tile((const float*)p.in[I_WIN] + (size_t)l * 1024 * CIN, CIN, (bf16_t*)(wb + W_IN), kt * 64, nt * 64, true, lds); return; }
    item -= 2880;
    if (item < 1024) {
        const int which = item >> 8, it = item & 255, kt = it & 15, nt = it >> 4;
        const int idx = which == 0 ? I_WATTO : which == 1 ? I_WCONVO : which == 2 ? I_WRWKVO : I_WOUT;
        const size_t off = which == 0 ? W_ATTO : which == 1 ? W_CONVO : which == 2 ? W_RWKVO : W_OUT;
        transpose_tile((const float*)p.in[idx] + (size_t)l * 1024 * 1024, 1024, (bf16_t*)(wb + off), kt * 64, nt * 64, false, lds); return;
    }
    item -= 1024;
    if (item < 512) { const int kt = item & 15, nt = item >> 4; transpose_tile((const float*)p.in[I_WQ] + (size_t)l * 1024 * 2048, 2048, (bf16_t*)(wb + W_QP), kt * 64, nt * 64, false, lds); return; }
    item -= 512;
    if (item >= 2) {
        item -= 2;
        if (item < 16) { transpose_tile((const float*)p.in[I_W2] + (size_t)l * 64 * 1024, 1024, (bf16_t*)(wb + W_W2T), 0, item * 64, false, lds, 64); return; }
        item -= 16;
        if (item < 16) { transpose_tile((const float*)p.in[I_A2] + (size_t)l * 64 * 1024, 1024, (bf16_t*)(wb + W_A2T), 0, item * 64, false, lds, 64); return; }
        return;
    }
    {
        const float* src = (const float*)p.in[item == 0 ? I_KEY1 : I_KEY2] + (size_t)l * 16384;
        bf16_t* dst = (bf16_t*)(wb + (item == 0 ? W_KEY1 : W_KEY2));
        for (int i = threadIdx.x * 4; i < 16384; i += 1024) { const f32x4 v = *(const f32x4*)(src + i); *(u32x2*)(dst + i) = pack4(v[0], v[1], v[2], v[3]); }
    }
}
constexpr size_t OFF_PU8 = OFF_ZR, OFF_PV8 = OFF_ZR + 16 * MiB, OFF_PSU = OFF_ZR + 32 * MiB, OFF_PSV = OFF_PSU + 65536;
DI void convert_uv_item(const Params& p, int l, int item) {
    const int lane = threadIdx.x & 63, rowi = item * 4 + (threadIdx.x >> 6);
    const int arr = rowi >> 14, row = rowi & 16383;
    const float* src = (const float*)p.in[arr == 0 ? I_PU : I_PV] + ((size_t)l * 16384 + row) * 1024;
    unsigned* dst = (unsigned*)(p.ws + (arr == 0 ? OFF_PU8 : OFF_PV8) + (size_t)row * 1024);
    f32x4 v[4]; float am = 0.f;
#pragma unroll
    for (int i = 0; i < 4; ++i) { v[i] = *(const f32x4*)(src + i * 256 + lane * 4); am = fmaxf(am, fmaxf(fmaxf(fabsf(v[i][0]), fabsf(v[i][1])), fmaxf(fabsf(v[i][2]), fabsf(v[i][3])))); }
    am = wave_max(am);
    const float sc = am > 0.f ? am * (1.0f / 127.0f) : 1.0f, isc = am > 0.f ? 127.0f / am : 0.f;
#pragma unroll
    for (int i = 0; i < 4; ++i) {
        unsigned w = 0;
#pragma unroll
        for (int e = 0; e < 4; ++e) { const int q = (int)rintf(v[i][e] * isc) + (arr == 0 ? 0 : 128); w |= ((unsigned)q & 255u) << (8 * e); }
        dst[i * 64 + lane] = w;
    }
    if (lane == 0) ((float*)(p.ws + (arr == 0 ? OFF_PSU : OFF_PSV)))[row] = sc;
}

DI void norm_rows(const Params& p, const float* xin, const float* gain, const float* shv, const float* scv, bf16_t* out) {
    const int lane = threadIdx.x & 63;
    const int gw = blockIdx.x * 4 + (threadIdx.x >> 6), nw = gridDim.x * 4;
    for (int t = gw; t < NT; t += nw) {
        const int b = t >> 13;
        f32x4 v[4]; float ss = 0.f;
#pragma unroll
        for (int i = 0; i < 4; ++i) { v[i] = *(const f32x4*)(xin + (size_t)t * 1024 + i * 256 + lane * 4); ss += v[i][0] * v[i][0] + v[i][1] * v[i][1] + v[i][2] * v[i][2] + v[i][3] * v[i][3]; }
        ss = wave_sum(ss);
        const float rstd = rsqrtf(ss * (1.0f / 1024.0f) + 1e-6f);
#pragma unroll
        for (int i = 0; i < 4; ++i) {
            const int n = i * 256 + lane * 4;
            const f32x4 g = *(const f32x4*)(gain + n), sc = *(const f32x4*)(scv + b * 6144 + n), sh = *(const f32x4*)(shv + b * 6144 + n);
            float o[4];
#pragma unroll
            for (int e = 0; e < 4; ++e) o[e] = v[i][e] * rstd * g[e] * (1.0f + sc[e]) + sh[e];
            *(u32x2*)(out + (size_t)t * 1024 + n) = pack4(o[0], o[1], o[2], o[3]);
        }
    }
}

DI void phaseB_tile(const Params& p, int mt, int nt, char* lds) {
    const int tid = threadIdx.x, lane = tid & 63, wid = tid >> 6, wm = wid >> 1, wn = wid & 1;
    const int fr = lane & 15, fq = lane >> 4;
    const bf16_t* X = (const bf16_t*)(p.ws + OFF_H) + (size_t)mt * 128 * 1024;
    const bf16_t* W = (const bf16_t*)(p.ws + OFF_W + W_IN) + (size_t)nt * 128 * 1024;
    const int n0 = nt * 128, nb = n0 + wn * 64;
    const int m0 = mt * 128 + wm * 64;
    f32x4 acc[4][4]; zero_acc(acc);
    if (n0 >= 2048 && n0 < 3072) {
        gemm_mainloop<true>(acc, X, 1024, W, 1024, 1024, lds);
        bf16_t* VT = (bf16_t*)(p.ws + OFF_VT);
#pragma unroll
        for (int ni = 0; ni < 4; ++ni) {
            const int col = nb - 2048 + ni * 16 + fr, hh = col >> 7, dv = col & 127, d = dv >> 5, rr = dv & 31;
#pragma unroll
            for (int ti = 0; ti < 4; ++ti) {
                const int tok = m0 + ti * 16 + fq * 4;
                const int b = tok >> 13, s = tok & 8191, kt = s >> 6, kl = s & 63, kb = kl >> 5, x = kl & 31;
                const int s_ = (x >> 4) & 1, jhi = (x >> 3) & 1, h_ = (x >> 2) & 1;
                const size_t base = ((size_t)((b * 8 + hh) * 128 + kt)) * 8192 + (size_t)(((((d * 2 + kb) * 2 + s_) * 2 + h_) * 32 + rr) * 8 + jhi * 4);
                *(u32x2*)(VT + base) = pack4(acc[ti][ni][0], acc[ti][ni][1], acc[ti][ni][2], acc[ti][ni][3]);
            }
        }
        return;
    }
    gemm_mainloop<false>(acc, X, 1024, W, 1024, 1024, lds);
    if (n0 < 2048) {
        const bool isK = n0 >= 1024;
        const int nn = nb - (isK ? 1024 : 0), hh = nn >> 7, c = (nn >> 6) & 1;
        const float scl = isK ? 1.0f : 0.125f * 1.4426950408889634f;
        bf16_t* dst = (bf16_t*)(p.ws + (isK ? OFF_K : OFF_Q));
        const float* rc = (const float*)(p.ws + OFF_ROPE);
        const float* rs = rc + (size_t)NT * 32;
#pragma unroll
        for (int ti = 0; ti < 4; ++ti) {
            const int tok = m0 + ti * 16 + fr, b = tok >> 13, s = tok & 8191;
            bf16_t* row = dst + ((size_t)(((b * 8 + hh) * 2 + c)) * SEQ + s) * 64;
#pragma unroll
            for (int ni = 0; ni < 2; ++ni) {
                const int i0 = ni * 16 + fq * 4;
                const f32x4 cs = *(const f32x4*)(rc + (size_t)tok * 32 + i0), sn = *(const f32x4*)(rs + (size_t)tok * 32 + i0);
                float o1[4], o2[4];
#pragma unroll
                for (int r = 0; r < 4; ++r) {
                    const float t1 = acc[ti][ni][r], t2 = acc[ti][ni + 2][r];
                    o1[r] = (t1 * cs[r] - t2 * sn[r]) * scl; o2[r] = (t2 * cs[r] + t1 * sn[r]) * scl;
                }
                *(u32x2*)(row + i0) = pack4(o1[0], o1[1], o1[2], o1[3]);
                *(u32x2*)(row + 32 + i0) = pack4(o2[0], o2[1], o2[2], o2[3]);
            }
        }
    } else if (n0 < 5120) {
        const int j = (nb - 3072) >> 6;
        bf16_t* UC = (bf16_t*)(p.ws + OFF_UC);
#pragma unroll
        for (int ti = 0; ti < 4; ++ti) {
            const int tok = m0 + ti * 16 + fr;
#pragma unroll
            for (int ni = 0; ni < 2; ++ni) {
                const int ch = 32 * j + ni * 16 + fq * 4;
                float o[4];
#pragma unroll
                for (int r = 0; r < 4; ++r) o[r] = acc[ti][ni][r] * sigmoidf_(acc[ti][ni + 2][r]);
                *(u32x2*)(UC + (size_t)tok * 1024 + ch) = pack4(o[0], o[1], o[2], o[3]);
            }
        }
    } else if (n0 < 8448) {
        bf16_t* ZR = (bf16_t*)(p.ws + OFF_ZR);
#pragma unroll
        for (int ti = 0; ti < 4; ++ti) {
            const int tok = m0 + ti * 16 + fr;
#pragma unroll
            for (int ni = 0; ni < 4; ++ni) {
                const int col = nb - 5120 + ni * 16 + fq * 4;
                *(u32x2*)(ZR + (size_t)tok * RWKV_LD + col) = pack4(acc[ti][ni][0], acc[ti][ni][1], acc[ti][ni][2], acc[ti][ni][3]);
            }
        }
    } else {
        bf16_t* ZG = (bf16_t*)(p.ws + OFF_ZG);
#pragma unroll
        for (int ti = 0; ti < 4; ++ti) {
            const int tok = m0 + ti * 16 + fr;
#pragma unroll
            for (int ni = 0; ni < 4; ++ni) {
                const int col = nb - 8448 + ni * 16 + fq * 4;
                *(u32x2*)(ZG + (size_t)tok * ZG_LD + col) = pack4(sigmoidf_(acc[ti][ni][0]), sigmoidf_(acc[ti][ni][1]), sigmoidf_(acc[ti][ni][2]), sigmoidf_(acc[ti][ni][3]));
            }
        }
    }
}

DI void zr_shift8(const bf16_t* ZR, const float* mu, int tok, int col, float (&z)[8]) {
    const u32x4 cv = *(const u32x4*)(ZR + (size_t)tok * RWKV_LD + col);
    u32x4 pv = (u32x4){0u, 0u, 0u, 0u};
    if ((tok & 8191) != 0) pv = *(const u32x4*)(ZR + (size_t)(tok - 1) * RWKV_LD + col);
    float c[8], q[8]; unpack8(cv, c); unpack8(pv, q);
    const f32x4 m0 = *(const f32x4*)(mu + col), m1 = *(const f32x4*)(mu + col + 4);
#pragma unroll
    for (int e = 0; e < 4; ++e) { z[e] = c[e] + m0[e] * (q[e] - c[e]); z[4 + e] = c[4 + e] + m1[e] * (q[4 + e] - c[4 + e]); }
}
DI void zr_shift4(const bf16_t* ZR, const float* mu, int tok, int col, float (&z)[4]) {
    const u32x2 cv = *(const u32x2*)(ZR + (size_t)tok * RWKV_LD + col);
    u32x2 pv = (u32x2){0u, 0u};
    if ((tok & 8191) != 0) pv = *(const u32x2*)(ZR + (size_t)(tok - 1) * RWKV_LD + col);
    float c[4], q[4]; unpack4(cv, c); unpack4(pv, q);
    const f32x4 m0 = *(const f32x4*)(mu + col);
#pragma unroll
    for (int e = 0; e < 4; ++e) z[e] = c[e] + m0[e] * (q[e] - c[e]);
}

constexpr size_t OFF_LORA = 501 * MiB;
constexpr size_t OFF_CF = 509 * MiB;
DI void lora_in_tile(const Params& p, int l, int tile) {
    const int tid = threadIdx.x, tok = tile * 16 + (tid >> 4), c8 = (tid & 15) * 8;
    const bf16_t* ZR = (const bf16_t*)(p.ws + OFF_ZR);
    const float* mu = (const float*)p.in[I_MU] + (size_t)l * RWKV_LD;
    bf16_t* out = (bf16_t*)(p.ws + OFF_LORA) + (size_t)tok * 256;
    float z[8], y[8];
    zr_shift8(ZR, mu, tok, 3072 + c8, z);
#pragma unroll
    for (int e = 0; e < 8; ++e) y[e] = c8 < 64 ? tanhf(z[e]) : z[e];
    { u32x4 w; w.x = pk2(y[0], y[1]); w.y = pk2(y[2], y[3]); w.z = pk2(y[4], y[5]); w.w = pk2(y[6], y[7]); *(u32x4*)(out + c8) = w; }
}
DI void lora_wa_tile(const Params& p, int l, int which, int mt, int nt, char* lds) {
    const int tid = threadIdx.x, lane = tid & 63, wid = tid >> 6, wm = wid >> 1, wn = wid & 1, fr = lane & 15, fq = lane >> 4;
    const int m0 = mt * 128 + wm * 64, nb = nt * 128 + wn * 64;
    f32x4 acc[4][4]; zero_acc(acc);
    gemm_mainloop<false>(acc, (const bf16_t*)(p.ws + OFF_LORA) + (size_t)mt * 128 * 256 + which * 64, 256,
                         (const bf16_t*)(p.ws + OFF_W + (which == 0 ? W_W2T : W_A2T)) + (size_t)nt * 128 * 64, 64, 64, lds);
    const float* bias = (const float*)p.in[which == 0 ? I_W0 : I_A0] + (size_t)l * 1024;
    bf16_t* dst = (bf16_t*)(p.ws + (which == 0 ? OFF_LW : OFF_A));
    const float scl = which == 0 ? -0.6065306597126334f : 1.0f;
#pragma unroll
    for (int ni = 0; ni < 4; ++ni) {
        const int n = nb + ni * 16 + fq * 4;
        const f32x4 bv = *(const f32x4*)(bias + n);
#pragma unroll
        for (int ti = 0; ti < 4; ++ti) {
            const int tok = m0 + ti * 16 + fr;
            float o[4];
#pragma unroll
            for (int r = 0; r < 4; ++r) o[r] = scl * sigmoidf_(acc[ti][ni][r] + bv[r]);
            *(u32x2*)(dst + (size_t)tok * 1024 + n) = pack4(o[0], o[1], o[2], o[3]);
        }
    }
}

DI void conv_tile(const Params& p, int l, int tile, char* lds) {
    const int tid = threadIdx.x, lane = tid & 63, wid = tid >> 6, t0 = tile * 16, s0 = t0 & 8191;
    const bf16_t* UC = (const bf16_t*)(p.ws + OFF_UC);
    bf16_t* out = (bf16_t*)(p.ws + OFF_CONVP);
    float* su = (float*)lds;
    float* red = su + 46 * 256;
    float s1[16], s2[16];
#pragma unroll
    for (int t = 0; t < 16; ++t) { s1[t] = 0.f; s2[t] = 0.f; }
#pragma unroll 1
    for (int ps = 0; ps < 4; ++ps) {
        const int cbase = ps * 256;
        __syncthreads();
        for (int ch = tid; ch < 46 * 32; ch += 256) {
            const int row = ch >> 5, c8 = (ch & 31) * 8;
            u32x4 v = (u32x4){0u, 0u, 0u, 0u};
            if (s0 - 30 + row >= 0) v = *(const u32x4*)(UC + (size_t)(t0 - 30 + row) * 1024 + cbase + c8);
            float f[8]; unpack8(v, f);
            *(f32x4*)(su + row * 256 + c8) = (f32x4){f[0], f[1], f[2], f[3]};
            *(f32x4*)(su + row * 256 + c8 + 4) = (f32x4){f[4], f[5], f[6], f[7]};
        }
        __syncthreads();
        const int c = cbase + tid;
        float w[31];
#pragma unroll
        for (int j = 0; j < 31; ++j) w[j] = ((const float*)p.in[I_CONVW])[(size_t)l * 31 * 1024 + j * 1024 + c];
        const float bias = ((const float*)p.in[I_CONVB])[l * 1024 + c];
        float acc[16];
#pragma unroll
        for (int t = 0; t < 16; ++t) acc[t] = bias;
#pragma unroll
        for (int rr = 0; rr < 46; ++rr) {
            const float uval = su[rr * 256 + tid];
#pragma unroll
            for (int t = 0; t < 16; ++t) if (rr - t >= 0 && rr - t <= 30) acc[t] += w[rr - t] * uval;
        }
#pragma unroll
        for (int t = 0; t < 16; ++t) {
            const bf16_t hb = f2bf(acc[t]); const float yr = bf2f(hb);
            s1[t] += yr; s2[t] += yr * yr;
            out[(size_t)(t0 + t) * 1024 + c] = hb;
        }
    }
    __syncthreads();
#pragma unroll
    for (int t = 0; t < 16; ++t) {
        const float a = wave_sum(s1[t]), b2 = wave_sum(s2[t]);
        if (lane == 0) { red[(wid * 16 + t) * 2] = a; red[(wid * 16 + t) * 2 + 1] = b2; }
    }
    __syncthreads();
#pragma unroll 1
    for (int ps = 0; ps < 4; ++ps) {
        const int c = ps * 256 + tid;
        const float g = ((const float*)p.in[I_CLNG])[l * 1024 + c], bb = ((const float*)p.in[I_CLNB])[l * 1024 + c];
#pragma unroll
        for (int t = 0; t < 16; ++t) {
            const float a = red[t * 2] + red[(16 + t) * 2] + red[(32 + t) * 2] + red[(48 + t) * 2];
            const float b2 = red[t * 2 + 1] + red[(16 + t) * 2 + 1] + red[(32 + t) * 2 + 1] + red[(48 + t) * 2 + 1];
            const float mean = a * (1.0f / 1024.0f), var = fmaxf(b2 * (1.0f / 1024.0f) - mean * mean, 0.f);
            const float y = bf2f(out[(size_t)(t0 + t) * 1024 + c]);
            const float yn = (y - mean) * rsqrtf(var + 1e-5f) * g + bb;
            out[(size_t)(t0 + t) * 1024 + c] = f2bf(siluf_(yn));
        }
    }
}

constexpr int NSEG = 4, SEGLEN = SEQ / NSEG;
constexpr int SCAN_BUF = 5 * 1024 + 512;
constexpr size_t OFF_FS = 497 * MiB;
static_assert((size_t)NB * 16 * NSEG * 2 * 4096 * 4 <= 15 * MiB, "segment state region");
DI float row8_sum(float x) { x += dpp_f<0xB1>(x); x += dpp_f<0x4E>(x); x += dpp_f<0x141>(x); return x; }
enum { SCAN_PASS1 = 0, SCAN_PASS1_DATA = 1, SCAN_FINAL = 2 };
struct StepVec { f32x2 w[4], a[4], b[4], k[4], r[4]; float v; };
DI f32x2 v2lo(f32x4 v) { return __builtin_shufflevector(v, v, 0, 1); }
DI f32x2 v2hi(f32x4 v) { return __builtin_shufflevector(v, v, 2, 3); }
DI void ld4pairs(const float* q, f32x2 (&d)[4]) { const f32x4 x = *(const f32x4*)q, y = *(const f32x4*)(q + 4); d[0] = v2lo(x); d[1] = v2hi(x); d[2] = v2lo(y); d[3] = v2hi(y); }

template <int MODE>
DI void scan_block(const Params& p, int l, int b, int hh, int seg, int half, char* lds) {
    const int tid = threadIdx.x;
    const int il = tid >> 3, cgp = tid & 7;
    const int ts = tid >> 4, jg = tid & 15;
    float* bufs = (float*)lds;
    float* ybuf = bufs + 2 * SCAN_BUF;
    const bf16_t* ZR = (const bf16_t*)(p.ws + OFF_ZR);
    const bf16_t* Ab = (const bf16_t*)(p.ws + OFF_A);
    const bf16_t* Lb = (const bf16_t*)(p.ws + OFF_LW);
    bf16_t* YS = (bf16_t*)(p.ws + OFF_YS);
    float* FS = (float*)(p.ws + OFF_FS) + (size_t)((b * 16 + hh) * NSEG) * 2 * 4096;
    const float* mu = (const float*)p.in[I_MU] + (size_t)l * RWKV_LD;
    const int ncol = hh * 64 + jg * 4;
    const f32x4 kkv = *(const f32x4*)((const float*)p.in[I_KK] + l * 1024 + ncol);
    const f32x4 kav = *(const f32x4*)((const float*)p.in[I_KA] + l * 1024 + ncol);
    const int tokb = b * SEQ + seg * SEGLEN;
    float rr[4], kk[4], vv[4]; u32x2 av, lv;
    auto stage_load = [&](int c) {
        const int tok = tokb + c * 16 + ts;
        if (MODE == SCAN_FINAL) zr_shift4(ZR, mu, tok, ncol, rr);
        zr_shift4(ZR, mu, tok, 1024 + ncol, kk);
        zr_shift4(ZR, mu, tok, 2048 + ncol, vv);
        av = *(const u32x2*)(Ab + (size_t)tok * 1024 + ncol); lv = *(const u32x2*)(Lb + (size_t)tok * 1024 + ncol);
    };
    auto stage_write = [&](float* buf) {
        float a[4], lw[4]; unpack4(av, a); unpack4(lv, lw);
        float kq[4], ss = 0.f;
#pragma unroll
        for (int e = 0; e < 4; ++e) { kq[e] = kk[e] * kkv[e]; ss += kq[e] * kq[e]; }
        ss = row16_sum(ss);
        const float inv = 1.0f / fmaxf(sqrtf(ss), 1e-12f);
        f32x4 W4, K4, A4, B4, R4;
#pragma unroll
        for (int e = 0; e < 4; ++e) {
            const float kf = kq[e] * inv;
            W4[e] = __expf(lw[e]); K4[e] = kk[e] * (1.0f + (a[e] - 1.0f) * kav[e]); A4[e] = -kf; B4[e] = kf * a[e]; R4[e] = MODE == SCAN_FINAL ? rr[e] : 0.f;
        }
        float* bp = buf + ts * 64 + jg * 4;
        *(f32x4*)(bp) = W4; *(f32x4*)(bp + 1024) = K4; *(f32x4*)(bp + 2048) = A4; *(f32x4*)(bp + 3072) = B4;
        if ((jg >> 3) == half) *(f32x4*)(buf + 5120 + ts * 32 + (jg & 7) * 4) = (f32x4){vv[0], vv[1], vv[2], vv[3]};
        if (MODE == SCAN_FINAL) *(f32x4*)(bp + 4096) = R4;
    };
    f32x2 S[4], P[4];
#pragma unroll
    for (int q = 0; q < 4; ++q) {
        S[q] = (f32x2){0.f, 0.f};
        P[q] = (f32x2){((half * 32 + il) == cgp * 8 + 2 * q) ? 1.0f : 0.f, ((half * 32 + il) == cgp * 8 + 2 * q + 1) ? 1.0f : 0.f};
    }
    __syncthreads();
    if (MODE == SCAN_FINAL && seg > 0) {
        float* srow = (float*)lds;
        for (int q = 0; q < seg; ++q) {
            const float* Zq = FS + (size_t)(q * 2 + 0) * 4096 + (size_t)(half * 32 + il) * 64 + cgp * 8;
            const float* Pq = FS + (size_t)(q * 2 + 1) * 4096 + cgp * 8;
            *(f32x4*)(srow + il * 64 + cgp * 8) = (f32x4){S[0].x, S[0].y, S[1].x, S[1].y};
            *(f32x4*)(srow + il * 64 + cgp * 8 + 4) = (f32x4){S[2].x, S[2].y, S[3].x, S[3].y};
            __syncthreads();
            f32x4 n0 = *(const f32x4*)Zq, n1 = *(const f32x4*)(Zq + 4);
            if (q > 0)
#pragma unroll 4
            for (int m = 0; m < 64; ++m) {
                const float sm = srow[il * 64 + m];
                n0 += sm * *(const f32x4*)(Pq + (size_t)m * 64); n1 += sm * *(const f32x4*)(Pq + (size_t)m * 64 + 4);
            }
            __syncthreads();
            S[0] = v2lo(n0); S[1] = v2hi(n0); S[2] = v2lo(n1); S[3] = v2hi(n1);
        }
    }
    stage_load(0); stage_write(bufs);
    __syncthreads();
    constexpr int NCH = SEGLEN / 16;
    for (int c = 0; c < NCH; ++c) {
        const float* buf = bufs + (c & 1) * SCAN_BUF;
        float* yb = ybuf + (c & 1) * 512;
        if (MODE == SCAN_FINAL && c > 0) {
            const float* yp = ybuf + ((c - 1) & 1) * 512;
#pragma unroll
            for (int q = 0; q < 2; ++q) { const int idx = tid + 256 * q; YS[(size_t)(tokb + (c - 1) * 16 + (idx >> 5)) * 1024 + hh * 64 + half * 32 + (idx & 31)] = f2bf(yp[idx]); }
        }
        if (c + 1 < NCH) stage_load(c + 1);
        float ykeep0 = 0.f, ykeep1 = 0.f;
        auto ldstep = [&](int t, StepVec& sv) {
            const float* bp = buf + t * 64 + cgp * 8;
            ld4pairs(bp, sv.w); ld4pairs(bp + 1024, sv.k); ld4pairs(bp + 2048, sv.a); ld4pairs(bp + 3072, sv.b);
            if (MODE == SCAN_FINAL) ld4pairs(bp + 4096, sv.r);
            sv.v = buf[5120 + t * 32 + il];
        };
        StepVec sv[2];
        ldstep(0, sv[0]);
#pragma unroll 2
        for (int t = 0; t < 16; ++t) {
            ldstep(t + 1, sv[(t + 1) & 1]);
            const StepVec& x = sv[t & 1];
            f32x2 d2 = S[0] * x.a[0]; d2 = S[1] * x.a[1] + d2; d2 = S[2] * x.a[2] + d2; d2 = S[3] * x.a[3] + d2;
            float sa = d2.x + d2.y;
            const f32x2 vv2 = (f32x2){x.v, x.v};
            f32x2 tq[4];
#pragma unroll
            for (int e = 0; e < 4; ++e) tq[e] = S[e] * x.w[e] + vv2 * x.k[e];
            sa = row8_sum(sa);
            const f32x2 sa2 = (f32x2){sa, sa};
#pragma unroll
            for (int e = 0; e < 4; ++e) S[e] = tq[e] + sa2 * x.b[e];
            if (MODE == SCAN_PASS1) {
                f32x2 e2 = P[0] * x.a[0]; e2 = P[1] * x.a[1] + e2; e2 = P[2] * x.a[2] + e2; e2 = P[3] * x.a[3] + e2;
                float pa = e2.x + e2.y;
                f32x2 pq[4];
#pragma unroll
                for (int e = 0; e < 4; ++e) pq[e] = P[e] * x.w[e];
                pa = row8_sum(pa);
                const f32x2 pa2 = (f32x2){pa, pa};
#pragma unroll
                for (int e = 0; e < 4; ++e) P[e] = pq[e] + pa2 * x.b[e];
            }
            if (MODE == SCAN_FINAL) {
                f32x2 y2 = S[0] * x.r[0]; y2 = S[1] * x.r[1] + y2; y2 = S[2] * x.r[2] + y2; y2 = S[3] * x.r[3] + y2;
                float y = y2.x + y2.y;
                y = row8_sum(y);
                if (cgp == (t & 7)) { if (t < 8) ykeep0 = y; else ykeep1 = y; }
            }
            __builtin_amdgcn_sched_barrier(0);
        }
        if (MODE == SCAN_FINAL) { yb[cgp * 32 + il] = ykeep0; yb[(cgp + 8) * 32 + il] = ykeep1; }
        if (c + 1 < NCH) stage_write(bufs + ((c + 1) & 1) * SCAN_BUF);
        __syncthreads();
    }
    if (MODE == SCAN_FINAL) {
        const float* yp = ybuf + ((NCH - 1) & 1) * 512;
#pragma unroll
        for (int q = 0; q < 2; ++q) { const int idx = tid + 256 * q; YS[(size_t)(tokb + (NCH - 1) * 16 + (idx >> 5)) * 1024 + hh * 64 + half * 32 + (idx & 31)] = f2bf(yp[idx]); }
    } else {
        float* dz = FS + (size_t)(seg * 2 + 0) * 4096 + (size_t)(half * 32 + il) * 64 + cgp * 8;
        *(f32x4*)dz = (f32x4){S[0].x, S[0].y, S[1].x, S[1].y}; *(f32x4*)(dz + 4) = (f32x4){S[2].x, S[2].y, S[3].x, S[3].y};
        if (MODE == SCAN_PASS1) {
            float* dp = FS + (size_t)(seg * 2 + 1) * 4096 + (size_t)(half * 32 + il) * 64 + cgp * 8;
            *(f32x4*)dp = (f32x4){P[0].x, P[0].y, P[1].x, P[1].y}; *(f32x4*)(dp + 4) = (f32x4){P[2].x, P[2].y, P[3].x, P[3].y};
        }
    }
}
constexpr int N_SCAN1 = 64 * (NSEG - 1), N_SCAN2 = 64 * NSEG;
DI void scan_item_pass1(const Params& p, int l, int it, char* lds) {
    const int half = it & 1, bh = (it >> 1) & 31, seg = (NSEG - 2) - (it >> 6);
    if (seg == 0) scan_block<SCAN_PASS1_DATA>(p, l, bh >> 4, bh & 15, seg, half, lds);
    else scan_block<SCAN_PASS1>(p, l, bh >> 4, bh & 15, seg, half, lds);
}
DI void scan_item_pass2(const Params& p, int l, int it, char* lds) {
    const int half = it & 1, bh = (it >> 1) & 31, seg = it >> 6;
    scan_block<SCAN_FINAL>(p, l, bh >> 4, bh & 15, seg, half, lds);
}

namespace cs {
constexpr int LDA = 72, LDB = 40;
constexpr int O_LW = 0;
constexpr int O_AT = O_LW + 4096;
constexpr int O_RT = O_AT + 16 * LDA * 2;
constexpr int O_BG = O_RT + 16 * LDA * 2;
constexpr int O_KG = O_BG + 16 * LDA * 2;
constexpr int O_BKT = O_KG + 16 * LDA * 2;
constexpr int O_UV = O_BKT + 64 * LDB * 2;
constexpr int O_XA = O_UV + 64 * LDB * 2;
constexpr int O_SA = O_XA + 64 * LDB * 2;
constexpr int O_ABB = O_SA + 64 * LDA * 2;
constexpr int O_AKB = O_ABB + 16 * 17 * 4 + 64;
constexpr int O_BRK = O_AKB + 16 * LDB * 2;
constexpr int O_TT = O_BRK + 16 * LDB * 2;
constexpr int O_G15 = O_TT + 64 * LDB * 2;
constexpr int O_END = O_G15 + 256;
static_assert(O_END <= 60000, "chunked-scan LDS map");
}
constexpr size_t OFF_TTG = 497 * MiB;
DI void scan_T_item(const Params& p, int l, int item, char* lds) {
    using namespace cs;
    const int tid = threadIdx.x, lane = tid & 63, wv = tid >> 6, fr = lane & 15, fq = lane >> 4;
    const int bh = item >> 7, grp = item & 127, b = bh >> 4, hh = bh & 15;
    const int ts = tid >> 4, jg = tid & 15;
    const bf16_t* ZR = (const bf16_t*)(p.ws + OFF_ZR);
    const bf16_t* Ab = (const bf16_t*)(p.ws + OFF_A);
    const bf16_t* Lb = (const bf16_t*)(p.ws + OFF_LW);
    const float* mu = (const float*)p.in[I_MU] + (size_t)l * RWKV_LD;
    const int ncol = hh * 64 + jg * 4;
    const f32x4 kkv = *(const f32x4*)((const float*)p.in[I_KK] + l * 1024 + ncol);
    float* sLW = (float*)lds;
    bf16_t* sA = (bf16_t*)(lds + 16384);
    bf16_t* sB = sA + 4 * 16 * LDA;
    float an[4][4], bn[4][4], lw[4][4];
    __syncthreads();
#pragma unroll
    for (int q = 0; q < 4; ++q) {
        const int tok = b * SEQ + (grp * 4 + q) * 16 + ts;
        float kk[4], a[4];
        zr_shift4(ZR, mu, tok, 1024 + ncol, kk);
        unpack4(*(const u32x2*)(Ab + (size_t)tok * 1024 + ncol), a);
        unpack4(*(const u32x2*)(Lb + (size_t)tok * 1024 + ncol), lw[q]);
        float kq[4], ss = 0.f;
#pragma unroll
        for (int e = 0; e < 4; ++e) { kq[e] = kk[e] * kkv[e]; ss += kq[e] * kq[e]; }
        ss = row16_sum(ss);
        const float inv = 1.0f / fmaxf(sqrtf(ss), 1e-12f);
#pragma unroll
        for (int e = 0; e < 4; ++e) { const float kf = kq[e] * inv; an[q][e] = -kf; bn[q][e] = kf * a[e]; }
        *(f32x4*)(sLW + (q * 16 + ts) * 64 + jg * 4) = (f32x4){lw[q][0], lw[q][1], lw[q][2], lw[q][3]};
    }
    __syncthreads();
#pragma unroll
    for (int q = 0; q < 4; ++q) {
        f32x4 pin = (f32x4){0.f, 0.f, 0.f, 0.f};
#pragma unroll
        for (int t = 0; t < 16; ++t) { const f32x4 x = *(const f32x4*)(sLW + (q * 16 + t) * 64 + jg * 4); if (t <= ts) pin += x; }
        float at4[4], bt4[4];
#pragma unroll
        for (int e = 0; e < 4; ++e) { at4[e] = an[q][e] * __expf(pin[e] - lw[q][e]); bt4[e] = bn[q][e] * __expf(-pin[e]); }
        *(u32x2*)(sA + (q * 16 + ts) * LDA + jg * 4) = pack4(at4[0], at4[1], at4[2], at4[3]);
        *(u32x2*)(sB + (q * 16 + ts) * LDA + jg * 4) = pack4(bt4[0], bt4[1], bt4[2], bt4[3]);
    }
    __syncthreads();
    f32x4 cg = (f32x4){0.f, 0.f, 0.f, 0.f};
#pragma unroll
    for (int ks = 0; ks < 2; ++ks) cg = MFMA16(*(const bf16x8*)(sB + (wv * 16 + fr) * LDA + ks * 32 + fq * 8), *(const bf16x8*)(sA + (wv * 16 + fr) * LDA + ks * 32 + fq * 8), cg);
#pragma unroll
    for (int r = 0; r < 4; ++r) if (fq * 4 + r >= fr) cg[r] = 0.f;
    float Tr[16];
#pragma unroll
    for (int sidx = 15; sidx >= 0; --sidx) {
        float acc = (sidx == fr) ? 1.0f : 0.f;
#pragma unroll
        for (int m = sidx + 1; m < 16; ++m) {
            const float asm_ = __int_as_float(__builtin_amdgcn_readlane(__float_as_int(cg[sidx & 3]), (sidx >> 2) * 16 + m));
            acc += asm_ * Tr[m];
        }
        Tr[sidx] = acc;
    }
    if (fq == 0) {
        bf16_t* dst = (bf16_t*)(p.ws + OFF_TTG) + ((size_t)(bh * 512 + grp * 4 + wv) * 16 + fr) * 16;
        u32x4 w0, w1;
        w0.x = pk2(Tr[0], Tr[1]); w0.y = pk2(Tr[2], Tr[3]); w0.z = pk2(Tr[4], Tr[5]); w0.w = pk2(Tr[6], Tr[7]);
        w1.x = pk2(Tr[8], Tr[9]); w1.y = pk2(Tr[10], Tr[11]); w1.z = pk2(Tr[12], Tr[13]); w1.w = pk2(Tr[14], Tr[15]);
        *(u32x4*)dst = w0; *(u32x4*)(dst + 8) = w1;
    }
}
constexpr int MSEG = 4, MCPS = (SEQ / 16) / MSEG;
constexpr size_t OFF_FS2 = 506 * MiB;
enum { MS_FINAL = 0, MS_DATA1 = 1, MS_IDENT = 2 };
template <int MODE>
DI void scan_mfma_block(const Params& p, int l, int b, int hh, int seg, char* lds) {
    using namespace cs;
    const int tid = threadIdx.x, lane = tid & 63, wv = tid >> 6, fr = lane & 15, fq = lane >> 4;
    const int ts = tid >> 4, jg = tid & 15;
    const bf16_t* ZR = (const bf16_t*)(p.ws + OFF_ZR);
    const bf16_t* Ab = (const bf16_t*)(p.ws + OFF_A);
    const bf16_t* Lb = (const bf16_t*)(p.ws + OFF_LW);
    const bf16_t* TTg = (const bf16_t*)(p.ws + OFF_TTG) + (size_t)((b * 16 + hh) * 512) * 256;
    bf16_t* YS = (bf16_t*)(p.ws + OFF_YS);
    const float* mu = (const float*)p.in[I_MU] + (size_t)l * RWKV_LD;
    const int ncol = hh * 64 + jg * 4;
    const f32x4 kkv = *(const f32x4*)((const float*)p.in[I_KK] + l * 1024 + ncol);
    const f32x4 kav = *(const f32x4*)((const float*)p.in[I_KA] + l * 1024 + ncol);
    float* sLW = (float*)(lds + O_LW);
    bf16_t* sAT = (bf16_t*)(lds + O_AT); bf16_t* sRT = (bf16_t*)(lds + O_RT); bf16_t* sBG = (bf16_t*)(lds + O_BG); bf16_t* sKG = (bf16_t*)(lds + O_KG);
    bf16_t* sBKT = (bf16_t*)(lds + O_BKT);
    bf16_t* sUV = (bf16_t*)(lds + O_UV) + wv * 16 * LDB; bf16_t* sXA = (bf16_t*)(lds + O_XA) + wv * 16 * LDB; bf16_t* sSA = (bf16_t*)(lds + O_SA) + wv * 16 * LDA;
    bf16_t* sAKB = (bf16_t*)(lds + O_AKB); bf16_t* sBRK = (bf16_t*)(lds + O_BRK);
    float* sG15 = (float*)(lds + O_G15);
    __syncthreads();
    for (int i = tid; i < O_END / 4; i += NTHREADS) ((unsigned*)lds)[i] = 0u;
    f32x4 S[4];
#pragma unroll
    for (int cb = 0; cb < 4; ++cb)
#pragma unroll
        for (int r = 0; r < 4; ++r) S[cb][r] = (MODE == MS_IDENT && (wv * 16 + fq * 4 + r) == (cb * 16 + fr)) ? 1.0f : 0.f;
    float* FS = (float*)(p.ws + OFF_FS2) + (size_t)((b * 16 + hh) * (MSEG - 1)) * 2 * 4096;
    if (MODE == MS_FINAL && seg > 0) {
        float* sS = (float*)lds + wv * 1024;
        for (int q = 0; q < seg; ++q) {
            const float* Zq = FS + (size_t)(q * 2 + 0) * 4096;
            const float* Pq = FS + (size_t)(q * 2 + 1) * 4096;
            f32x4 nw[4];
#pragma unroll
            for (int cb = 0; cb < 4; ++cb)
#pragma unroll
                for (int r = 0; r < 4; ++r) nw[cb][r] = Zq[(size_t)(wv * 16 + fq * 4 + r) * 64 + cb * 16 + fr];
            if (q > 0) {
                __syncthreads();
#pragma unroll
                for (int cb = 0; cb < 4; ++cb)
#pragma unroll
                    for (int r = 0; r < 4; ++r) sS[(fq * 4 + r) * 64 + cb * 16 + fr] = S[cb][r];
                __syncthreads();
#pragma unroll 1
                for (int m = 0; m < 64; ++m) {
                    const float p0 = Pq[m * 64 + fr], p1 = Pq[m * 64 + 16 + fr], p2 = Pq[m * 64 + 32 + fr], p3 = Pq[m * 64 + 48 + fr];
#pragma unroll
                    for (int r = 0; r < 4; ++r) { const float sm = sS[(fq * 4 + r) * 64 + m]; nw[0][r] += sm * p0; nw[1][r] += sm * p1; nw[2][r] += sm * p2; nw[3][r] += sm * p3; }
                }
            }
#pragma unroll
            for (int cb = 0; cb < 4; ++cb) S[cb] = nw[cb];
        }
        __syncthreads();
        for (int i = tid; i < 4096; i += NTHREADS) ((unsigned*)lds)[i] = 0u;
        __syncthreads();
#pragma unroll
        for (int cb = 0; cb < 4; ++cb)
#pragma unroll
            for (int r = 0; r < 4; ++r) sSA[(fq * 4 + r) * LDA + cb * 16 + fr] = f2bf(S[cb][r]);
    } else if (MODE == MS_IDENT) {
        __syncthreads();
#pragma unroll
        for (int cb = 0; cb < 4; ++cb)
#pragma unroll
            for (int r = 0; r < 4; ++r) sSA[(fq * 4 + r) * LDA + cb * 16 + fr] = f2bf(S[cb][r]);
    }
    const int tokb = b * SEQ + seg * MCPS * 16;
    float rr[4], kk[4], vv[4]; u32x2 av, lv; u32x4 tq;
    auto stage_load = [&](int c) {
        const int tok = tokb + c * 16 + ts;
        zr_shift4(ZR, mu, tok, ncol, rr); zr_shift4(ZR, mu, tok, 1024 + ncol, kk); zr_shift4(ZR, mu, tok, 2048 + ncol, vv);
        av = *(const u32x2*)(Ab + (size_t)tok * 1024 + ncol); lv = *(const u32x2*)(Lb + (size_t)tok * 1024 + ncol);
        tq = *(const u32x4*)(TTg + (size_t)(seg * MCPS + c) * 256 + fr * 16 + (fq & 1) * 8);
    };
    stage_load(0);
    for (int c = 0; c < MCPS; ++c) {
        float a[4], lw[4]; unpack4(av, a); unpack4(lv, lw);
        float kq[4], ss = 0.f;
#pragma unroll
        for (int e = 0; e < 4; ++e) { kq[e] = kk[e] * kkv[e]; ss += kq[e] * kq[e]; }
        ss = row16_sum(ss);
        const float inv = 1.0f / fmaxf(sqrtf(ss), 1e-12f);
        float kn[4], an[4], bn[4], rn[4], vn[4];
#pragma unroll
        for (int e = 0; e < 4; ++e) { const float kf = kq[e] * inv; kn[e] = kk[e] * (1.0f + (a[e] - 1.0f) * kav[e]); an[e] = -kf; bn[e] = kf * a[e]; rn[e] = rr[e]; vn[e] = vv[e]; }
        const bf16x8 tfrag = fq < 2 ? __builtin_bit_cast(bf16x8, tq) : (bf16x8){0, 0, 0, 0, 0, 0, 0, 0};
        *(f32x4*)(sLW + ts * 64 + jg * 4) = (f32x4){lw[0], lw[1], lw[2], lw[3]};
        if (c + 1 < MCPS) stage_load(c + 1);
        __syncthreads();
        f32x4 pin = (f32x4){0.f, 0.f, 0.f, 0.f}, pall = pin;
#pragma unroll
        for (int t = 0; t < 16; ++t) { const f32x4 x = *(const f32x4*)(sLW + t * 64 + jg * 4); pall += x; if (t <= ts) pin += x; }
        {
            float at4[4], rt4[4], bt4[4], kt4[4];
#pragma unroll
            for (int e = 0; e < 4; ++e) {
                const float g = __expf(pin[e]), gp = __expf(pin[e] - lw[e]), gi = __expf(-pin[e]);
                at4[e] = an[e] * gp; rt4[e] = rn[e] * g; bt4[e] = bn[e] * gi; kt4[e] = kn[e] * gi;
            }
            *(u32x2*)(sAT + ts * LDA + jg * 4) = pack4(at4[0], at4[1], at4[2], at4[3]);
            *(u32x2*)(sRT + ts * LDA + jg * 4) = pack4(rt4[0], rt4[1], rt4[2], rt4[3]);
            *(u32x2*)(sBG + ts * LDA + jg * 4) = pack4(bt4[0], bt4[1], bt4[2], bt4[3]);
            *(u32x2*)(sKG + ts * LDA + jg * 4) = pack4(kt4[0], kt4[1], kt4[2], kt4[3]);
#pragma unroll
            for (int e = 0; e < 4; ++e) {
                sBKT[(jg * 4 + e) * LDB + ts] = f2bf(bt4[e]); sBKT[(jg * 4 + e) * LDB + 16 + ts] = f2bf(kt4[e]);
                if (MODE != MS_IDENT) ((bf16_t*)(lds + O_UV))[((jg >> 2) * 16 + (jg & 3) * 4 + e) * LDB + 16 + ts] = f2bf(vn[e]);
            }
            if (ts == 15) *(f32x4*)(sG15 + jg * 4) = (f32x4){__expf(pall[0]), __expf(pall[1]), __expf(pall[2]), __expf(pall[3])};
        }
        __syncthreads();
        if (wv != 0) {
            const bf16_t* P = (wv & 1) ? sKG : sBG;
            const bf16_t* Q = (wv & 2) ? sRT : sAT;
            f32x4 cg = (f32x4){0.f, 0.f, 0.f, 0.f};
#pragma unroll
            for (int ks = 0; ks < 2; ++ks) cg = MFMA16(*(const bf16x8*)(P + fr * LDA + ks * 32 + fq * 8), *(const bf16x8*)(Q + fr * LDA + ks * 32 + fq * 8), cg);
#pragma unroll
            for (int r = 0; r < 4; ++r) { const int sidx = fq * 4 + r; const bool keep = (wv & 2) ? (sidx <= fr) : (sidx < fr); if (!keep) cg[r] = 0.f; }
            if (wv == 1) *(u32x2*)(sAKB + fr * LDB + 16 + fq * 4) = pack4(cg[0], cg[1], cg[2], cg[3]);
            else if (wv == 2) *(u32x2*)(sBRK + fr * LDB + fq * 4) = pack4(cg[0], cg[1], cg[2], cg[3]);
            else *(u32x2*)(sBRK + fr * LDB + 16 + fq * 4) = pack4(cg[0], cg[1], cg[2], cg[3]);
        }
        __syncthreads();
        f32x4 x1 = (f32x4){0.f, 0.f, 0.f, 0.f}, yv = x1;
        {
            const bf16x8 s0 = *(const bf16x8*)(sSA + fr * LDA + fq * 8), s1 = *(const bf16x8*)(sSA + fr * LDA + 32 + fq * 8);
            const bf16x8 uv = *(const bf16x8*)(sUV + fr * LDB + fq * 8);
            x1 = MFMA16(s0, *(const bf16x8*)(sAT + fr * LDA + fq * 8), x1);
            x1 = MFMA16(s1, *(const bf16x8*)(sAT + fr * LDA + 32 + fq * 8), x1);
            x1 = MFMA16(uv, *(const bf16x8*)(sAKB + fr * LDB + fq * 8), x1);
            yv = MFMA16(s0, *(const bf16x8*)(sRT + fr * LDA + fq * 8), yv);
            yv = MFMA16(s1, *(const bf16x8*)(sRT + fr * LDA + 32 + fq * 8), yv);
        }
#pragma unroll
        for (int r = 0; r < 4; ++r) sXA[(fq * 4 + r) * LDB + fr] = f2bf(x1[r]);
        asm volatile("s_waitcnt lgkmcnt(0)" ::: "memory");
        f32x4 u = (f32x4){0.f, 0.f, 0.f, 0.f};
        u = MFMA16(*(const bf16x8*)(sXA + fr * LDB + fq * 8), tfrag, u);
#pragma unroll
        for (int r = 0; r < 4; ++r) sUV[(fq * 4 + r) * LDB + fr] = f2bf(u[r]);
        asm volatile("s_waitcnt lgkmcnt(0)" ::: "memory");
        {
            const bf16x8 uv = *(const bf16x8*)(sUV + fr * LDB + fq * 8);
            yv = MFMA16(uv, *(const bf16x8*)(sBRK + fr * LDB + fq * 8), yv);
#pragma unroll
            for (int cb = 0; cb < 4; ++cb) S[cb] = MFMA16(uv, *(const bf16x8*)(sBKT + (cb * 16 + fr) * LDB + fq * 8), S[cb]);
        }
        if (MODE == MS_FINAL) *(u32x2*)(YS + (size_t)(tokb + c * 16 + fr) * 1024 + hh * 64 + wv * 16 + fq * 4) = pack4(yv[0], yv[1], yv[2], yv[3]);
#pragma unroll
        for (int cb = 0; cb < 4; ++cb) {
            const float g15 = sG15[cb * 16 + fr];
#pragma unroll
            for (int r = 0; r < 4; ++r) { S[cb][r] *= g15; sSA[(fq * 4 + r) * LDA + cb * 16 + fr] = f2bf(S[cb][r]); }
        }
    }
    if (MODE != MS_FINAL) {
        float* dst = FS + (size_t)(seg * 2 + (MODE == MS_IDENT ? 1 : 0)) * 4096;
#pragma unroll
        for (int cb = 0; cb < 4; ++cb)
#pragma unroll
            for (int r = 0; r < 4; ++r) dst[(size_t)(wv * 16 + fq * 4 + r) * 64 + cb * 16 + fr] = S[cb][r];
    }
}
constexpr int N_MS1 = 32 * (1 + 2 * (MSEG - 2)), N_MS2 = 32 * MSEG;
DI void ms_item_pass1(const Params& p, int l, int it, char* lds) {
    const int bh = it & 31, k = it >> 5;
    if (k & 1) scan_mfma_block<MS_IDENT>(p, l, bh >> 4, bh & 15, (k + 1) >> 1, lds);
    else scan_mfma_block<MS_DATA1>(p, l, bh >> 4, bh & 15, k >> 1, lds);
}
DI void ms_item_pass2(const Params& p, int l, int it, char* lds) {
    const int bh = it & 31, seg = it >> 5;
    scan_mfma_block<MS_FINAL>(p, l, bh >> 4, bh & 15, seg, lds);
}

constexpr int ATT_LDK = 72;
DI void attn_unit(const Params& p, int l, int unit, char* lds) {
    const int tid = threadIdx.x, lane = tid & 63, wid = tid >> 6, c = wid >> 1, qs = wid & 1, r32 = lane & 31, h = lane >> 5;
    const int qb = 127 - (unit >> 4), bh = unit & 15, hh = bh & 7, b = bh >> 3;
    const bf16_t* Qg = (const bf16_t*)(p.ws + OFF_Q);
    const bf16_t* Kg = (const bf16_t*)(p.ws + OFF_K);
    const bf16_t* VTg = (const bf16_t*)(p.ws + OFF_VT) + (size_t)bh * 128 * 8192;
    const int query = qb * 64 + qs * 32 + r32;
    bf16x8 qf[4];
#pragma unroll
    for (int ks = 0; ks < 4; ++ks) qf[ks] = *(const bf16x8*)(Qg + ((size_t)(bh * 2 + c) * SEQ + query) * 64 + ks * 16 + h * 8);
    auto issue = [&](int kt) {
        char* st = lds + (kt & 1) * 32768 + tid * 16;
#pragma unroll
        for (int i = 0; i < 4; ++i) {
            const int bb = tid * 16 + i * 4096, cm = bb >> 13, row = (bb >> 7) & 63, kc = ((bb >> 4) & 7) ^ ((row >> 1) & 7);
            __builtin_amdgcn_global_load_lds((const unsigned*)(Kg + ((size_t)(bh * 2 + cm) * SEQ + kt * 64 + row) * 64 + kc * 8), (LDSP unsigned*)(st + i * 4096), 16, 0, 0);
            __builtin_amdgcn_global_load_lds((const unsigned*)(VTg + (size_t)kt * 8192 + (tid + 256 * i) * 8), (LDSP unsigned*)(st + 16384 + i * 4096), 16, 0, 0);
        }
    };
    f32x16 O[4];
#pragma unroll
    for (int d = 0; d < 4; ++d)
#pragma unroll
        for (int e = 0; e < 16; ++e) O[d][e] = 0.f;
    float m_run = -INFINITY, lsum = 0.f;
    const int kswz = (r32 >> 1) & 7;
    issue(0);
    for (int kt = 0; kt <= qb; ++kt) {
        asm volatile("s_waitcnt vmcnt(0)" ::: "memory");
        __syncthreads();
        if (kt < qb) issue(kt + 1);
        const char* sKb = lds + (kt & 1) * 32768;
        const bf16_t* sVT = (const bf16_t*)(sKb + 16384);
        f32x16 st[2];
#pragma unroll
        for (int kb = 0; kb < 2; ++kb) {
#pragma unroll
            for (int e = 0; e < 16; ++e) st[kb][e] = 0.f;
#pragma unroll
            for (int ks = 0; ks < 4; ++ks) {
                const bf16x8 kf = *(const bf16x8*)(sKb + (c * 64 + kb * 32 + r32) * 128 + (((ks * 2 + h) ^ kswz) << 4));
                st[kb] = MFMA32(kf, qf[ks], st[kb]);
            }
        }
        if (kt == qb) {
            const int ql = qs * 32 + r32;
#pragma unroll
            for (int kb = 0; kb < 2; ++kb)
#pragma unroll
                for (int e = 0; e < 16; ++e) { const int keyl = kb * 32 + (e & 3) + 8 * (e >> 2) + 4 * h; if (keyl > ql) st[kb][e] = -INFINITY; }
        }
        float mx = st[0][0];
#pragma unroll
        for (int kb = 0; kb < 2; ++kb)
#pragma unroll
            for (int e = 0; e < 16; ++e) mx = fmaxf(mx, st[kb][e]);
        mx = fmaxf(mx, __shfl_xor(mx, 32));
        if (__any(mx > m_run + 8.0f)) {
            const float mnew = fmaxf(m_run, mx);
            const float alpha = __builtin_amdgcn_exp2f(m_run - mnew);
            m_run = mnew;
            lsum *= alpha;
#pragma unroll
            for (int d = 0; d < 4; ++d)
#pragma unroll
                for (int e = 0; e < 16; ++e) O[d][e] *= alpha;
        }
        float ps = 0.f;
#pragma unroll
        for (int kb = 0; kb < 2; ++kb)
#pragma unroll
            for (int e = 0; e < 16; ++e) { st[kb][e] = __builtin_amdgcn_exp2f(st[kb][e] - m_run); ps += st[kb][e]; }
        lsum += ps;
        bf16x8 pf[2][2];
#pragma unroll
        for (int kb = 0; kb < 2; ++kb)
#pragma unroll
            for (int s = 0; s < 2; ++s) {
                u32x4 pk;
                pk.x = pk2(st[kb][8 * s + 0], st[kb][8 * s + 1]); pk.y = pk2(st[kb][8 * s + 2], st[kb][8 * s + 3]);
                pk.z = pk2(st[kb][8 * s + 4], st[kb][8 * s + 5]); pk.w = pk2(st[kb][8 * s + 6], st[kb][8 * s + 7]);
                pf[kb][s] = __builtin_bit_cast(bf16x8, pk);
            }
#pragma unroll
        for (int d = 0; d < 4; ++d)
#pragma unroll
            for (int kb = 0; kb < 2; ++kb)
#pragma unroll
                for (int s = 0; s < 2; ++s) {
                    const bf16x8 vf = *(const bf16x8*)(sVT + (((d * 2 + kb) * 2 + s) * 64 + lane) * 8);
                    O[d] = MFMA32(vf, pf[kb][s], O[d]);
                }
    }
    const float ltot = lsum + __shfl_xor(lsum, 32);
    const float inv = 1.0f / ltot;
    float* xo = (float*)lds;
    __syncthreads();
    if (c == 1) {
#pragma unroll
        for (int d = 0; d < 4; ++d)
#pragma unroll
            for (int e = 0; e < 16; ++e) xo[(qs * 64 + d * 16 + e) * 64 + lane] = O[d][e] * inv;
    }
    __syncthreads();
    if (c == 0) {
        const float lam = ((const float*)(p.ws + OFF_CTRL + CT_LAM))[l];
        const float lam_init = 0.8f - 0.6f * expf(-0.3f * (float)l);
        float ss = 0.f;
#pragma unroll
        for (int d = 0; d < 4; ++d)
#pragma unroll
            for (int e = 0; e < 16; ++e) { const float o = O[d][e] * inv - lam * xo[(qs * 64 + d * 16 + e) * 64 + lane]; O[d][e] = o; ss += o * o; }
        ss += __shfl_xor(ss, 32);
        const float rstd = rsqrtf(ss * (1.0f / 128.0f) + 1e-6f) * (1.0f - lam_init);
        bf16_t* outp = (bf16_t*)(p.ws + OFF_ATTP) + (size_t)(b * SEQ + query) * 1024 + hh * 128;
        const float* hg = (const float*)p.in[I_AHG] + (size_t)(l * 8 + hh) * 128;
#pragma unroll
        for (int d = 0; d < 4; ++d)
#pragma unroll
            for (int g4 = 0; g4 < 4; ++g4) {
                const int dv0 = d * 32 + 8 * g4 + 4 * h;
                const f32x4 g = *(const f32x4*)(hg + dv0);
                *(u32x2*)(outp + dv0) = pack4(O[d][g4 * 4 + 0] * rstd * g[0], O[d][g4 * 4 + 1] * rstd * g[1], O[d][g4 * 4 + 2] * rstd * g[2], O[d][g4 * 4 + 3] * rstd * g[3]);
            }
    }
}

DI void rwkv_post_tile(const Params& p, int l, int tile, char* lds) {
    const int tid = threadIdx.x, t0 = tile * 16, n4 = tid * 4;
    const bf16_t* ZR = (const bf16_t*)(p.ws + OFF_ZR);
    const bf16_t* Ab = (const bf16_t*)(p.ws + OFF_A);
    const bf16_t* YS = (const bf16_t*)(p.ws + OFF_YS);
    const float* mu = (const float*)p.in[I_MU] + (size_t)l * RWKV_LD;
    float* sg = (float*)lds;
    __syncthreads();
    {
        const int tk = tid >> 4, c8 = (tid & 15) * 8;
        float z[8]; zr_shift8(ZR, mu, t0 + tk, 3200 + c8, z);
#pragma unroll
        for (int e = 0; e < 8; ++e) sg[tk * 128 + c8 + e] = sigmoidf_(z[e]);
    }
    __syncthreads();
    f32x4 gacc[16];
#pragma unroll
    for (int t = 0; t < 16; ++t) gacc[t] = (f32x4){0.f, 0.f, 0.f, 0.f};
    const float* g2 = (const float*)p.in[I_G2] + (size_t)l * 128 * 1024 + n4;
#pragma unroll 2
    for (int k = 0; k < 128; k += 4) {
        const f32x4 w0 = *(const f32x4*)(g2 + (size_t)(k + 0) * 1024), w1 = *(const f32x4*)(g2 + (size_t)(k + 1) * 1024),
                    w2 = *(const f32x4*)(g2 + (size_t)(k + 2) * 1024), w3 = *(const f32x4*)(g2 + (size_t)(k + 3) * 1024);
#pragma unroll
        for (int t = 0; t < 16; ++t) {
            const f32x4 a = *(const f32x4*)(sg + t * 128 + k);
            gacc[t] += a[0] * w0 + a[1] * w1 + a[2] * w2 + a[3] * w3;
        }
    }
    const f32x4 kav = *(const f32x4*)((const float*)p.in[I_KA] + l * 1024 + n4);
    const f32x4 rkv = *(const f32x4*)((const float*)p.in[I_RK] + l * 1024 + n4);
    const f32x4 gng = *(const f32x4*)((const float*)p.in[I_GNG] + l * 1024 + n4);
    const f32x4 gnb = *(const f32x4*)((const float*)p.in[I_GNB] + l * 1024 + n4);
    bf16_t* out = (bf16_t*)(p.ws + OFF_RWKVP);
#pragma unroll
    for (int t = 0; t < 16; ++t) {
        const int tok = t0 + t;
        float r[4], k[4], v[4], a[4], y[4];
        zr_shift4(ZR, mu, tok, n4, r); zr_shift4(ZR, mu, tok, 1024 + n4, k); zr_shift4(ZR, mu, tok, 2048 + n4, v);
        unpack4(*(const u32x2*)(Ab + (size_t)tok * 1024 + n4), a);
        unpack4(*(const u32x2*)(YS + (size_t)tok * 1024 + n4), y);
        float cf = 0.f, s1 = 0.f, s2 = 0.f;
#pragma unroll
        for (int e = 0; e < 4; ++e) { const float kn = k[e] * (1.0f + (a[e] - 1.0f) * kav[e]); cf += r[e] * kn * rkv[e]; s1 += y[e]; s2 += y[e] * y[e]; }
        cf = row16_sum(cf); s1 = row16_sum(s1); s2 = row16_sum(s2);
        const float mean = s1 * (1.0f / 64.0f), var = fmaxf(s2 * (1.0f / 64.0f) - mean * mean, 0.f), rstd = rsqrtf(var + 64e-5f);
        float o[4];
#pragma unroll
        for (int e = 0; e < 4; ++e) o[e] = ((y[e] - mean) * rstd * gng[e] + gnb[e] + cf * v[e]) * gacc[t][e];
        *(u32x2*)(out + (size_t)tok * 1024 + n4) = pack4(o[0], o[1], o[2], o[3]);
    }
}

DI void phaseF_tile(const Params& p, int mt, int nt, char* lds) {
    const int tid = threadIdx.x, lane = tid & 63, wid = tid >> 6, wm = wid >> 1, wn = wid & 1, fr = lane & 15, fq = lane >> 4;
    const int m0 = mt * 128 + wm * 64, nb = nt * 128 + wn * 64;
    const bf16_t* ZG = (const bf16_t*)(p.ws + OFF_ZG);
    f32x4 sum[4][4]; zero_acc(sum);
#pragma unroll 1
    for (int br = 0; br < 3; ++br) {
        const size_t xoff = br == 0 ? OFF_ATTP : br == 1 ? OFF_CONVP : OFF_RWKVP;
        const size_t woff = br == 0 ? W_ATTO : br == 1 ? W_CONVO : W_RWKVO;
        f32x4 acc[4][4]; zero_acc(acc);
        gemm_mainloop<false>(acc, (const bf16_t*)(p.ws + xoff) + (size_t)mt * 128 * 1024, 1024, (const bf16_t*)(p.ws + OFF_W + woff) + (size_t)nt * 128 * 1024, 1024, 1024, lds);
#pragma unroll
        for (int ti = 0; ti < 4; ++ti) {
            const int tok = m0 + ti * 16 + fr;
#pragma unroll
            for (int ni = 0; ni < 4; ++ni) {
                float g[4]; unpack4(*(const u32x2*)(ZG + (size_t)tok * ZG_LD + br * 1024 + nb + ni * 16 + fq * 4), g);
#pragma unroll
                for (int r = 0; r < 4; ++r) sum[ti][ni][r] += g[r] * acc[ti][ni][r];
            }
        }
    }
    bf16_t* out = (bf16_t*)(p.ws + OFF_MERGED);
#pragma unroll
    for (int ti = 0; ti < 4; ++ti) {
        const int tok = m0 + ti * 16 + fr;
#pragma unroll
        for (int ni = 0; ni < 4; ++ni)
            *(u32x2*)(out + (size_t)tok * 1024 + nb + ni * 16 + fq * 4) = pack4(sum[ti][ni][0], sum[ti][ni][1], sum[ti][ni][2], sum[ti][ni][3]);
    }
}
DI void phaseG_tile(const Params& p, int l, int mt, int nt, char* lds) {
    const int tid = threadIdx.x, lane = tid & 63, wid = tid >> 6, wm = wid >> 1, wn = wid & 1, fr = lane & 15, fq = lane >> 4;
    const int m0 = mt * 128 + wm * 64, nb = nt * 128 + wn * 64;
    f32x4 acc[4][4]; zero_acc(acc);
    gemm_mainloop<false>(acc, (const bf16_t*)(p.ws + OFF_MERGED) + (size_t)mt * 128 * 1024, 1024, (const bf16_t*)(p.ws + OFF_W + W_OUT) + (size_t)nt * 128 * 1024, 1024, 1024, lds);
    const float* xin = l == 0 ? (const float*)p.in[I_X] : p.out;
    const float* ada = (const float*)(p.ws + OFF_CTRL + CT_ADA) + (size_t)l * 2 * 6144;
#pragma unroll
    for (int ti = 0; ti < 4; ++ti) {
        const int tok = m0 + ti * 16 + fr, b = tok >> 13;
#pragma unroll
        for (int ni = 0; ni < 4; ++ni) {
            const int n = nb + ni * 16 + fq * 4;
            const f32x4 xv = *(const f32x4*)(xin + (size_t)tok * 1024 + n), gt = *(const f32x4*)(ada + b * 6144 + 2 * 1024 + n);
            *(f32x4*)(p.out + (size_t)tok * 1024 + n) = xv + (1.0f + gt) * acc[ti][ni];
        }
    }
}
DI void phaseI_tile(const Params& p, int mt, int nt, char* lds) {
    const int tid = threadIdx.x, lane = tid & 63, wid = tid >> 6, wm = wid >> 1, wn = wid & 1, fr = lane & 15, fq = lane >> 4;
    const int m0 = mt * 128 + wm * 64, nb = nt * 128 + wn * 64;
    f32x4 acc[4][4]; zero_acc(acc);
    gemm_mainloop<false>(acc, (const bf16_t*)(p.ws + OFF_H) + (size_t)mt * 128 * 1024, 1024, (const bf16_t*)(p.ws + OFF_W + W_QP) + (size_t)nt * 128 * 1024, 1024, 1024, lds);
    bf16_t* out = (bf16_t*)(p.ws + OFF_QP);
#pragma unroll
    for (int ti = 0; ti < 4; ++ti) {
        const int tok = m0 + ti * 16 + fr;
#pragma unroll
        for (int ni = 0; ni < 4; ++ni)
            *(u32x2*)(out + (size_t)tok * 2048 + nb + ni * 16 + fq * 4) = pack4(acc[ti][ni][0], acc[ti][ni][1], acc[ti][ni][2], acc[ti][ni][3]);
    }
}
DI void phaseJ_tile(const Params& p, int mt, int g, char* lds) {
    const int tid = threadIdx.x, lane = tid & 63, wid = tid >> 6, wm = wid >> 1, wn = wid & 1, fr = lane & 15, fq = lane >> 4;
    const int m0 = mt * 128 + wm * 64, nb = wn * 64;
    f32x4 acc[4][4]; zero_acc(acc);
    gemm_mainloop<true>(acc, (const bf16_t*)(p.ws + OFF_QP) + (size_t)mt * 128 * 2048 + g * 128, 2048, (const bf16_t*)(p.ws + OFF_W + ((g & 1) ? W_KEY2 : W_KEY1)), 128, 128, lds);
    float* out = (float*)(p.ws + OFF_SCORES);
#pragma unroll
    for (int ni = 0; ni < 4; ++ni) {
        const int n = nb + ni * 16 + fr;
#pragma unroll
        for (int ti = 0; ti < 4; ++ti) *(f32x4*)(out + (size_t)(g * 128 + n) * NT + m0 + ti * 16 + fq * 4) = acc[ti][ni];
    }
}

DI void phaseIJ_tile(const Params& p, int mt, int g, char* lds) {
    const int tid = threadIdx.x, lane = tid & 63, wid = tid >> 6, wm = wid >> 1, wn = wid & 1, fr = lane & 15, fq = lane >> 4;
    f32x4 acc[4][4]; zero_acc(acc);
    gemm_mainloop<false>(acc, (const bf16_t*)(p.ws + OFF_H) + (size_t)mt * 128 * 1024, 1024, (const bf16_t*)(p.ws + OFF_W + W_QP) + (size_t)g * 128 * 1024, 1024, 1024, lds);
    const int swz = (fr >> 1) & 7;
    __syncthreads();
#pragma unroll
    for (int ti = 0; ti < 4; ++ti) {
        const int row = wm * 64 + ti * 16 + fr;
#pragma unroll
        for (int ni = 0; ni < 4; ++ni)
            *(u32x2*)(lds + wn * GEMM_STAGE + row * 128 + (((ni * 2 + (fq >> 1)) ^ swz) << 4) + (fq & 1) * 8) = pack4(acc[ti][ni][0], acc[ti][ni][1], acc[ti][ni][2], acc[ti][ni][3]);
    }
    {
        const bf16_t* gw = (const bf16_t*)(p.ws + OFF_W + ((g & 1) ? W_KEY2 : W_KEY1)) + (size_t)(tid >> 3) * 128 + (((tid & 7) ^ ((tid >> 4) & 7)) * 8);
#pragma unroll
        for (int st = 0; st < 2; ++st)
#pragma unroll
            for (int i = 0; i < 4; ++i)
                __builtin_amdgcn_global_load_lds((const unsigned*)(gw + (size_t)(32 * i) * 128 + st * 64), (LDSP unsigned*)(lds + st * GEMM_STAGE + 16384 + tid * 16 + i * 4096), 16, 0, 0);
    }
    asm volatile("s_waitcnt vmcnt(0) lgkmcnt(0)" ::: "memory");
    __syncthreads();
    f32x4 sc[4][4]; zero_acc(sc);
#pragma unroll
    for (int kt = 0; kt < 2; ++kt) {
        const char* sx = lds + kt * GEMM_STAGE;
        const char* sw = sx + 16384;
#pragma unroll
        for (int ks = 0; ks < 2; ++ks) {
            const int cb = ((ks * 4 + fq) ^ swz) << 4;
            bf16x8 xf[4], wf[4];
#pragma unroll
            for (int i = 0; i < 4; ++i) {
                xf[i] = *(const bf16x8*)(sx + (wm * 64 + i * 16 + fr) * 128 + cb);
                wf[i] = *(const bf16x8*)(sw + (wn * 64 + i * 16 + fr) * 128 + cb);
            }
#pragma unroll
            for (int ti = 0; ti < 4; ++ti)
#pragma unroll
                for (int ni = 0; ni < 4; ++ni) sc[ti][ni] = MFMA16(xf[ti], wf[ni], sc[ti][ni]);
        }
    }
    asm volatile("" ::: "memory");
    __builtin_amdgcn_sched_barrier(0);
    const int m0 = mt * 128 + wm * 64, nb = wn * 64;
    float* out = (float*)(p.ws + OFF_SCORES);
#pragma unroll
    for (int ni = 0; ni < 4; ++ni) {
        const int n = nb + ni * 16 + fr;
#pragma unroll
        for (int ti = 0; ti < 4; ++ti) *(f32x4*)(out + (size_t)(g * 128 + n) * NT + m0 + ti * 16 + fq * 4) = sc[ti][ni];
    }
}

DI void ins16(float (&a)[16], float x) {
#pragma unroll
    for (int i = 0; i < 16; ++i) { const float t = fmaxf(a[i], x); x = fminf(a[i], x); a[i] = t; }
}
DI void topk_thread(const Params& p, int idx) {
    const int hd = idx >> 14, t = idx & (NT - 1);
    const float* s1 = (const float*)(p.ws + OFF_SCORES) + (size_t)(hd * 256) * NT + t;
    const float* s2 = s1 + (size_t)128 * NT;
    float a[16], b[16], c[16];
#pragma unroll
    for (int i = 0; i < 16; ++i) { a[i] = -INFINITY; b[i] = -INFINITY; c[i] = -INFINITY; }
#pragma unroll 8
    for (int n = 0; n < 128; ++n) {
        const float x1 = __uint_as_float((__float_as_uint(s1[(size_t)n * NT]) & 0xFFFFFF80u) | (unsigned)(127 - n));
        const float x2 = __uint_as_float((__float_as_uint(s2[(size_t)n * NT]) & 0xFFFFFF80u) | (unsigned)(127 - n));
        ins16(a, x1); ins16(b, x2);
    }
    float v1[16], v2[16]; int i1[16], i2[16];
#pragma unroll
    for (int i = 0; i < 16; ++i) {
        const unsigned ua = __float_as_uint(a[i]), ub = __float_as_uint(b[i]);
        v1[i] = __uint_as_float(ua & 0xFFFFFF80u); i1[i] = 127 - (int)(ua & 127u);
        v2[i] = __uint_as_float(ub & 0xFFFFFF80u); i2[i] = 127 - (int)(ub & 127u);
    }
#pragma unroll
    for (int i = 0; i < 16; ++i)
#pragma unroll
        for (int j = 0; j < 16; ++j)
            if ((i + 1) * (j + 1) <= 16) ins16(c, __uint_as_float((__float_as_uint(v1[i] + v2[j]) & 0xFFFFFF00u) | (unsigned)(255 - (i * 16 + j))));
    float tv[16]; int eid[16];
#pragma unroll
    for (int r = 0; r < 16; ++r) {
        const unsigned u = __float_as_uint(c[r]);
        tv[r] = __uint_as_float(u & 0xFFFFFF00u);
        const int flat = 255 - (int)(u & 255u), ii = flat >> 4, jj = flat & 15;
        int e1 = 0, e2 = 0;
#pragma unroll
        for (int i = 0; i < 16; ++i) { e1 = (ii == i) ? i1[i] : e1; e2 = (jj == i) ? i2[i] : e2; }
        eid[r] = e1 * 128 + e2;
    }
    float sm = 0.f;
    const float mx = tv[0];
#pragma unroll
    for (int r = 0; r < 16; ++r) { tv[r] = __expf(tv[r] - mx); sm += tv[r]; }
    const float inv = 1.0f / sm;
    int* ep = (int*)(p.ws + OFF_EID) + (size_t)t * 128 + hd * 16;
    float* gp = (float*)(p.ws + OFF_GATE) + (size_t)t * 128 + hd * 16;
#pragma unroll
    for (int q = 0; q < 4; ++q) {
        *(u32x4*)(ep + q * 4) = (u32x4){(unsigned)eid[q * 4], (unsigned)eid[q * 4 + 1], (unsigned)eid[q * 4 + 2], (unsigned)eid[q * 4 + 3]};
        *(f32x4*)(gp + q * 4) = (f32x4){tv[q * 4] * inv, tv[q * 4 + 1] * inv, tv[q * 4 + 2] * inv, tv[q * 4 + 3] * inv};
    }
}

DI void cvt_u8x4(unsigned w, float (&f)[4]) { f[0] = (float)(w & 255u); f[1] = (float)((w >> 8) & 255u); f[2] = (float)((w >> 16) & 255u); f[3] = (float)(w >> 24); }
DI float gelu_zs(float v) {
    const float av = fabsf(v), t = __builtin_amdgcn_rcpf(av * 0.2316418882f + 1.0f);
    float q = t * 0.5307027145f + (-0.7265760135f); q = q * t + 0.7107068705f; q = q * t + (-0.142248368f); q = q * t + 0.127414796f; q = q * t;
    const float e = __builtin_amdgcn_exp2f(v * v * (-0.72134752044f));
    const float m = v * (q * e);
    return v < 0.f ? m : v - m;
}
DI void peer_token(const Params& p, int l, int t) {
    const int lane = threadIdx.x & 63, b = t >> 13;
    const unsigned char* U = (const unsigned char*)(p.ws + OFF_PU8);
    const unsigned char* V = (const unsigned char*)(p.ws + OFF_PV8);
    const float* SU = (const float*)(p.ws + OFF_PSU);
    const float* SV = (const float*)(p.ws + OFF_PSV);
    bf16_t* H = (bf16_t*)(p.ws + OFF_H);
    int hq[4]; float sh;
    {
        float hv[16]; float f[8];
        unpack8(*(const u32x4*)(H + (size_t)t * 1024 + lane * 16), f); for (int e = 0; e < 8; ++e) hv[e] = f[e];
        unpack8(*(const u32x4*)(H + (size_t)t * 1024 + lane * 16 + 8), f); for (int e = 0; e < 8; ++e) hv[8 + e] = f[e];
        float am = 0.f;
#pragma unroll
        for (int e = 0; e < 16; ++e) am = fmaxf(am, fabsf(hv[e]));
        am = wave_max(am);
        sh = am > 0.f ? am * (1.0f / 127.0f) : 1.0f;
        const float ish = am > 0.f ? 127.0f / am : 0.f;
#pragma unroll
        for (int q = 0; q < 4; ++q) {
            unsigned w = 0;
#pragma unroll
            for (int e = 0; e < 4; ++e) w |= ((unsigned)(int)rintf(hv[q * 4 + e] * ish) & 255u) << (8 * e);
            hq[q] = (int)w;
        }
    }
    const int* eidp = (const int*)(p.ws + OFF_EID) + (size_t)t * 128;
    const float* gatep = (const float*)(p.ws + OFF_GATE) + (size_t)t * 128;
    const int id0 = eidp[lane], id1 = eidp[64 + lane];
    const float g0 = gatep[lane], g1 = gatep[64 + lane];
    const float su0 = SU[id0] * sh, su1 = SU[id1] * sh, gs0 = g0 * SV[id0], gs1 = g1 * SV[id1];
    float acc[16], csum = 0.f;
#pragma unroll
    for (int e = 0; e < 16; ++e) acc[e] = 0.f;
    const int eidx = lane >> 3;
    const bool hi32 = (lane & 32) != 0, hi16 = (lane & 16) != 0, hi8 = (lane & 8) != 0;
#pragma unroll 1
    for (int g = 0; g < 16; ++g) {
        const int jbase = (g & 7) * 8;
        const int idr = (g & 8) ? id1 : id0; const float sur = (g & 8) ? su1 : su0, gsr = (g & 8) ? gs1 : gs0;
        u32x4 uq[8], vq[8];
#pragma unroll
        for (int e = 0; e < 8; ++e) {
            const int id = __builtin_amdgcn_readlane(idr, jbase + e);
            uq[e] = *(const u32x4*)(U + (size_t)id * 1024 + lane * 16);
            vq[e] = *(const u32x4*)(V + (size_t)id * 1024 + lane * 16);
        }
        float d[8];
#pragma unroll
        for (int e = 0; e < 8; ++e) {
            int sdot = __builtin_amdgcn_sdot4((int)uq[e].x, hq[0], 0, false);
            sdot = __builtin_amdgcn_sdot4((int)uq[e].y, hq[1], sdot, false);
            sdot = __builtin_amdgcn_sdot4((int)uq[e].z, hq[2], sdot, false);
            sdot = __builtin_amdgcn_sdot4((int)uq[e].w, hq[3], sdot, false);
            d[e] = (float)sdot;
        }
        float r4[4], r2[2];
#pragma unroll
        for (int i = 0; i < 4; ++i) { const float keep = hi32 ? d[4 + i] : d[i], send = hi32 ? d[i] : d[4 + i]; r4[i] = keep + __shfl_xor(send, 32); }
#pragma unroll
        for (int i = 0; i < 2; ++i) { const float keep = hi16 ? r4[2 + i] : r4[i], send = hi16 ? r4[i] : r4[2 + i]; r2[i] = keep + __shfl_xor(send, 16); }
        float r1;
        { const float keep = hi8 ? r2[1] : r2[0], send = hi8 ? r2[0] : r2[1]; r1 = keep + __shfl_xor(send, 8); }
        r1 = row8_sum(r1);
        const float dotv = r1 * __shfl(sur, jbase + eidx);
        const float ccl = gelu_zs(dotv) * __shfl(gsr, jbase + eidx);
#pragma unroll
        for (int e = 0; e < 8; ++e) {
            const float cc = __int_as_float(__builtin_amdgcn_readlane(__float_as_int(ccl), e * 8));
            csum += cc;
            float f[4];
            cvt_u8x4(vq[e].x, f); acc[0] += cc * f[0]; acc[1] += cc * f[1]; acc[2] += cc * f[2]; acc[3] += cc * f[3];
            cvt_u8x4(vq[e].y, f); acc[4] += cc * f[0]; acc[5] += cc * f[1]; acc[6] += cc * f[2]; acc[7] += cc * f[3];
            cvt_u8x4(vq[e].z, f); acc[8] += cc * f[0]; acc[9] += cc * f[1]; acc[10] += cc * f[2]; acc[11] += cc * f[3];
            cvt_u8x4(vq[e].w, f); acc[12] += cc * f[0]; acc[13] += cc * f[1]; acc[14] += cc * f[2]; acc[15] += cc * f[3];
        }
    }
#pragma unroll
    for (int e = 0; e < 16; ++e) acc[e] -= 128.0f * csum;
    const float* ada = (const float*)(p.ws + OFF_CTRL + CT_ADA) + (size_t)(l * 2 + b) * 6144;
    float xv[16], ss = 0.f;
#pragma unroll
    for (int q = 0; q < 4; ++q) {
        const int n = lane * 16 + q * 4;
        const f32x4 x1 = *(const f32x4*)(p.out + (size_t)t * 1024 + n), gt = *(const f32x4*)(ada + 5 * 1024 + n);
#pragma unroll
        for (int e = 0; e < 4; ++e) { const float x2 = x1[e] + (1.0f + gt[e]) * acc[q * 4 + e]; xv[q * 4 + e] = x2; ss += x2 * x2; }
    }
    ss = wave_sum(ss);
    const float rstd = rsqrtf(ss * (1.0f / 1024.0f) + 1e-6f);
    if (l + 1 < DEPTH) {
        const float* ada2 = (const float*)(p.ws + OFF_CTRL + CT_ADA) + (size_t)((l + 1) * 2 + b) * 6144;
        const float* g1n = (const float*)p.in[I_N1G] + (size_t)(l + 1) * 1024;
        float o[16];
#pragma unroll
        for (int q = 0; q < 4; ++q) {
            const int n = lane * 16 + q * 4;
            const f32x4 g = *(const f32x4*)(g1n + n), sh = *(const f32x4*)(ada2 + n), sc = *(const f32x4*)(ada2 + 1024 + n);
            *(f32x4*)(p.out + (size_t)t * 1024 + n) = (f32x4){xv[q * 4], xv[q * 4 + 1], xv[q * 4 + 2], xv[q * 4 + 3]};
#pragma unroll
            for (int e = 0; e < 4; ++e) o[q * 4 + e] = xv[q * 4 + e] * rstd * g[e] * (1.0f + sc[e]) + sh[e];
        }
        u32x4 w0, w1;
        w0.x = pk2(o[0], o[1]); w0.y = pk2(o[2], o[3]); w0.z = pk2(o[4], o[5]); w0.w = pk2(o[6], o[7]);
        w1.x = pk2(o[8], o[9]); w1.y = pk2(o[10], o[11]); w1.z = pk2(o[12], o[13]); w1.w = pk2(o[14], o[15]);
        *(u32x4*)(H + (size_t)t * 1024 + lane * 16) = w0; *(u32x4*)(H + (size_t)t * 1024 + lane * 16 + 8) = w1;
    } else {
        const float* fg = (const float*)p.in[I_FG];
#pragma unroll
        for (int q = 0; q < 4; ++q) {
            const int n = lane * 16 + q * 4;
            const f32x4 g = *(const f32x4*)(fg + n);
            f32x4 o;
#pragma unroll
            for (int e = 0; e < 4; ++e) o[e] = xv[q * 4 + e] * rstd * g[e];
            *(f32x4*)(p.out + (size_t)t * 1024 + n) = o;
        }
    }
}

#define XB_TMO      128
#define XB_XCNT(j)  (256  + 64 * (j))
#define XB_XSUB(j)  (1280 + 64 * (j))
#define XB_XGEN(j)  (2304 + 64 * (j))
#define XB_TOP      3328
#define XB_TOPGEN   3392
#define XCD_BAR_WORDS 3456
#define XB_SPIN_CAP (1u << 18)
#define LAS __attribute__((address_space(3)))
DI unsigned xb_ld(unsigned* q)              { return __hip_atomic_load(q, __ATOMIC_RELAXED, __HIP_MEMORY_SCOPE_AGENT); }
DI unsigned xb_add(unsigned* q, unsigned v) { return __hip_atomic_fetch_add(q, v, __ATOMIC_RELAXED, __HIP_MEMORY_SCOPE_AGENT); }
DI unsigned xb_xcc_id() { return (unsigned)__builtin_amdgcn_s_getreg((3 << 11) | 20) & 0xFu; }
#define XB_SPIN(cond, bar) do { unsigned _sp = 0; while (cond) { __builtin_amdgcn_s_sleep(1); \
    if ((++_sp & 255u) == 0u) { if (xb_ld(&(bar)[XB_TMO])) break; if (_sp > XB_SPIN_CAP) { atomicAdd(&(bar)[XB_TMO], 1u); break; } } } } while (0)
struct XcdBarrier { unsigned* bar; unsigned x; volatile LAS unsigned* st; };
DI XcdBarrier xcd_barrier_post(unsigned* bar, volatile LAS unsigned* st) {
    XcdBarrier b; b.bar = bar; b.x = xb_xcc_id(); b.st = st;
    if (threadIdx.x == 0) (void)xb_add(&bar[XB_XCNT(b.x)], 1u);
    return b;
}
DI void xcd_barrier_complete(unsigned* bar, unsigned x, unsigned& nloc, unsigned& nx) {
    const unsigned G = gridDim.x * gridDim.y * gridDim.z;
    unsigned sum, cnt, mine, sp = 0u;
    for (;;) {
        sum = 0u; cnt = 0u; mine = 0u;
#pragma unroll
        for (unsigned j = 0; j < 16; ++j) { const unsigned c = xb_ld(&bar[XB_XCNT(j)]); sum += c; cnt += (c > 0u) ? 1u : 0u; mine = (j == x) ? c : mine; }
        if (sum == G) break;
        __builtin_amdgcn_s_sleep(1);
        if ((++sp & 255u) == 0u) { if (xb_ld(&bar[XB_TMO])) break; if (sp > XB_SPIN_CAP) { atomicAdd(&bar[XB_TMO], 1u); break; } }
    }
    nloc = mine > 0u ? mine : 1u; nx = cnt > 0u ? cnt : 1u;
}
DI void xcd_barrier(const XcdBarrier& b) {
    asm volatile("s_waitcnt vmcnt(0)" ::: "memory");
    __syncthreads();
    if (threadIdx.x == 0) {
        unsigned* bar = b.bar;
        __builtin_amdgcn_s_waitcnt(0);
        unsigned nloc = b.st[0], nx = b.st[1];
        if (nloc == 0u) { xcd_barrier_complete(bar, b.x, nloc, nx); b.st[0] = nloc; b.st[1] = nx; }
        const unsigned old = xb_add(&bar[XB_XSUB(b.x)], 1u);
        const unsigned gen = old / nloc;
        if (old + 1u == (gen + 1u) * nloc) {
            __builtin_amdgcn_fence(__ATOMIC_RELEASE, "agent");
            asm volatile("s_waitcnt vmcnt(0)" ::: "memory");
            const unsigned og = xb_add(&bar[XB_TOP], 1u);
            const unsigned tg = og / nx;
            if (og + 1u == (tg + 1u) * nx) xb_add(&bar[XB_TOPGEN], 1u);
            else XB_SPIN(xb_ld(&bar[XB_TOPGEN]) == tg, bar);
            __builtin_amdgcn_fence(__ATOMIC_ACQUIRE, "agent");
            xb_add(&bar[XB_XGEN(b.x)], 1u);
            asm volatile("s_waitcnt vmcnt(0)" ::: "memory");
        } else {
            XB_SPIN(xb_ld(&bar[XB_XGEN(b.x)]) == gen, bar);
            __builtin_amdgcn_fence(__ATOMIC_ACQUIRE, "agent");
            asm volatile("s_waitcnt vmcnt(0)" ::: "memory");
        }
    }
    __syncthreads();
}
constexpr size_t CT_BAR = 16384;

constexpr int LDS_BYTES = 2 * GEMM_STAGE + 64;
constexpr int N_PHASES = 2 + 13 * DEPTH;
constexpr int ATT_U1 = 624;
constexpr int ATT_U0 = 256;
DI void attn_queue(const Params& p, int l, char* lds, int part, int jbase, int jlim) {
    const int tid = threadIdx.x;
    unsigned* cnt = (unsigned*)(p.ws + OFF_CTRL + CT_CNT) + 64 * (l * 3 + part);
    int* s_unit = (int*)(lds + LDS_BYTES - 16);
    if (tid == 0) s_unit[1] = 0;
    for (;;) {
        __syncthreads();
        if (tid == 0) {
            const int myx = (int)(xb_xcc_id() & 7u);
            int unit = -1, qi = s_unit[1];
            while (qi < 8) {
                const int x = (myx + qi) & 7;
                const int j = jbase + (int)atomicAdd(cnt + x * 8, 1u);
                if (j < jlim) { unit = ((j >> 1) << 4) | (x * 2 + (j & 1)); break; }
                ++qi;
            }
            s_unit[0] = unit; s_unit[1] = qi;
        }
        __syncthreads();
        const int unit = s_unit[0];
        if (unit < 0) break;
        attn_unit(p, l, unit, lds);
    }
}

#ifndef MULTI_LAUNCH
#define MULTI_LAUNCH 0
#endif

template <int ph> DI void run_phase(const Params& p, char* lds) {
    const int bid = blockIdx.x, nblk = gridDim.x, tid = threadIdx.x;
    const int gw = bid * 4 + (tid >> 6), nw = nblk * 4;
    const int vb = (nblk == 512) ? (bid % 8) * 64 + ((bid / 8) % 32) * 2 + (bid / 256) : (nblk % 8 == 0) ? (bid % 8) * (nblk / 8) + bid / 8 : bid;
    float* ada = (float*)(p.ws + OFF_CTRL + CT_ADA);
    if (ph == 0) {
        const int total = 192 + 1 + 256 + NCONV_ITEMS / 2;
        for (int it = bid; it < total; it += nblk) {
            if (it < 192) ada_item(p, it, lds);
            else if (it == 192) lam_item(p);
            else if (it < 449) rope_item(p, it - 193);
            else convert_item(p, 0, it - 449, lds);
        }
        return;
    }
    if (ph == 1) {
        norm_rows(p, (const float*)p.in[I_X], (const float*)p.in[I_N1G], ada, ada + 1024, (bf16_t*)(p.ws + OFF_H));
        for (int it = NCONV_ITEMS / 2 + bid; it < NCONV_ITEMS; it += nblk) convert_item(p, 0, it, lds);
        return;
    }
    constexpr int l = (ph - 2) / 13, sub0 = (ph - 2) % 13, sub = sub0 <= 1 ? sub0 : sub0 == 2 ? 100 : sub0 == 3 ? 101 : sub0 <= 5 ? 2 : sub0 <= 10 ? sub0 - 3 : sub0 - 2;
    switch (sub) {
    case 0:
        for (int tile = vb; tile < 128 * 90; tile += nblk) { int mt, nt; tile_coords(tile, 90, mt, nt); phaseB_tile(p, mt, nt, lds); }
        break;
    case 1:
        for (int it = bid; it < 2048; it += nblk) { if (it < 1024) conv_tile(p, l, it, lds); else lora_in_tile(p, l, it - 1024); }
        break;
    case 101:
        for (int it = bid; it < 4096; it += nblk) scan_T_item(p, l, it, lds);
        attn_queue(p, l, lds, 2, 256 - ATT_U0 / 8, 256);
        break;
    case 100:
        for (int tile = vb; tile < 2048; tile += nblk) { int mt, nt; tile_coords(tile & 1023, 8, mt, nt); lora_wa_tile(p, l, tile >> 10, mt, nt, lds); }
        break;
    case 2: {
        const bool second = sub0 == 5;
#if SCAN_MFMA
        if (!second) { for (int it = bid; it < N_MS1; it += nblk) ms_item_pass1(p, l, it, lds); }
        else { for (int it = bid; it < N_MS2; it += nblk) ms_item_pass2(p, l, it, lds); }
#else
        if (!second) { for (int it = bid; it < N_SCAN1; it += nblk) scan_item_pass1(p, l, it, lds); }
        else { for (int it = bid; it < N_SCAN2; it += nblk) scan_item_pass2(p, l, it, lds); }
#endif
        attn_queue(p, l, lds, second ? 1 : 0, second ? ATT_U1 / 8 : 0, second ? 256 - ATT_U0 / 8 : ATT_U1 / 8);
        break; }
    case 3:
        for (int it = bid; it < 1024; it += nblk) rwkv_post_tile(p, l, it, lds);
        break;
    case 4:
        for (int tile = vb; tile < 128 * 8; tile += nblk) { int mt, nt; tile_coords(tile, 8, mt, nt); phaseF_tile(p, mt, nt, lds); }
        break;
    case 5:
        for (int it = vb; it < 1024 + 8192; it += nblk) {
            if (it < 1024) { int mt, nt; tile_coords(it, 8, mt, nt); phaseG_tile(p, l, mt, nt, lds); }
            else convert_uv_item(p, l, it - 1024);
        }
        break;
    case 6:
        norm_rows(p, p.out, (const float*)p.in[I_N2G] + (size_t)l * 1024, ada + (size_t)l * 2 * 6144 + 3 * 1024, ada + (size_t)l * 2 * 6144 + 4 * 1024, (bf16_t*)(p.ws + OFF_H));
        break;
    case 7:
        for (int tile = vb; tile < 128 * 16; tile += nblk) { int mt, nt; tile_coords(tile, 16, mt, nt); phaseIJ_tile(p, mt, nt, lds); }
        break;
    case 8:
        break;
    case 9:
        for (int idx = bid * NTHREADS + tid; idx < NT * 8; idx += nblk * NTHREADS) topk_thread(p, idx);
        if (l + 1 < DEPTH) for (int it = bid; it < NCONV_ITEMS; it += nblk) convert_item(p, l + 1, it, lds);
        break;
    case 10:
        for (int t = gw; t < NT; t += nw) peer_token(p, l, t);
        break;
    }
}

#ifndef PROBE_PH
#define PROBE_PH -1
#endif
#ifndef PROBE_MULT
#define PROBE_MULT 3
#endif
#define PHASE(N) if (p.ph_begin <= N && N < p.ph_end) { unsigned long long pt0 = 0; if (N == PROBE_PH) pt0 = __builtin_amdgcn_s_memrealtime(); run_phase<N>(p, lds); \
    if (N + 1 < p.ph_end) xcd_barrier(xb); \
    if (N == PROBE_PH) { const unsigned long long pt1 = __builtin_amdgcn_s_memrealtime(); while (__builtin_amdgcn_s_memrealtime() - pt1 < PROBE_MULT * (pt1 - pt0)) __builtin_amdgcn_s_sleep(8); __syncthreads(); } }
extern __shared__ __attribute__((aligned(16))) char dyn_lds[];
__global__ void __launch_bounds__(NTHREADS, 2) mega_kernel(Params p) {
    char* lds = dyn_lds;
    volatile LAS unsigned* xst = (volatile LAS unsigned*)(lds + LDS_BYTES - 32);
    if (threadIdx.x == 0) { xst[0] = 0u; xst[1] = 0u; }
    __syncthreads();
    const XcdBarrier xb = xcd_barrier_post((unsigned*)(p.ws + OFF_CTRL + CT_BAR), xst);
    if (p.ph_begin < 0) cg::this_grid().sync();
    PHASE(0) PHASE(1) PHASE(2) PHASE(3) PHASE(4) PHASE(5) PHASE(6) PHASE(7) PHASE(8) PHASE(9) PHASE(10) PHASE(11) PHASE(12) PHASE(13)
    PHASE(14) PHASE(15) PHASE(16) PHASE(17) PHASE(18) PHASE(19) PHASE(20) PHASE(21) PHASE(22) PHASE(23) PHASE(24) PHASE(25) PHASE(26) PHASE(27)
    static_assert(N_PHASES == 28, "phase list");
}

extern "C" void kernel_launch(void* const* d_in, const int* in_sizes, int n_in, void* d_out, int out_size, void* d_ws, size_t ws_size, hipStream_t stream) {
    static int grid_blocks = 0;
    if (!grid_blocks) {
        int dev = 0, cus = 0, per_cu = 0;
        hipGetDevice(&dev);
        hipDeviceGetAttribute(&cus, hipDeviceAttributeMultiprocessorCount, dev);
        hipFuncSetAttribute((const void*)mega_kernel, hipFuncAttributeMaxDynamicSharedMemorySize, LDS_BYTES);
        hipOccupancyMaxActiveBlocksPerMultiprocessor(&per_cu, mega_kernel, NTHREADS, LDS_BYTES);
        if (per_cu > 2) per_cu = 2;
        if (per_cu < 1) per_cu = 1;
        grid_blocks = cus * per_cu;
        if (ws_size < WS_END) fprintf(stderr, "workspace too small: %zu < %zu\n", ws_size, (size_t)WS_END);
    }
    Params p{};
    for (int i = 0; i < N_IN; ++i) p.in[i] = d_in[i];
    p.out = (float*)d_out; p.ws = (char*)d_ws;
    hipMemsetAsync(d_ws, 0, 32768, stream);
#if MULTI_LAUNCH
    for (int ph = 0; ph < N_PHASES; ++ph) {
        p.ph_begin = ph; p.ph_end = ph + 1;
        hipLaunchKernelGGL(mega_kernel, dim3(grid_blocks), dim3(NTHREADS), LDS_BYTES, stream, p);
    }
#else
    p.ph_begin = 0; p.ph_end = N_PHASES;
    void* args[] = {&p};
    hipError_t e = hipLaunchCooperativeKernel((void*)mega_kernel, dim3(grid_blocks), dim3(NTHREADS), args, LDS_BYTES, stream);
    if (e != hipSuccess) fprintf(stderr, "cooperative launch failed: %s (grid %d)\n", hipGetErrorString(e), grid_blocks);
#endif
}
```

```cpp
#include <hip/hip_runtime.h>
#include <hip/hip_cooperative_groups.h>
#include <cstdio>
#include <cstdint>
namespace cg = cooperative_groups;
#ifndef SCAN_MFMA
#define SCAN_MFMA 1
#endif
#ifndef SCAN_TEST
#define SCAN_TEST 0
#endif

#define DI __device__ __forceinline__
typedef unsigned short bf16_t;
typedef short bf16x8 __attribute__((ext_vector_type(8)));
typedef float f32x2 __attribute__((ext_vector_type(2)));
typedef float f32x4 __attribute__((ext_vector_type(4)));
typedef float f32x16 __attribute__((ext_vector_type(16)));
typedef unsigned u32x2 __attribute__((ext_vector_type(2)));
typedef unsigned u32x4 __attribute__((ext_vector_type(4)));
typedef __bf16 nbf16x2 __attribute__((ext_vector_type(2)));

constexpr int NB = 2, SEQ = 8192, NT = NB * SEQ, DM = 1024, CIN = 11520, DEPTH = 2;
constexpr int NTHREADS = 256;
constexpr size_t MiB = (size_t)1 << 20;
constexpr size_t OFF_CTRL = 0, OFF_ROPE = 1 * MiB, OFF_W = 5 * MiB, OFF_H = 41 * MiB, OFF_Q = 73 * MiB, OFF_K = 105 * MiB,
                 OFF_VT = 137 * MiB, OFF_UC = 169 * MiB, OFF_ZR = 201 * MiB, OFF_ZG = 305 * MiB, OFF_A = 401 * MiB,
                 OFF_LW = 433 * MiB, OFF_YS = 465 * MiB, WS_END = 497 * MiB;
constexpr size_t OFF_CONVP = OFF_H, OFF_ATTP = OFF_UC, OFF_RWKVP = OFF_Q, OFF_MERGED = OFF_K, OFF_PU = OFF_ZR,
                 OFF_PV = OFF_ZR + 32 * MiB, OFF_QP = OFF_ZG, OFF_SCORES = OFF_Q, OFF_EID = OFF_A, OFF_GATE = OFF_A + 8 * MiB;
constexpr size_t W_IN = 0, W_ATTO = (size_t)CIN * 1024 * 2, W_CONVO = W_ATTO + 2 * MiB, W_RWKVO = W_CONVO + 2 * MiB,
                 W_OUT = W_RWKVO + 2 * MiB, W_QP = W_OUT + 2 * MiB, W_KEY1 = W_QP + 4 * MiB, W_KEY2 = W_KEY1 + 32768,
                 W_W2T = W_KEY2 + 32768, W_A2T = W_W2T + 131072, W_G2T = W_A2T + 131072;
static_assert(W_G2T + 262144 <= 36 * MiB, "W region overflow");
constexpr size_t CT_CNT = 0, CT_LAM = 3072, CT_ADA = 65536;
constexpr int RWKV_LD = 3328, ZG_LD = 3072;

enum { I_X = 0, I_C, I_POS, I_WADA, I_BADA, I_N1G, I_WIN, I_LQ1, I_LK1, I_LQ2, I_LK2, I_AHG, I_WATTO, I_CONVW, I_CONVB, I_CLNG, I_CLNB,
       I_WCONVO, I_MU, I_W0, I_W2, I_A0, I_A2, I_G2, I_KK, I_KA, I_RK, I_GNG, I_GNB, I_WRWKVO, I_WOUT, I_N2G, I_WQ, I_KEY1, I_KEY2,
       I_PU, I_PV, I_FG, N_IN };

struct Params {
    const void* in[N_IN];
    float* out;
    char* ws;
    int ph_begin, ph_end;
};

DI unsigned pk2(float lo, float hi) { f32x2 v = {lo, hi}; nbf16x2 b = __builtin_convertvector(v, nbf16x2); return __builtin_bit_cast(unsigned, b); }
DI float bflo(unsigned u) { return __uint_as_float(u << 16); }
DI float bfhi(unsigned u) { return __uint_as_float(u & 0xffff0000u); }
DI float bf2f(bf16_t h) { return __uint_as_float(((unsigned)h) << 16); }
DI bf16_t f2bf(float x) { return (bf16_t)(pk2(x, x) & 0xffffu); }
DI float sigmoidf_(float x) { return 1.0f / (1.0f + __expf(-x)); }
DI float siluf_(float x) { return x / (1.0f + __expf(-x)); }
template <int CTRL> DI float dpp_f(float x) { return __int_as_float(__builtin_amdgcn_update_dpp(0, __float_as_int(x), CTRL, 0xF, 0xF, true)); }
DI float row16_sum(float x) { x += dpp_f<0xB1>(x); x += dpp_f<0x4E>(x); x += dpp_f<0x141>(x); x += dpp_f<0x140>(x); return x; }
DI float row16_max(float x) { x = fmaxf(x, dpp_f<0xB1>(x)); x = fmaxf(x, dpp_f<0x4E>(x)); x = fmaxf(x, dpp_f<0x141>(x)); x = fmaxf(x, dpp_f<0x140>(x)); return x; }
DI float wave_sum(float x) { x = row16_sum(x); x += __shfl_xor(x, 16); x += __shfl_xor(x, 32); return x; }
DI float wave_max(float x) { x = row16_max(x); x = fmaxf(x, __shfl_xor(x, 16)); x = fmaxf(x, __shfl_xor(x, 32)); return x; }
DI void unpack8(u32x4 v, float (&f)[8]) { f[0] = bflo(v.x); f[1] = bfhi(v.x); f[2] = bflo(v.y); f[3] = bfhi(v.y); f[4] = bflo(v.z); f[5] = bfhi(v.z); f[6] = bflo(v.w); f[7] = bfhi(v.w); }
DI void unpack4(u32x2 v, float (&f)[4]) { f[0] = bflo(v.x); f[1] = bfhi(v.x); f[2] = bflo(v.y); f[3] = bfhi(v.y); }
DI u32x2 pack4(float a, float b, float c, float d) { u32x2 r; r.x = pk2(a, b); r.y = pk2(c, d); return r; }

#define MFMA16(a, b, c) __builtin_amdgcn_mfma_f32_16x16x32_bf16((a), (b), (c), 0, 0, 0)
#define MFMA32(a, b, c) __builtin_amdgcn_mfma_f32_32x32x16_bf16((a), (b), (c), 0, 0, 0)

constexpr int GEMM_STAGE = 32768;
#define LDSP __attribute__((address_space(3)))
template <bool NMODE>
DI void gemm_mainloop(f32x4 (&acc)[4][4], const bf16_t* X, size_t ldx, const bf16_t* W, size_t ldw, int K, char* lds) {
    const int tid = threadIdx.x, lane = tid & 63, wid = tid >> 6, wm = wid >> 1, wn = wid & 1;
    const int fr = lane & 15, fq = lane >> 4;
    const int srow = tid >> 3, skc = (tid & 7) ^ ((tid >> 4) & 7);
    const bf16_t* gx = X + (size_t)srow * ldx + skc * 8;
    const bf16_t* gw = W + (size_t)srow * ldw + skc * 8;
    const int nk = K >> 6;
    auto issue = [&](int kt) {
        char* st = lds + (kt & 1) * GEMM_STAGE + tid * 16;
        const int ko = kt * 64;
#pragma unroll
        for (int i = 0; i < 4; ++i) {
            __builtin_amdgcn_global_load_lds((const unsigned*)(gx + (size_t)(32 * i) * ldx + ko), (LDSP unsigned*)(st + i * 4096), 16, 0, 0);
            __builtin_amdgcn_global_load_lds((const unsigned*)(gw + (size_t)(32 * i) * ldw + ko), (LDSP unsigned*)(st + 16384 + i * 4096), 16, 0, 0);
        }
    };
    const int swz = (fr >> 1) & 7;
    asm volatile("s_waitcnt vmcnt(0) lgkmcnt(0)" ::: "memory");
    __syncthreads();
    issue(0);
    for (int kt = 0; kt < nk; ++kt) {
        asm volatile("s_waitcnt vmcnt(0)" ::: "memory");
        __syncthreads();
        if (kt + 1 < nk) issue(kt + 1);
        const char* sx = lds + (kt & 1) * GEMM_STAGE;
        const char* sw = sx + 16384;
#pragma unroll
        for (int ks = 0; ks < 2; ++ks) {
            const int cb = ((ks * 4 + fq) ^ swz) << 4;
            bf16x8 xf[4], wf[4];
#pragma unroll
            for (int i = 0; i < 4; ++i) {
                xf[i] = *(const bf16x8*)(sx + (wm * 64 + i * 16 + fr) * 128 + cb);
                wf[i] = *(const bf16x8*)(sw + (wn * 64 + i * 16 + fr) * 128 + cb);
            }
#pragma unroll
            for (int ti = 0; ti < 4; ++ti)
#pragma unroll
                for (int ni = 0; ni < 4; ++ni)
                    acc[ti][ni] = NMODE ? MFMA16(xf[ti], wf[ni], acc[ti][ni]) : MFMA16(wf[ni], xf[ti], acc[ti][ni]);
        }
    }
    asm volatile("" ::: "memory");
    __builtin_amdgcn_sched_barrier(0);
}
DI void zero_acc(f32x4 (&acc)[4][4]) {
#pragma unroll
    for (int i = 0; i < 4; ++i)
#pragma unroll
        for (int j = 0; j < 4; ++j) acc[i][j] = (f32x4){0.f, 0.f, 0.f, 0.f};
}
DI void tile_coords(int tile, int nN, int& mt, int& nt) { const int per = 16 * nN; const int g = tile / per, r = tile % per; nt = r >> 4; mt = g * 16 + (r & 15); }

DI void ada_item(const Params& p, int item, char* lds) {
    const int l = item / 96, cgp = item % 96, tid = threadIdx.x, lane = tid & 63, wid = tid >> 6;
    const float* c = (const float*)p.in[I_C];
    const float* w = (const float*)p.in[I_WADA] + (size_t)l * 1024 * 6144 + cgp * 64 + lane;
    float a0 = 0.f, a1 = 0.f;
    const int k0 = wid * 256;
#pragma unroll 8
    for (int k = k0; k < k0 + 256; ++k) {
        const float wv = w[(size_t)k * 6144];
        a0 += siluf_(c[k]) * wv; a1 += siluf_(c[1024 + k]) * wv;
    }
    float* red = (float*)lds;
    __syncthreads();
    red[(wid * 2 + 0) * 64 + lane] = a0; red[(wid * 2 + 1) * 64 + lane] = a1;
    __syncthreads();
    if (tid < 128) {
        const int b = tid >> 6, n = cgp * 64 + (tid & 63);
        float s = ((const float*)p.in[I_BADA])[l * 6144 + n];
        for (int w4 = 0; w4 < 4; ++w4) s += red[(w4 * 2 + b) * 64 + (tid & 63)];
        ((float*)(p.ws + OFF_CTRL + CT_ADA))[(l * 2 + b) * 6144 + n] = s;
    }
}
DI void lam_item(const Params& p) {
    if (threadIdx.x < 64) {
        const int lane = threadIdx.x;
        for (int l = 0; l < DEPTH; ++l) {
            float s1 = ((const float*)p.in[I_LQ1])[l * 64 + lane] * ((const float*)p.in[I_LK1])[l * 64 + lane];
            float s2 = ((const float*)p.in[I_LQ2])[l * 64 + lane] * ((const float*)p.in[I_LK2])[l * 64 + lane];
            s1 = wave_sum(s1); s2 = wave_sum(s2);
            const float lam_init = 0.8f - 0.6f * expf(-0.3f * (float)l);
            if (lane == 0) ((float*)(p.ws + OFF_CTRL + CT_LAM))[l] = expf(s1) - expf(s2) + lam_init;
        }
    }
}
DI void rope_item(const Params& p, int item) {
    const int* pos = (const int*)p.in[I_POS];
    float* rc = (float*)(p.ws + OFF_ROPE);
    float* rs = rc + (size_t)NT * 32;
#pragma unroll
    for (int e = 0; e < 8; ++e) {
        const int idx = item * 2048 + e * 256 + threadIdx.x;
        const int t = idx >> 5, i = idx & 31;
        const float inv = powf(10000.0f, -(float)i / 32.0f);
        const float ang = (float)pos[t] * inv;
        float sn, cs; sincosf(ang, &sn, &cs);
        rc[idx] = cs; rs[idx] = sn;
    }
}
DI int win_srcmap(int n) {
    if (n < 3072 || n >= 5120) return n;
    const int q = n - 3072, j = q >> 6, r = q & 63;
    return r < 32 ? 3072 + 32 * j + r : 3072 + 1024 + 32 * j + (r - 32);
}
DI void transpose_tile(const float* src, int N, bf16_t* dst, int k0, int n0, bool perm, char* lds, int dld = 1024) {
    float* t = (float*)lds;
    const int tid = threadIdx.x;
    const int r = tid >> 4, c4 = (tid & 15) * 4;
    int ns = n0 + c4; if (perm) ns = win_srcmap(ns);
    __syncthreads();
#pragma unroll
    for (int i = 0; i < 4; ++i) {
        const int kl = r + 16 * i;
        const f32x4 v = *(const f32x4*)(src + (size_t)(k0 + kl) * N + ns);
        t[(c4 + 0) * 65 + kl] = v[0]; t[(c4 + 1) * 65 + kl] = v[1]; t[(c4 + 2) * 65 + kl] = v[2]; t[(c4 + 3) * 65 + kl] = v[3];
    }
    __syncthreads();
    const int nl = tid >> 2, kq = (tid & 3) * 16;
    u32x4 o0, o1;
    const float* tr = t + nl * 65 + kq;
    o0.x = pk2(tr[0], tr[1]); o0.y = pk2(tr[2], tr[3]); o0.z = pk2(tr[4], tr[5]); o0.w = pk2(tr[6], tr[7]);
    o1.x = pk2(tr[8], tr[9]); o1.y = pk2(tr[10], tr[11]); o1.z = pk2(tr[12], tr[13]); o1.w = pk2(tr[14], tr[15]);
    bf16_t* d = dst + (size_t)(n0 + nl) * dld + k0 + kq;
    *(u32x4*)d = o0; *(u32x4*)(d + 8) = o1;
}
constexpr int NCONV_ITEMS = 2880 + 1024 + 512 + 2 + 32 + 32;
DI void convert_item(const Params& p, int l, int item, char* lds) {
    char* wb = p.ws + OFF_W;
    if (item < 2880) { const int kt = item % 16, nt = item / 16; transpose_tile((const float*)p.in[I_WIN] + (size_t)l * 1024 * CIN, CIN, (bf16_t*)(wb + W_IN), kt * 64, nt * 64, true, lds); return; }
    item -= 2880;
    if (item < 1024) {
        const int which = item >> 8, it = item & 255, kt = it & 15, nt = it >> 4;
        const int idx = which == 0 ? I_WATTO : which == 1 ? I_WCONVO : which == 2 ? I_WRWKVO : I_WOUT;
        const size_t off = which == 0 ? W_ATTO : which == 1 ? W_CONVO : which == 2 ? W_RWKVO : W_OUT;
        transpose_tile((const float*)p.in[idx] + (size_t)l * 1024 * 1024, 1024, (bf16_t*)(wb + off), kt * 64, nt * 64, false, lds); return;
    }
    item -= 1024;
    if (item < 512) { const int kt = item & 15, nt = item >> 4; transpose_tile((const float*)p.in[I_WQ] + (size_t)l * 1024 * 2048, 2048, (bf16_t*)(wb + W_QP), kt * 64, nt * 64, false, lds); return; }
    item -= 512;
    if (item >= 2) {
        item -= 2;
        if (item < 16) { transpose_tile((const float*)p.in[I_W2] + (size_t)l * 64 * 1024, 1024, (bf16_t*)(wb + W_W2T), 0, item * 64, false, lds, 64); return; }
        item -= 16;
        if (item < 16) { transpose_tile((const float*)p.in[I_A2] + (size_t)l * 64 * 1024, 1024, (bf16_t*)(wb + W_A2T), 0, item * 64, false, lds, 64); return; }
        item -= 16;
        if (item < 32) { transpose_tile((const float*)p.in[I_G2] + (size_t)l * 128 * 1024, 1024, (bf16_t*)(wb + W_G2T), (item & 1) * 64, (item >> 1) * 64, false, lds, 128); return; }
        return;
    }
    {
        const float* src = (const float*)p.in[item == 0 ? I_KEY1 : I_KEY2] + (size_t)l * 16384;
        bf16_t* dst = (bf16_t*)(wb + (item == 0 ? W_KEY1 : W_KEY2));
        for (int i = threadIdx.x * 4; i < 16384; i += 1024) { const f32x4 v = *(const f32x4*)(src + i); *(u32x2*)(dst + i) = pack4(v[0], v[1], v[2], v[3]); }
    }
}
constexpr size_t OFF_PU8 = OFF_ZR, OFF_PV8 = OFF_ZR + 16 * MiB, OFF_PSU = OFF_ZR + 32 * MiB, OFF_PSV = OFF_PSU + 65536;
DI void convert_uv_item(const Params& p, int l, int item) {
    const int lane = threadIdx.x & 63, rowi = item * 4 + (threadIdx.x >> 6);
    const int arr = rowi >> 14, row = rowi & 16383;
    const float* src = (const float*)p.in[arr == 0 ? I_PU : I_PV] + ((size_t)l * 16384 + row) * 1024;
    unsigned* dst = (unsigned*)(p.ws + (arr == 0 ? OFF_PU8 : OFF_PV8) + (size_t)row * 1024);
    f32x4 v[4]; float am = 0.f;
#pragma unroll
    for (int i = 0; i < 4; ++i) { v[i] = *(const f32x4*)(src + i * 256 + lane * 4); am = fmaxf(am, fmaxf(fmaxf(fabsf(v[i][0]), fabsf(v[i][1])), fmaxf(fabsf(v[i][2]), fabsf(v[i][3])))); }
    am = wave_max(am);
    const float sc = am > 0.f ? am * (1.0f / 127.0f) : 1.0f, isc = am > 0.f ? 127.0f / am : 0.f;
#pragma unroll
    for (int i = 0; i < 4; ++i) {
        unsigned w = 0;
#pragma unroll
        for (int e = 0; e < 4; ++e) { const int q = (int)rintf(v[i][e] * isc) + (arr == 0 ? 0 : 128); w |= ((unsigned)q & 255u) << (8 * e); }
        dst[i * 64 + lane] = w;
    }
    if (lane == 0) ((float*)(p.ws + (arr == 0 ? OFF_PSU : OFF_PSV)))[row] = sc;
}

DI void norm_rows(const Params& p, const float* xin, const float* gain, const float* shv, const float* scv, bf16_t* out) {
    const int lane = threadIdx.x & 63;
    const int gw = blockIdx.x * 4 + (threadIdx.x >> 6), nw = gridDim.x * 4;
    for (int t = gw; t < NT; t += nw) {
        const int b = t >> 13;
        f32x4 v[4]; float ss = 0.f;
#pragma unroll
        for (int i = 0; i < 4; ++i) { v[i] = *(const f32x4*)(xin + (size_t)t * 1024 + i * 256 + lane * 4); ss += v[i][0] * v[i][0] + v[i][1] * v[i][1] + v[i][2] * v[i][2] + v[i][3] * v[i][3]; }
        ss = wave_sum(ss);
        const float rstd = rsqrtf(ss * (1.0f / 1024.0f) + 1e-6f);
#pragma unroll
        for (int i = 0; i < 4; ++i) {
            const int n = i * 256 + lane * 4;
            const f32x4 g = *(const f32x4*)(gain + n), sc = *(const f32x4*)(scv + b * 6144 + n), sh = *(const f32x4*)(shv + b * 6144 + n);
            float o[4];
#pragma unroll
            for (int e = 0; e < 4; ++e) o[e] = v[i][e] * rstd * g[e] * (1.0f + sc[e]) + sh[e];
            *(u32x2*)(out + (size_t)t * 1024 + n) = pack4(o[0], o[1], o[2], o[3]);
        }
    }
}

DI void phaseB_tile(const Params& p, int mt, int nt, char* lds) {
    const int tid = threadIdx.x, lane = tid & 63, wid = tid >> 6, wm = wid >> 1, wn = wid & 1;
    const int fr = lane & 15, fq = lane >> 4;
    const bf16_t* X = (const bf16_t*)(p.ws + OFF_H) + (size_t)mt * 128 * 1024;
    const bf16_t* W = (const bf16_t*)(p.ws + OFF_W + W_IN) + (size_t)nt * 128 * 1024;
    const int n0 = nt * 128, nb = n0 + wn * 64;
    const int m0 = mt * 128 + wm * 64;
    f32x4 acc[4][4]; zero_acc(acc);
    if (n0 >= 2048 && n0 < 3072) {
        gemm_mainloop<true>(acc, X, 1024, W, 1024, 1024, lds);
        bf16_t* VT = (bf16_t*)(p.ws + OFF_VT);
#pragma unroll
        for (int ni = 0; ni < 4; ++ni) {
            const int col = nb - 2048 + ni * 16 + fr, hh = col >> 7, dv = col & 127, d = dv >> 5, rr = dv & 31;
#pragma unroll
            for (int ti = 0; ti < 4; ++ti) {
                const int tok = m0 + ti * 16 + fq * 4;
                const int b = tok >> 13, s = tok & 8191, kt = s >> 6, kl = s & 63, kb = kl >> 5, x = kl & 31;
                const int s_ = (x >> 4) & 1, jhi = (x >> 3) & 1, h_ = (x >> 2) & 1;
                const size_t base = ((size_t)((b * 8 + hh) * 128 + kt)) * 8192 + (size_t)(((((d * 2 + kb) * 2 + s_) * 2 + h_) * 32 + rr) * 8 + jhi * 4);
                *(u32x2*)(VT + base) = pack4(acc[ti][ni][0], acc[ti][ni][1], acc[ti][ni][2], acc[ti][ni][3]);
            }
        }
        return;
    }
    gemm_mainloop<false>(acc, X, 1024, W, 1024, 1024, lds);
    if (n0 < 2048) {
        const bool isK = n0 >= 1024;
        const int nn = nb - (isK ? 1024 : 0), hh = nn >> 7, c = (nn >> 6) & 1;
        const float scl = isK ? 1.0f : 0.125f * 1.4426950408889634f;
        bf16_t* dst = (bf16_t*)(p.ws + (isK ? OFF_K : OFF_Q));
        const float* rc = (const float*)(p.ws + OFF_ROPE);
        const float* rs = rc + (size_t)NT * 32;
#pragma unroll
        for (int ti = 0; ti < 4; ++ti) {
            const int tok = m0 + ti * 16 + fr, b = tok >> 13, s = tok & 8191;
            bf16_t* row = dst + ((size_t)(((b * 8 + hh) * 2 + c)) * SEQ + s) * 64;
#pragma unroll
            for (int ni = 0; ni < 2; ++ni) {
                const int i0 = ni * 16 + fq * 4;
                const f32x4 cs = *(const f32x4*)(rc + (size_t)tok * 32 + i0), sn = *(const f32x4*)(rs + (size_t)tok * 32 + i0);
                float o1[4], o2[4];
#pragma unroll
                for (int r = 0; r < 4; ++r) {
                    const float t1 = acc[ti][ni][r], t2 = acc[ti][ni + 2][r];
                    o1[r] = (t1 * cs[r] - t2 * sn[r]) * scl; o2[r] = (t2 * cs[r] + t1 * sn[r]) * scl;
                }
                *(u32x2*)(row + i0) = pack4(o1[0], o1[1], o1[2], o1[3]);
                *(u32x2*)(row + 32 + i0) = pack4(o2[0], o2[1], o2[2], o2[3]);
            }
        }
    } else if (n0 < 5120) {
        const int j = (nb - 3072) >> 6;
        bf16_t* UC = (bf16_t*)(p.ws + OFF_UC);
#pragma unroll
        for (int ti = 0; ti < 4; ++ti) {
            const int tok = m0 + ti * 16 + fr;
#pragma unroll
            for (int ni = 0; ni < 2; ++ni) {
                const int ch = 32 * j + ni * 16 + fq * 4;
                float o[4];
#pragma unroll
                for (int r = 0; r < 4; ++r) o[r] = acc[ti][ni][r] * sigmoidf_(acc[ti][ni + 2][r]);
                *(u32x2*)(UC + (size_t)tok * 1024 + ch) = pack4(o[0], o[1], o[2], o[3]);
            }
        }
    } else if (n0 < 8448) {
        bf16_t* ZR = (bf16_t*)(p.ws + OFF_ZR);
#pragma unroll
        for (int ti = 0; ti < 4; ++ti) {
            const int tok = m0 + ti * 16 + fr;
#pragma unroll
            for (int ni = 0; ni < 4; ++ni) {
                const int col = nb - 5120 + ni * 16 + fq * 4;
                *(u32x2*)(ZR + (size_t)tok * RWKV_LD + col) = pack4(acc[ti][ni][0], acc[ti][ni][1], acc[ti][ni][2], acc[ti][ni][3]);
            }
        }
    } else {
        bf16_t* ZG = (bf16_t*)(p.ws + OFF_ZG);
#pragma unroll
        for (int ti = 0; ti < 4; ++ti) {
            const int tok = m0 + ti * 16 + fr;
#pragma unroll
            for (int ni = 0; ni < 4; ++ni) {
                const int col = nb - 8448 + ni * 16 + fq * 4;
                *(u32x2*)(ZG + (size_t)tok * ZG_LD + col) = pack4(sigmoidf_(acc[ti][ni][0]), sigmoidf_(acc[ti][ni][1]), sigmoidf_(acc[ti][ni][2]), sigmoidf_(acc[ti][ni][3]));
            }
        }
    }
}

DI void zr_shift8(const bf16_t* ZR, const float* mu, int tok, int col, float (&z)[8]) {
    const u32x4 cv = *(const u32x4*)(ZR + (size_t)tok * RWKV_LD + col);
    u32x4 pv = (u32x4){0u, 0u, 0u, 0u};
    if ((tok & 8191) != 0) pv = *(const u32x4*)(ZR + (size_t)(tok - 1) * RWKV_LD + col);
    float c[8], q[8]; unpack8(cv, c); unpack8(pv, q);
    const f32x4 m0 = *(const f32x4*)(mu + col), m1 = *(const f32x4*)(mu + col + 4);
#pragma unroll
    for (int e = 0; e < 4; ++e) { z[e] = c[e] + m0[e] * (q[e] - c[e]); z[4 + e] = c[4 + e] + m1[e] * (q[4 + e] - c[4 + e]); }
}
DI void zr_shift4(const bf16_t* ZR, const float* mu, int tok, int col, float (&z)[4]) {
    const u32x2 cv = *(const u32x2*)(ZR + (size_t)tok * RWKV_LD + col);
    u32x2 pv = (u32x2){0u, 0u};
    if ((tok & 8191) != 0) pv = *(const u32x2*)(ZR + (size_t)(tok - 1) * RWKV_LD + col);
    float c[4], q[4]; unpack4(cv, c); unpack4(pv, q);
    const f32x4 m0 = *(const f32x4*)(mu + col);
#pragma unroll
    for (int e = 0; e < 4; ++e) z[e] = c[e] + m0[e] * (q[e] - c[e]);
}

constexpr size_t OFF_LORA = 501 * MiB;
constexpr size_t OFF_CF = 509 * MiB;
DI void lora_in_tile(const Params& p, int l, int tile) {
    const int tid = threadIdx.x, tok = tile * 16 + (tid >> 4), c8 = (tid & 15) * 8;
    const bf16_t* ZR = (const bf16_t*)(p.ws + OFF_ZR);
    const float* mu = (const float*)p.in[I_MU] + (size_t)l * RWKV_LD;
    bf16_t* out = (bf16_t*)(p.ws + OFF_LORA) + (size_t)tok * 256;
    float z[8], y[8];
    zr_shift8(ZR, mu, tok, 3072 + c8, z);
#pragma unroll
    for (int e = 0; e < 8; ++e) y[e] = c8 < 64 ? tanhf(z[e]) : z[e];
    { u32x4 w; w.x = pk2(y[0], y[1]); w.y = pk2(y[2], y[3]); w.z = pk2(y[4], y[5]); w.w = pk2(y[6], y[7]); *(u32x4*)(out + c8) = w; }
}
DI void lora_wa_tile(const Params& p, int l, int which, int mt, int nt, char* lds) {
    const int tid = threadIdx.x, lane = tid & 63, wid = tid >> 6, wm = wid >> 1, wn = wid & 1, fr = lane & 15, fq = lane >> 4;
    const int m0 = mt * 128 + wm * 64, nb = nt * 128 + wn * 64;
    f32x4 acc[4][4]; zero_acc(acc);
    gemm_mainloop<false>(acc, (const bf16_t*)(p.ws + OFF_LORA) + (size_t)mt * 128 * 256 + which * 64, 256,
                         (const bf16_t*)(p.ws + OFF_W + (which == 0 ? W_W2T : W_A2T)) + (size_t)nt * 128 * 64, 64, 64, lds);
    const float* bias = (const float*)p.in[which == 0 ? I_W0 : I_A0] + (size_t)l * 1024;
    bf16_t* dst = (bf16_t*)(p.ws + (which == 0 ? OFF_LW : OFF_A));
    const float scl = which == 0 ? -0.6065306597126334f : 1.0f;
#pragma unroll
    for (int ni = 0; ni < 4; ++ni) {
        const int n = nb + ni * 16 + fq * 4;
        const f32x4 bv = *(const f32x4*)(bias + n);
#pragma unroll
        for (int ti = 0; ti < 4; ++ti) {
            const int tok = m0 + ti * 16 + fr;
            float o[4];
#pragma unroll
            for (int r = 0; r < 4; ++r) o[r] = scl * sigmoidf_(acc[ti][ni][r] + bv[r]);
            *(u32x2*)(dst + (size_t)tok * 1024 + n) = pack4(o[0], o[1], o[2], o[3]);
        }
    }
}

DI void conv_tile(const Params& p, int l, int tile, char* lds) {
    const int tid = threadIdx.x, lane = tid & 63, wid = tid >> 6, t0 = tile * 16, s0 = t0 & 8191;
    const bf16_t* UC = (const bf16_t*)(p.ws + OFF_UC);
    bf16_t* out = (bf16_t*)(p.ws + OFF_CONVP);
    float* su = (float*)lds;
    float* red = su + 46 * 256;
    float s1[16], s2[16];
#pragma unroll
    for (int t = 0; t < 16; ++t) { s1[t] = 0.f; s2[t] = 0.f; }
#pragma unroll 1
    for (int ps = 0; ps < 4; ++ps) {
        const int cbase = ps * 256;
        __syncthreads();
        for (int ch = tid; ch < 46 * 32; ch += 256) {
            const int row = ch >> 5, c8 = (ch & 31) * 8;
            u32x4 v = (u32x4){0u, 0u, 0u, 0u};
            if (s0 - 30 + row >= 0) v = *(const u32x4*)(UC + (size_t)(t0 - 30 + row) * 1024 + cbase + c8);
            float f[8]; unpack8(v, f);
            *(f32x4*)(su + row * 256 + c8) = (f32x4){f[0], f[1], f[2], f[3]};
            *(f32x4*)(su + row * 256 + c8 + 4) = (f32x4){f[4], f[5], f[6], f[7]};
        }
        __syncthreads();
        const int c = cbase + tid;
        float w[31];
#pragma unroll
        for (int j = 0; j < 31; ++j) w[j] = ((const float*)p.in[I_CONVW])[(size_t)l * 31 * 1024 + j * 1024 + c];
        const float bias = ((const float*)p.in[I_CONVB])[l * 1024 + c];
        float acc[16];
#pragma unroll
        for (int t = 0; t < 16; ++t) acc[t] = bias;
#pragma unroll
        for (int rr = 0; rr < 46; ++rr) {
            const float uval = su[rr * 256 + tid];
#pragma unroll
            for (int t = 0; t < 16; ++t) if (rr - t >= 0 && rr - t <= 30) acc[t] += w[rr - t] * uval;
        }
#pragma unroll
        for (int t = 0; t < 16; ++t) {
            const bf16_t hb = f2bf(acc[t]); const float yr = bf2f(hb);
            s1[t] += yr; s2[t] += yr * yr;
            out[(size_t)(t0 + t) * 1024 + c] = hb;
        }
    }
    __syncthreads();
#pragma unroll
    for (int t = 0; t < 16; ++t) {
        const float a = wave_sum(s1[t]), b2 = wave_sum(s2[t]);
        if (lane == 0) { red[(wid * 16 + t) * 2] = a; red[(wid * 16 + t) * 2 + 1] = b2; }
    }
    __syncthreads();
#pragma unroll 1
    for (int ps = 0; ps < 4; ++ps) {
        const int c = ps * 256 + tid;
        const float g = ((const float*)p.in[I_CLNG])[l * 1024 + c], bb = ((const float*)p.in[I_CLNB])[l * 1024 + c];
#pragma unroll
        for (int t = 0; t < 16; ++t) {
            const float a = red[t * 2] + red[(16 + t) * 2] + red[(32 + t) * 2] + red[(48 + t) * 2];
            const float b2 = red[t * 2 + 1] + red[(16 + t) * 2 + 1] + red[(32 + t) * 2 + 1] + red[(48 + t) * 2 + 1];
            const float mean = a * (1.0f / 1024.0f), var = fmaxf(b2 * (1.0f / 1024.0f) - mean * mean, 0.f);
            const float y = bf2f(out[(size_t)(t0 + t) * 1024 + c]);
            const float yn = (y - mean) * rsqrtf(var + 1e-5f) * g + bb;
            out[(size_t)(t0 + t) * 1024 + c] = f2bf(siluf_(yn));
        }
    }
}

constexpr int NSEG = 4, SEGLEN = SEQ / NSEG;
constexpr int SCAN_BUF = 5 * 1024 + 512;
constexpr size_t OFF_FS = 497 * MiB;
static_assert((size_t)NB * 16 * NSEG * 2 * 4096 * 4 <= 15 * MiB, "segment state region");
DI float row8_sum(float x) { x += dpp_f<0xB1>(x); x += dpp_f<0x4E>(x); x += dpp_f<0x141>(x); return x; }
enum { SCAN_PASS1 = 0, SCAN_PASS1_DATA = 1, SCAN_FINAL = 2 };
struct StepVec { f32x2 w[4], a[4], b[4], k[4], r[4]; float v; };
DI f32x2 v2lo(f32x4 v) { return __builtin_shufflevector(v, v, 0, 1); }
DI f32x2 v2hi(f32x4 v) { return __builtin_shufflevector(v, v, 2, 3); }
DI void ld4pairs(const float* q, f32x2 (&d)[4]) { const f32x4 x = *(const f32x4*)q, y = *(const f32x4*)(q + 4); d[0] = v2lo(x); d[1] = v2hi(x); d[2] = v2lo(y); d[3] = v2hi(y); }

template <int MODE>
DI void scan_block(const Params& p, int l, int b, int hh, int seg, int half, char* lds) {
    const int tid = threadIdx.x;
    const int il = tid >> 3, cgp = tid & 7;
    const int ts = tid >> 4, jg = tid & 15;
    float* bufs = (float*)lds;
    float* ybuf = bufs + 2 * SCAN_BUF;
    const bf16_t* ZR = (const bf16_t*)(p.ws + OFF_ZR);
    const bf16_t* Ab = (const bf16_t*)(p.ws + OFF_A);
    const bf16_t* Lb = (const bf16_t*)(p.ws + OFF_LW);
    bf16_t* YS = (bf16_t*)(p.ws + OFF_YS);
    float* FS = (float*)(p.ws + OFF_FS) + (size_t)((b * 16 + hh) * NSEG) * 2 * 4096;
    const float* mu = (const float*)p.in[I_MU] + (size_t)l * RWKV_LD;
    const int ncol = hh * 64 + jg * 4;
    const f32x4 kkv = *(const f32x4*)((const float*)p.in[I_KK] + l * 1024 + ncol);
    const f32x4 kav = *(const f32x4*)((const float*)p.in[I_KA] + l * 1024 + ncol);
    const int tokb = b * SEQ + seg * SEGLEN;
    float rr[4], kk[4], vv[4]; u32x2 av, lv;
    auto stage_load = [&](int c) {
        const int tok = tokb + c * 16 + ts;
        if (MODE == SCAN_FINAL) zr_shift4(ZR, mu, tok, ncol, rr);
        zr_shift4(ZR, mu, tok, 1024 + ncol, kk);
        zr_shift4(ZR, mu, tok, 2048 + ncol, vv);
        av = *(const u32x2*)(Ab + (size_t)tok * 1024 + ncol); lv = *(const u32x2*)(Lb + (size_t)tok * 1024 + ncol);
    };
    auto stage_write = [&](float* buf) {
        float a[4], lw[4]; unpack4(av, a); unpack4(lv, lw);
        float kq[4], ss = 0.f;
#pragma unroll
        for (int e = 0; e < 4; ++e) { kq[e] = kk[e] * kkv[e]; ss += kq[e] * kq[e]; }
        ss = row16_sum(ss);
        const float inv = 1.0f / fmaxf(sqrtf(ss), 1e-12f);
        f32x4 W4, K4, A4, B4, R4;
#pragma unroll
        for (int e = 0; e < 4; ++e) {
            const float kf = kq[e] * inv;
            W4[e] = __expf(lw[e]); K4[e] = kk[e] * (1.0f + (a[e] - 1.0f) * kav[e]); A4[e] = -kf; B4[e] = kf * a[e]; R4[e] = MODE == SCAN_FINAL ? rr[e] : 0.f;
        }
        float* bp = buf + ts * 64 + jg * 4;
        *(f32x4*)(bp) = W4; *(f32x4*)(bp + 1024) = K4; *(f32x4*)(bp + 2048) = A4; *(f32x4*)(bp + 3072) = B4;
        if ((jg >> 3) == half) *(f32x4*)(buf + 5120 + ts * 32 + (jg & 7) * 4) = (f32x4){vv[0], vv[1], vv[2], vv[3]};
        if (MODE == SCAN_FINAL) *(f32x4*)(bp + 4096) = R4;
    };
    f32x2 S[4], P[4];
#pragma unroll
    for (int q = 0; q < 4; ++q) {
        S[q] = (f32x2){0.f, 0.f};
        P[q] = (f32x2){((half * 32 + il) == cgp * 8 + 2 * q) ? 1.0f : 0.f, ((half * 32 + il) == cgp * 8 + 2 * q + 1) ? 1.0f : 0.f};
    }
    __syncthreads();
    if (MODE == SCAN_FINAL && seg > 0) {
        float* srow = (float*)lds;
        for (int q = 0; q < seg; ++q) {
            const float* Zq = FS + (size_t)(q * 2 + 0) * 4096 + (size_t)(half * 32 + il) * 64 + cgp * 8;
            const float* Pq = FS + (size_t)(q * 2 + 1) * 4096 + cgp * 8;
            *(f32x4*)(srow + il * 64 + cgp * 8) = (f32x4){S[0].x, S[0].y, S[1].x, S[1].y};
            *(f32x4*)(srow + il * 64 + cgp * 8 + 4) = (f32x4){S[2].x, S[2].y, S[3].x, S[3].y};
            __syncthreads();
            f32x4 n0 = *(const f32x4*)Zq, n1 = *(const f32x4*)(Zq + 4);
            if (q > 0)
#pragma unroll 4
            for (int m = 0; m < 64; ++m) {
                const float sm = srow[il * 64 + m];
                n0 += sm * *(const f32x4*)(Pq + (size_t)m * 64); n1 += sm * *(const f32x4*)(Pq + (size_t)m * 64 + 4);
            }
            __syncthreads();
            S[0] = v2lo(n0); S[1] = v2hi(n0); S[2] = v2lo(n1); S[3] = v2hi(n1);
        }
    }
    stage_load(0); stage_write(bufs);
    __syncthreads();
    constexpr int NCH = SEGLEN / 16;
    for (int c = 0; c < NCH; ++c) {
        const float* buf = bufs + (c & 1) * SCAN_BUF;
        float* yb = ybuf + (c & 1) * 512;
        if (MODE == SCAN_FINAL && c > 0) {
            const float* yp = ybuf + ((c - 1) & 1) * 512;
#pragma unroll
            for (int q = 0; q < 2; ++q) { const int idx = tid + 256 * q; YS[(size_t)(tokb + (c - 1) * 16 + (idx >> 5)) * 1024 + hh * 64 + half * 32 + (idx & 31)] = f2bf(yp[idx]); }
        }
        if (c + 1 < NCH) stage_load(c + 1);
        float ykeep0 = 0.f, ykeep1 = 0.f;
        auto ldstep = [&](int t, StepVec& sv) {
            const float* bp = buf + t * 64 + cgp * 8;
            ld4pairs(bp, sv.w); ld4pairs(bp + 1024, sv.k); ld4pairs(bp + 2048, sv.a); ld4pairs(bp + 3072, sv.b);
            if (MODE == SCAN_FINAL) ld4pairs(bp + 4096, sv.r);
            sv.v = buf[5120 + t * 32 + il];
        };
        StepVec sv[2];
        ldstep(0, sv[0]);
#pragma unroll 2
        for (int t = 0; t < 16; ++t) {
            ldstep(t + 1, sv[(t + 1) & 1]);
            const StepVec& x = sv[t & 1];
            f32x2 d2 = S[0] * x.a[0]; d2 = S[1] * x.a[1] + d2; d2 = S[2] * x.a[2] + d2; d2 = S[3] * x.a[3] + d2;
            float sa = d2.x + d2.y;
            const f32x2 vv2 = (f32x2){x.v, x.v};
            f32x2 tq[4];
#pragma unroll
            for (int e = 0; e < 4; ++e) tq[e] = S[e] * x.w[e] + vv2 * x.k[e];
            sa = row8_sum(sa);
            const f32x2 sa2 = (f32x2){sa, sa};
#pragma unroll
            for (int e = 0; e < 4; ++e) S[e] = tq[e] + sa2 * x.b[e];
            if (MODE == SCAN_PASS1) {
                f32x2 e2 = P[0] * x.a[0]; e2 = P[1] * x.a[1] + e2; e2 = P[2] * x.a[2] + e2; e2 = P[3] * x.a[3] + e2;
                float pa = e2.x + e2.y;
                f32x2 pq[4];
#pragma unroll
                for (int e = 0; e < 4; ++e) pq[e] = P[e] * x.w[e];
                pa = row8_sum(pa);
                const f32x2 pa2 = (f32x2){pa, pa};
#pragma unroll
                for (int e = 0; e < 4; ++e) P[e] = pq[e] + pa2 * x.b[e];
            }
            if (MODE == SCAN_FINAL) {
                f32x2 y2 = S[0] * x.r[0]; y2 = S[1] * x.r[1] + y2; y2 = S[2] * x.r[2] + y2; y2 = S[3] * x.r[3] + y2;
                float y = y2.x + y2.y;
                y = row8_sum(y);
                if (cgp == (t & 7)) { if (t < 8) ykeep0 = y; else ykeep1 = y; }
            }
            __builtin_amdgcn_sched_barrier(0);
        }
        if (MODE == SCAN_FINAL) { yb[cgp * 32 + il] = ykeep0; yb[(cgp + 8) * 32 + il] = ykeep1; }
        if (c + 1 < NCH) stage_write(bufs + ((c + 1) & 1) * SCAN_BUF);
        __syncthreads();
    }
    if (MODE == SCAN_FINAL) {
        const float* yp = ybuf + ((NCH - 1) & 1) * 512;
#pragma unroll
        for (int q = 0; q < 2; ++q) { const int idx = tid + 256 * q; YS[(size_t)(tokb + (NCH - 1) * 16 + (idx >> 5)) * 1024 + hh * 64 + half * 32 + (idx & 31)] = f2bf(yp[idx]); }
    } else {
        float* dz = FS + (size_t)(seg * 2 + 0) * 4096 + (size_t)(half * 32 + il) * 64 + cgp * 8;
        *(f32x4*)dz = (f32x4){S[0].x, S[0].y, S[1].x, S[1].y}; *(f32x4*)(dz + 4) = (f32x4){S[2].x, S[2].y, S[3].x, S[3].y};
        if (MODE == SCAN_PASS1) {
            float* dp = FS + (size_t)(seg * 2 + 1) * 4096 + (size_t)(half * 32 + il) * 64 + cgp * 8;
            *(f32x4*)dp = (f32x4){P[0].x, P[0].y, P[1].x, P[1].y}; *(f32x4*)(dp + 4) = (f32x4){P[2].x, P[2].y, P[3].x, P[3].y};
        }
    }
}
constexpr int N_SCAN1 = 64 * (NSEG - 1), N_SCAN2 = 64 * NSEG;
DI void scan_item_pass1(const Params& p, int l, int it, char* lds) {
    const int half = it & 1, bh = (it >> 1) & 31, seg = (NSEG - 2) - (it >> 6);
    if (seg == 0) scan_block<SCAN_PASS1_DATA>(p, l, bh >> 4, bh & 15, seg, half, lds);
    else scan_block<SCAN_PASS1>(p, l, bh >> 4, bh & 15, seg, half, lds);
}
DI void scan_item_pass2(const Params& p, int l, int it, char* lds) {
    const int half = it & 1, bh = (it >> 1) & 31, seg = it >> 6;
    scan_block<SCAN_FINAL>(p, l, bh >> 4, bh & 15, seg, half, lds);
}

namespace cs {
constexpr int LDA = 72, LDB = 40;
constexpr int O_LW = 0;
constexpr int O_AT = O_LW + 4096;
constexpr int O_RT = O_AT + 16 * LDA * 2;
constexpr int O_BG = O_RT + 16 * LDA * 2;
constexpr int O_KG = O_BG + 16 * LDA * 2;
constexpr int O_BKT = O_KG + 16 * LDA * 2;
constexpr int O_UV = O_BKT + 64 * LDB * 2;
constexpr int O_XA = O_UV + 64 * LDB * 2;
constexpr int O_SA = O_XA + 64 * LDB * 2;
constexpr int O_ABB = O_SA + 64 * LDA * 2;
constexpr int O_AKB = O_ABB + 16 * 17 * 4 + 64;
constexpr int O_BRK = O_AKB + 16 * LDB * 2;
constexpr int O_TT = O_BRK + 16 * LDB * 2;
constexpr int O_G15 = O_TT + 64 * LDB * 2;
constexpr int O_END = O_G15 + 256;
static_assert(O_END <= 60000, "chunked-scan LDS map");
}
constexpr size_t OFF_TTG = 497 * MiB;
DI void scan_T_item(const Params& p, int l, int item, char* lds) {
    using namespace cs;
    const int tid = threadIdx.x, lane = tid & 63, wv = tid >> 6, fr = lane & 15, fq = lane >> 4;
    const int bh = item >> 7, grp = item & 127, b = bh >> 4, hh = bh & 15;
    const int ts = tid >> 4, jg = tid & 15;
    const bf16_t* ZR = (const bf16_t*)(p.ws + OFF_ZR);
    const bf16_t* Ab = (const bf16_t*)(p.ws + OFF_A);
    const bf16_t* Lb = (const bf16_t*)(p.ws + OFF_LW);
    const float* mu = (const float*)p.in[I_MU] + (size_t)l * RWKV_LD;
    const int ncol = hh * 64 + jg * 4;
    const f32x4 kkv = *(const f32x4*)((const float*)p.in[I_KK] + l * 1024 + ncol);
    float* sLW = (float*)lds;
    bf16_t* sA = (bf16_t*)(lds + 16384);
    bf16_t* sB = sA + 4 * 16 * LDA;
    float an[4][4], bn[4][4], lw[4][4];
    __syncthreads();
#pragma unroll
    for (int q = 0; q < 4; ++q) {
        const int tok = b * SEQ + (grp * 4 + q) * 16 + ts;
        float kk[4], a[4];
        zr_shift4(ZR, mu, tok, 1024 + ncol, kk);
        unpack4(*(const u32x2*)(Ab + (size_t)tok * 1024 + ncol), a);
        unpack4(*(const u32x2*)(Lb + (size_t)tok * 1024 + ncol), lw[q]);
        float kq[4], ss = 0.f;
#pragma unroll
        for (int e = 0; e < 4; ++e) { kq[e] = kk[e] * kkv[e]; ss += kq[e] * kq[e]; }
        ss = row16_sum(ss);
        const float inv = 1.0f / fmaxf(sqrtf(ss), 1e-12f);
#pragma unroll
        for (int e = 0; e < 4; ++e) { const float kf = kq[e] * inv; an[q][e] = -kf; bn[q][e] = kf * a[e]; }
        *(f32x4*)(sLW + (q * 16 + ts) * 64 + jg * 4) = (f32x4){lw[q][0], lw[q][1], lw[q][2], lw[q][3]};
    }
    __syncthreads();
#pragma unroll
    for (int q = 0; q < 4; ++q) {
        f32x4 pin = (f32x4){0.f, 0.f, 0.f, 0.f};
#pragma unroll
        for (int t = 0; t < 16; ++t) { const f32x4 x = *(const f32x4*)(sLW + (q * 16 + t) * 64 + jg * 4); if (t <= ts) pin += x; }
        float at4[4], bt4[4];
#pragma unroll
        for (int e = 0; e < 4; ++e) { at4[e] = an[q][e] * __expf(pin[e] - lw[q][e]); bt4[e] = bn[q][e] * __expf(-pin[e]); }
        *(u32x2*)(sA + (q * 16 + ts) * LDA + jg * 4) = pack4(at4[0], at4[1], at4[2], at4[3]);
        *(u32x2*)(sB + (q * 16 + ts) * LDA + jg * 4) = pack4(bt4[0], bt4[1], bt4[2], bt4[3]);
    }
    __syncthreads();
    f32x4 cg = (f32x4){0.f, 0.f, 0.f, 0.f};
#pragma unroll
    for (int ks = 0; ks < 2; ++ks) cg = MFMA16(*(const bf16x8*)(sB + (wv * 16 + fr) * LDA + ks * 32 + fq * 8), *(const bf16x8*)(sA + (wv * 16 + fr) * LDA + ks * 32 + fq * 8), cg);
#pragma unroll
    for (int r = 0; r < 4; ++r) if (fq * 4 + r >= fr) cg[r] = 0.f;
    float Tr[16];
#pragma unroll
    for (int sidx = 15; sidx >= 0; --sidx) {
        float acc = (sidx == fr) ? 1.0f : 0.f;
#pragma unroll
        for (int m = sidx + 1; m < 16; ++m) {
            const float asm_ = __int_as_float(__builtin_amdgcn_readlane(__float_as_int(cg[sidx & 3]), (sidx >> 2) * 16 + m));
            acc += asm_ * Tr[m];
        }
        Tr[sidx] = acc;
    }
    if (fq == 0) {
        bf16_t* dst = (bf16_t*)(p.ws + OFF_TTG) + ((size_t)(bh * 512 + grp * 4 + wv) * 16 + fr) * 16;
        u32x4 w0, w1;
        w0.x = pk2(Tr[0], Tr[1]); w0.y = pk2(Tr[2], Tr[3]); w0.z = pk2(Tr[4], Tr[5]); w0.w = pk2(Tr[6], Tr[7]);
        w1.x = pk2(Tr[8], Tr[9]); w1.y = pk2(Tr[10], Tr[11]); w1.z = pk2(Tr[12], Tr[13]); w1.w = pk2(Tr[14], Tr[15]);
        *(u32x4*)dst = w0; *(u32x4*)(dst + 8) = w1;
    }
}
constexpr int MSEG = 4, MCPS = (SEQ / 16) / MSEG;
constexpr size_t OFF_FS2 = 506 * MiB;
enum { MS_FINAL = 0, MS_DATA1 = 1, MS_IDENT = 2 };
template <int MODE>
DI void scan_mfma_block(const Params& p, int l, int b, int hh, int seg, char* lds) {
    using namespace cs;
    const int tid = threadIdx.x, lane = tid & 63, wv = tid >> 6, fr = lane & 15, fq = lane >> 4;
    const int ts = tid >> 4, jg = tid & 15;
    const bf16_t* ZR = (const bf16_t*)(p.ws + OFF_ZR);
    const bf16_t* Ab = (const bf16_t*)(p.ws + OFF_A);
    const bf16_t* Lb = (const bf16_t*)(p.ws + OFF_LW);
    const bf16_t* TTg = (const bf16_t*)(p.ws + OFF_TTG) + (size_t)((b * 16 + hh) * 512) * 256;
    bf16_t* YS = (bf16_t*)(p.ws + OFF_YS);
    const float* mu = (const float*)p.in[I_MU] + (size_t)l * RWKV_LD;
    const int ncol = hh * 64 + jg * 4;
    const f32x4 kkv = *(const f32x4*)((const float*)p.in[I_KK] + l * 1024 + ncol);
    const f32x4 kav = *(const f32x4*)((const float*)p.in[I_KA] + l * 1024 + ncol);
    float* sLW = (float*)(lds + O_LW);
    bf16_t* sAT = (bf16_t*)(lds + O_AT); bf16_t* sRT = (bf16_t*)(lds + O_RT); bf16_t* sBG = (bf16_t*)(lds + O_BG); bf16_t* sKG = (bf16_t*)(lds + O_KG);
    bf16_t* sBKT = (bf16_t*)(lds + O_BKT);
    bf16_t* sUV = (bf16_t*)(lds + O_UV) + wv * 16 * LDB; bf16_t* sXA = (bf16_t*)(lds + O_XA) + wv * 16 * LDB; bf16_t* sSA = (bf16_t*)(lds + O_SA) + wv * 16 * LDA;
    bf16_t* sAKB = (bf16_t*)(lds + O_AKB); bf16_t* sBRK = (bf16_t*)(lds + O_BRK);
    float* sG15 = (float*)(lds + O_G15);
    __syncthreads();
    for (int i = tid; i < O_END / 4; i += NTHREADS) ((unsigned*)lds)[i] = 0u;
    f32x4 S[4];
#pragma unroll
    for (int cb = 0; cb < 4; ++cb)
#pragma unroll
        for (int r = 0; r < 4; ++r) S[cb][r] = (MODE == MS_IDENT && (wv * 16 + fq * 4 + r) == (cb * 16 + fr)) ? 1.0f : 0.f;
    float* FS = (float*)(p.ws + OFF_FS2) + (size_t)((b * 16 + hh) * (MSEG - 1)) * 2 * 4096;
    if (MODE == MS_FINAL && seg > 0) {
        float* sS = (float*)lds + wv * 1024;
        for (int q = 0; q < seg; ++q) {
            const float* Zq = FS + (size_t)(q * 2 + 0) * 4096;
            const float* Pq = FS + (size_t)(q * 2 + 1) * 4096;
            f32x4 nw[4];
#pragma unroll
            for (int cb = 0; cb < 4; ++cb)
#pragma unroll
                for (int r = 0; r < 4; ++r) nw[cb][r] = Zq[(size_t)(wv * 16 + fq * 4 + r) * 64 + cb * 16 + fr];
            if (q > 0) {
                __syncthreads();
#pragma unroll
                for (int cb = 0; cb < 4; ++cb)
#pragma unroll
                    for (int r = 0; r < 4; ++r) sS[(fq * 4 + r) * 64 + cb * 16 + fr] = S[cb][r];
                __syncthreads();
#pragma unroll 1
                for (int m = 0; m < 64; ++m) {
                    const float p0 = Pq[m * 64 + fr], p1 = Pq[m * 64 + 16 + fr], p2 = Pq[m * 64 + 32 + fr], p3 = Pq[m * 64 + 48 + fr];
#pragma unroll
                    for (int r = 0; r < 4; ++r) { const float sm = sS[(fq * 4 + r) * 64 + m]; nw[0][r] += sm * p0; nw[1][r] += sm * p1; nw[2][r] += sm * p2; nw[3][r] += sm * p3; }
                }
            }
#pragma unroll
            for (int cb = 0; cb < 4; ++cb) S[cb] = nw[cb];
        }
        __syncthreads();
        for (int i = tid; i < 4096; i += NTHREADS) ((unsigned*)lds)[i] = 0u;
        __syncthreads();
#pragma unroll
        for (int cb = 0; cb < 4; ++cb)
#pragma unroll
            for (int r = 0; r < 4; ++r) sSA[(fq * 4 + r) * LDA + cb * 16 + fr] = f2bf(S[cb][r]);
    } else if (MODE == MS_IDENT) {
        __syncthreads();
#pragma unroll
        for (int cb = 0; cb < 4; ++cb)
#pragma unroll
            for (int r = 0; r < 4; ++r) sSA[(fq * 4 + r) * LDA + cb * 16 + fr] = f2bf(S[cb][r]);
    }
    const int tokb = b * SEQ + seg * MCPS * 16;
    float rr[4], kk[4], vv[4]; u32x2 av, lv; u32x4 tq;
    auto stage_load = [&](int c) {
        const int tok = tokb + c * 16 + ts;
        zr_shift4(ZR, mu, tok, ncol, rr); zr_shift4(ZR, mu, tok, 1024 + ncol, kk); zr_shift4(ZR, mu, tok, 2048 + ncol, vv);
        av = *(const u32x2*)(Ab + (size_t)tok * 1024 + ncol); lv = *(const u32x2*)(Lb + (size_t)tok * 1024 + ncol);
        tq = *(const u32x4*)(TTg + (size_t)(seg * MCPS + c) * 256 + fr * 16 + (fq & 1) * 8);
    };
    stage_load(0);
    for (int c = 0; c < MCPS; ++c) {
        float a[4], lw[4]; unpack4(av, a); unpack4(lv, lw);
        float kq[4], ss = 0.f;
#pragma unroll
        for (int e = 0; e < 4; ++e) { kq[e] = kk[e] * kkv[e]; ss += kq[e] * kq[e]; }
        ss = row16_sum(ss);
        const float inv = 1.0f / fmaxf(sqrtf(ss), 1e-12f);
        float kn[4], an[4], bn[4], rn[4], vn[4];
#pragma unroll
        for (int e = 0; e < 4; ++e) { const float kf = kq[e] * inv; kn[e] = kk[e] * (1.0f + (a[e] - 1.0f) * kav[e]); an[e] = -kf; bn[e] = kf * a[e]; rn[e] = rr[e]; vn[e] = vv[e]; }
        const bf16x8 tfrag = fq < 2 ? __builtin_bit_cast(bf16x8, tq) : (bf16x8){0, 0, 0, 0, 0, 0, 0, 0};
        *(f32x4*)(sLW + ts * 64 + jg * 4) = (f32x4){lw[0], lw[1], lw[2], lw[3]};
        if (c + 1 < MCPS) stage_load(c + 1);
        __syncthreads();
        f32x4 pin = (f32x4){0.f, 0.f, 0.f, 0.f}, pall = pin;
#pragma unroll
        for (int t = 0; t < 16; ++t) { const f32x4 x = *(const f32x4*)(sLW + t * 64 + jg * 4); pall += x; if (t <= ts) pin += x; }
        {
            float at4[4], rt4[4], bt4[4], kt4[4];
#pragma unroll
            for (int e = 0; e < 4; ++e) {
                const float g = __expf(pin[e]), gp = __expf(pin[e] - lw[e]), gi = __expf(-pin[e]);
                at4[e] = an[e] * gp; rt4[e] = rn[e] * g; bt4[e] = bn[e] * gi; kt4[e] = kn[e] * gi;
            }
            *(u32x2*)(sAT + ts * LDA + jg * 4) = pack4(at4[0], at4[1], at4[2], at4[3]);
            *(u32x2*)(sRT + ts * LDA + jg * 4) = pack4(rt4[0], rt4[1], rt4[2], rt4[3]);
            *(u32x2*)(sBG + ts * LDA + jg * 4) = pack4(bt4[0], bt4[1], bt4[2], bt4[3]);
            *(u32x2*)(sKG + ts * LDA + jg * 4) = pack4(kt4[0], kt4[1], kt4[2], kt4[3]);
#pragma unroll
            for (int e = 0; e < 4; ++e) {
                sBKT[(jg * 4 + e) * LDB + ts] = f2bf(bt4[e]); sBKT[(jg * 4 + e) * LDB + 16 + ts] = f2bf(kt4[e]);
                if (MODE != MS_IDENT) ((bf16_t*)(lds + O_UV))[((jg >> 2) * 16 + (jg & 3) * 4 + e) * LDB + 16 + ts] = f2bf(vn[e]);
            }
            if (ts == 15) *(f32x4*)(sG15 + jg * 4) = (f32x4){__expf(pall[0]), __expf(pall[1]), __expf(pall[2]), __expf(pall[3])};
        }
        __syncthreads();
        if (wv != 0) {
            const bf16_t* P = (wv & 1) ? sKG : sBG;
            const bf16_t* Q = (wv & 2) ? sRT : sAT;
            f32x4 cg = (f32x4){0.f, 0.f, 0.f, 0.f};
#pragma unroll
            for (int ks = 0; ks < 2; ++ks) cg = MFMA16(*(const bf16x8*)(P + fr * LDA + ks * 32 + fq * 8), *(const bf16x8*)(Q + fr * LDA + ks * 32 + fq * 8), cg);
#pragma unroll
            for (int r = 0; r < 4; ++r) { const int sidx = fq * 4 + r; const bool keep = (wv & 2) ? (sidx <= fr) : (sidx < fr); if (!keep) cg[r] = 0.f; }
            if (wv == 1) *(u32x2*)(sAKB + fr * LDB + 16 + fq * 4) = pack4(cg[0], cg[1], cg[2], cg[3]);
            else if (wv == 2) *(u32x2*)(sBRK + fr * LDB + fq * 4) = pack4(cg[0], cg[1], cg[2], cg[3]);
            else *(u32x2*)(sBRK + fr * LDB + 16 + fq * 4) = pack4(cg[0], cg[1], cg[2], cg[3]);
        }
        __syncthreads();
        f32x4 x1 = (f32x4){0.f, 0.f, 0.f, 0.f}, yv = x1;
        {
            const bf16x8 s0 = *(const bf16x8*)(sSA + fr * LDA + fq * 8), s1 = *(const bf16x8*)(sSA + fr * LDA + 32 + fq * 8);
            const bf16x8 uv = *(const bf16x8*)(sUV + fr * LDB + fq * 8);
            x1 = MFMA16(s0, *(const bf16x8*)(sAT + fr * LDA + fq * 8), x1);
            x1 = MFMA16(s1, *(const bf16x8*)(sAT + fr * LDA + 32 + fq * 8), x1);
            x1 = MFMA16(uv, *(const bf16x8*)(sAKB + fr * LDB + fq * 8), x1);
            yv = MFMA16(s0, *(const bf16x8*)(sRT + fr * LDA + fq * 8), yv);
            yv = MFMA16(s1, *(const bf16x8*)(sRT + fr * LDA + 32 + fq * 8), yv);
        }
#pragma unroll
        for (int r = 0; r < 4; ++r) sXA[(fq * 4 + r) * LDB + fr] = f2bf(x1[r]);
        asm volatile("s_waitcnt lgkmcnt(0)" ::: "memory");
        f32x4 u = (f32x4){0.f, 0.f, 0.f, 0.f};
        u = MFMA16(*(const bf16x8*)(sXA + fr * LDB + fq * 8), tfrag, u);
#pragma unroll
        for (int r = 0; r < 4; ++r) sUV[(fq * 4 + r) * LDB + fr] = f2bf(u[r]);
        asm volatile("s_waitcnt lgkmcnt(0)" ::: "memory");
        {
            const bf16x8 uv = *(const bf16x8*)(sUV + fr * LDB + fq * 8);
            yv = MFMA16(uv, *(const bf16x8*)(sBRK + fr * LDB + fq * 8), yv);
#pragma unroll
            for (int cb = 0; cb < 4; ++cb) S[cb] = MFMA16(uv, *(const bf16x8*)(sBKT + (cb * 16 + fr) * LDB + fq * 8), S[cb]);
        }
        if (MODE == MS_FINAL) *(u32x2*)(YS + (size_t)(tokb + c * 16 + fr) * 1024 + hh * 64 + wv * 16 + fq * 4) = pack4(yv[0], yv[1], yv[2], yv[3]);
#pragma unroll
        for (int cb = 0; cb < 4; ++cb) {
            const float g15 = sG15[cb * 16 + fr];
#pragma unroll
            for (int r = 0; r < 4; ++r) { S[cb][r] *= g15; sSA[(fq * 4 + r) * LDA + cb * 16 + fr] = f2bf(S[cb][r]); }
        }
    }
    if (MODE != MS_FINAL) {
        float* dst = FS + (size_t)(seg * 2 + (MODE == MS_IDENT ? 1 : 0)) * 4096;
#pragma unroll
        for (int cb = 0; cb < 4; ++cb)
#pragma unroll
            for (int r = 0; r < 4; ++r) dst[(size_t)(wv * 16 + fq * 4 + r) * 64 + cb * 16 + fr] = S[cb][r];
    }
}
constexpr int N_MS1 = 32 * (1 + 2 * (MSEG - 2)), N_MS2 = 32 * MSEG;
DI void ms_item_pass1(const Params& p, int l, int it, char* lds) {
    const int bh = it & 31, k = it >> 5;
    if (k & 1) scan_mfma_block<MS_IDENT>(p, l, bh >> 4, bh & 15, (k + 1) >> 1, lds);
    else scan_mfma_block<MS_DATA1>(p, l, bh >> 4, bh & 15, k >> 1, lds);
}
DI void ms_item_pass2(const Params& p, int l, int it, char* lds) {
    const int bh = it & 31, seg = it >> 5;
    scan_mfma_block<MS_FINAL>(p, l, bh >> 4, bh & 15, seg, lds);
}

constexpr int ATT_LDK = 72;
DI void attn_unit(const Params& p, int l, int unit, char* lds) {
    const int tid = threadIdx.x, lane = tid & 63, wid = tid >> 6, c = wid >> 1, qs = wid & 1, r32 = lane & 31, h = lane >> 5;
    const int qb = 127 - (unit >> 4), bh = unit & 15, hh = bh & 7, b = bh >> 3;
    const bf16_t* Qg = (const bf16_t*)(p.ws + OFF_Q);
    const bf16_t* Kg = (const bf16_t*)(p.ws + OFF_K);
    const bf16_t* VTg = (const bf16_t*)(p.ws + OFF_VT) + (size_t)bh * 128 * 8192;
    const int query = qb * 64 + qs * 32 + r32;
    bf16x8 qf[4];
#pragma unroll
    for (int ks = 0; ks < 4; ++ks) qf[ks] = *(const bf16x8*)(Qg + ((size_t)(bh * 2 + c) * SEQ + query) * 64 + ks * 16 + h * 8);
    auto issue = [&](int kt) {
        char* st = lds + (kt & 1) * 32768 + tid * 16;
#pragma unroll
        for (int i = 0; i < 4; ++i) {
            const int bb = tid * 16 + i * 4096, cm = bb >> 13, row = (bb >> 7) & 63, kc = ((bb >> 4) & 7) ^ ((row >> 1) & 7);
            __builtin_amdgcn_global_load_lds((const unsigned*)(Kg + ((size_t)(bh * 2 + cm) * SEQ + kt * 64 + row) * 64 + kc * 8), (LDSP unsigned*)(st + i * 4096), 16, 0, 0);
            __builtin_amdgcn_global_load_lds((const unsigned*)(VTg + (size_t)kt * 8192 + (tid + 256 * i) * 8), (LDSP unsigned*)(st + 16384 + i * 4096), 16, 0, 0);
        }
    };
    f32x16 O[4];
#pragma unroll
    for (int d = 0; d < 4; ++d)
#pragma unroll
        for (int e = 0; e < 16; ++e) O[d][e] = 0.f;
    float m_run = -INFINITY, lsum = 0.f;
    const int kswz = (r32 >> 1) & 7;
    issue(0);
    for (int kt = 0; kt <= qb; ++kt) {
        asm volatile("s_waitcnt vmcnt(0)" ::: "memory");
        __syncthreads();
        if (kt < qb) issue(kt + 1);
        const char* sKb = lds + (kt & 1) * 32768;
        const bf16_t* sVT = (const bf16_t*)(sKb + 16384);
        f32x16 st[2];
#pragma unroll
        for (int kb = 0; kb < 2; ++kb) {
#pragma unroll
            for (int e = 0; e < 16; ++e) st[kb][e] = 0.f;
#pragma unroll
            for (int ks = 0; ks < 4; ++ks) {
                const bf16x8 kf = *(const bf16x8*)(sKb + (c * 64 + kb * 32 + r32) * 128 + (((ks * 2 + h) ^ kswz) << 4));
                st[kb] = MFMA32(kf, qf[ks], st[kb]);
            }
        }
        if (kt == qb) {
            const int ql = qs * 32 + r32;
#pragma unroll
            for (int kb = 0; kb < 2; ++kb)
#pragma unroll
                for (int e = 0; e < 16; ++e) { const int keyl = kb * 32 + (e & 3) + 8 * (e >> 2) + 4 * h; if (keyl > ql) st[kb][e] = -INFINITY; }
        }
        float mx = st[0][0];
#pragma unroll
        for (int kb = 0; kb < 2; ++kb)
#pragma unroll
            for (int e = 0; e < 16; ++e) mx = fmaxf(mx, st[kb][e]);
        mx = fmaxf(mx, __shfl_xor(mx, 32));
        if (__any(mx > m_run + 8.0f)) {
            const float mnew = fmaxf(m_run, mx);
            const float alpha = __builtin_amdgcn_exp2f(m_run - mnew);
            m_run = mnew;
            lsum *= alpha;
#pragma unroll
            for (int d = 0; d < 4; ++d)
#pragma unroll
                for (int e = 0; e < 16; ++e) O[d][e] *= alpha;
        }
        float ps = 0.f;
#pragma unroll
        for (int kb = 0; kb < 2; ++kb)
#pragma unroll
            for (int e = 0; e < 16; ++e) { st[kb][e] = __builtin_amdgcn_exp2f(st[kb][e] - m_run); ps += st[kb][e]; }
        lsum += ps;
        bf16x8 pf[2][2];
#pragma unroll
        for (int kb = 0; kb < 2; ++kb)
#pragma unroll
            for (int s = 0; s < 2; ++s) {
                u32x4 pk;
                pk.x = pk2(st[kb][8 * s + 0], st[kb][8 * s + 1]); pk.y = pk2(st[kb][8 * s + 2], st[kb][8 * s + 3]);
                pk.z = pk2(st[kb][8 * s + 4], st[kb][8 * s + 5]); pk.w = pk2(st[kb][8 * s + 6], st[kb][8 * s + 7]);
                pf[kb][s] = __builtin_bit_cast(bf16x8, pk);
            }
#pragma unroll
        for (int d = 0; d < 4; ++d)
#pragma unroll
            for (int kb = 0; kb < 2; ++kb)
#pragma unroll
                for (int s = 0; s < 2; ++s) {
                    const bf16x8 vf = *(const bf16x8*)(sVT + (((d * 2 + kb) * 2 + s) * 64 + lane) * 8);
                    O[d] = MFMA32(vf, pf[kb][s], O[d]);
                }
    }
    const float ltot = lsum + __shfl_xor(lsum, 32);
    const float inv = 1.0f / ltot;
    float* xo = (float*)lds;
    __syncthreads();
    if (c == 1) {
#pragma unroll
        for (int d = 0; d < 4; ++d)
#pragma unroll
            for (int e = 0; e < 16; ++e) xo[(qs * 64 + d * 16 + e) * 64 + lane] = O[d][e] * inv;
    }
    __syncthreads();
    if (c == 0) {
        const float lam = ((const float*)(p.ws + OFF_CTRL + CT_LAM))[l];
        const float lam_init = 0.8f - 0.6f * expf(-0.3f * (float)l);
        float ss = 0.f;
#pragma unroll
        for (int d = 0; d < 4; ++d)
#pragma unroll
            for (int e = 0; e < 16; ++e) { const float o = O[d][e] * inv - lam * xo[(qs * 64 + d * 16 + e) * 64 + lane]; O[d][e] = o; ss += o * o; }
        ss += __shfl_xor(ss, 32);
        const float rstd = rsqrtf(ss * (1.0f / 128.0f) + 1e-6f) * (1.0f - lam_init);
        bf16_t* outp = (bf16_t*)(p.ws + OFF_ATTP) + (size_t)(b * SEQ + query) * 1024 + hh * 128;
        const float* hg = (const float*)p.in[I_AHG] + (size_t)(l * 8 + hh) * 128;
#pragma unroll
        for (int d = 0; d < 4; ++d)
#pragma unroll
            for (int g4 = 0; g4 < 4; ++g4) {
                const int dv0 = d * 32 + 8 * g4 + 4 * h;
                const f32x4 g = *(const f32x4*)(hg + dv0);
                *(u32x2*)(outp + dv0) = pack4(O[d][g4 * 4 + 0] * rstd * g[0], O[d][g4 * 4 + 1] * rstd * g[1], O[d][g4 * 4 + 2] * rstd * g[2], O[d][g4 * 4 + 3] * rstd * g[3]);
            }
    }
}

DI void rwkv_post_tile(const Params& p, int l, int tile, char* lds) {
    const int tid = threadIdx.x, lane = tid & 63, wv = tid >> 6, fr = lane & 15, fq = lane >> 4, t0 = tile * 16, n4 = tid * 4;
    const bf16_t* ZR = (const bf16_t*)(p.ws + OFF_ZR);
    const bf16_t* Ab = (const bf16_t*)(p.ws + OFF_A);
    const bf16_t* YS = (const bf16_t*)(p.ws + OFF_YS);
    const float* mu = (const float*)p.in[I_MU] + (size_t)l * RWKV_LD;
    constexpr int LDSG = 136, LDG = 1028;
    bf16_t* sgb = (bf16_t*)lds;
    bf16_t* gL = (bf16_t*)(lds + 8192);
    __syncthreads();
    {
        const int tk = tid >> 4, c8 = (tid & 15) * 8;
        float z[8]; zr_shift8(ZR, mu, t0 + tk, 3200 + c8, z);
        u32x4 w;
        w.x = pk2(sigmoidf_(z[0]), sigmoidf_(z[1])); w.y = pk2(sigmoidf_(z[2]), sigmoidf_(z[3])); w.z = pk2(sigmoidf_(z[4]), sigmoidf_(z[5])); w.w = pk2(sigmoidf_(z[6]), sigmoidf_(z[7]));
        *(u32x4*)(sgb + tk * LDSG + c8) = w;
    }
    __syncthreads();
    {
        bf16x8 xf[4];
#pragma unroll
        for (int ks = 0; ks < 4; ++ks) xf[ks] = *(const bf16x8*)(sgb + fr * LDSG + ks * 32 + fq * 8);
        const bf16_t* g2t = (const bf16_t*)(p.ws + OFF_W + W_G2T) + (size_t)(wv * 256 + fr) * 128 + fq * 8;
#pragma unroll 4
        for (int nb = 0; nb < 16; ++nb) {
            f32x4 acc = (f32x4){0.f, 0.f, 0.f, 0.f};
#pragma unroll
            for (int ks = 0; ks < 4; ++ks) acc = MFMA16(*(const bf16x8*)(g2t + (size_t)nb * 16 * 128 + ks * 32), xf[ks], acc);
            *(u32x2*)(gL + fr * LDG + wv * 256 + nb * 16 + fq * 4) = pack4(acc[0], acc[1], acc[2], acc[3]);
        }
    }
    __syncthreads();
    const f32x4 kav = *(const f32x4*)((const float*)p.in[I_KA] + l * 1024 + n4);
    const f32x4 rkv = *(const f32x4*)((const float*)p.in[I_RK] + l * 1024 + n4);
    const f32x4 gng = *(const f32x4*)((const float*)p.in[I_GNG] + l * 1024 + n4);
    const f32x4 gnb = *(const f32x4*)((const float*)p.in[I_GNB] + l * 1024 + n4);
    bf16_t* out = (bf16_t*)(p.ws + OFF_RWKVP);
#pragma unroll
    for (int t = 0; t < 16; ++t) {
        const int tok = t0 + t;
        float r[4], k[4], v[4], a[4], y[4];
        zr_shift4(ZR, mu, tok, n4, r); zr_shift4(ZR, mu, tok, 1024 + n4, k); zr_shift4(ZR, mu, tok, 2048 + n4, v);
        unpack4(*(const u32x2*)(Ab + (size_t)tok * 1024 + n4), a);
        unpack4(*(const u32x2*)(YS + (size_t)tok * 1024 + n4), y);
        float gt[4]; unpack4(*(const u32x2*)(gL + t * LDG + n4), gt);
        float cf = 0.f, s1 = 0.f, s2 = 0.f;
#pragma unroll
        for (int e = 0; e < 4; ++e) { const float kn = k[e] * (1.0f + (a[e] - 1.0f) * kav[e]); cf += r[e] * kn * rkv[e]; s1 += y[e]; s2 += y[e] * y[e]; }
        cf = row16_sum(cf); s1 = row16_sum(s1); s2 = row16_sum(s2);
        const float mean = s1 * (1.0f / 64.0f), var = fmaxf(s2 * (1.0f / 64.0f) - mean * mean, 0.f), rstd = rsqrtf(var + 64e-5f);
        float o[4];
#pragma unroll
        for (int e = 0; e < 4; ++e) o[e] = ((y[e] - mean) * rstd * gng[e] + gnb[e] + cf * v[e]) * gt[e];
        *(u32x2*)(out + (size_t)tok * 1024 + n4) = pack4(o[0], o[1], o[2], o[3]);
    }
}

DI void phaseF_tile(const Params& p, int mt, int nt, char* lds) {
    const int tid = threadIdx.x, lane = tid & 63, wid = tid >> 6, wm = wid >> 1, wn = wid & 1, fr = lane & 15, fq = lane >> 4;
    const int m0 = mt * 128 + wm * 64, nb = nt * 128 + wn * 64;
    const bf16_t* ZG = (const bf16_t*)(p.ws + OFF_ZG);
    f32x4 sum[4][4]; zero_acc(sum);
#pragma unroll 1
    for (int br = 0; br < 3; ++br) {
        const size_t xoff = br == 0 ? OFF_ATTP : br == 1 ? OFF_CONVP : OFF_RWKVP;
        const size_t woff = br == 0 ? W_ATTO : br == 1 ? W_CONVO : W_RWKVO;
        f32x4 acc[4][4]; zero_acc(acc);
        gemm_mainloop<false>(acc, (const bf16_t*)(p.ws + xoff) + (size_t)mt * 128 * 1024, 1024, (const bf16_t*)(p.ws + OFF_W + woff) + (size_t)nt * 128 * 1024, 1024, 1024, lds);
#pragma unroll
        for (int ti = 0; ti < 4; ++ti) {
            const int tok = m0 + ti * 16 + fr;
#pragma unroll
            for (int ni = 0; ni < 4; ++ni) {
                float g[4]; unpack4(*(const u32x2*)(ZG + (size_t)tok * ZG_LD + br * 1024 + nb + ni * 16 + fq * 4), g);
#pragma unroll
                for (int r = 0; r < 4; ++r) sum[ti][ni][r] += g[r] * acc[ti][ni][r];
            }
        }
    }
    bf16_t* out = (bf16_t*)(p.ws + OFF_MERGED);
#pragma unroll
    for (int ti = 0; ti < 4; ++ti) {
        const int tok = m0 + ti * 16 + fr;
#pragma unroll
        for (int ni = 0; ni < 4; ++ni)
            *(u32x2*)(out + (size_t)tok * 1024 + nb + ni * 16 + fq * 4) = pack4(sum[ti][ni][0], sum[ti][ni][1], sum[ti][ni][2], sum[ti][ni][3]);
    }
}
DI void phaseG_tile(const Params& p, int l, int mt, int nt, char* lds) {
    const int tid = threadIdx.x, lane = tid & 63, wid = tid >> 6, wm = wid >> 1, wn = wid & 1, fr = lane & 15, fq = lane >> 4;
    const int m0 = mt * 128 + wm * 64, nb = nt * 128 + wn * 64;
    f32x4 acc[4][4]; zero_acc(acc);
    gemm_mainloop<false>(acc, (const bf16_t*)(p.ws + OFF_MERGED) + (size_t)mt * 128 * 1024, 1024, (const bf16_t*)(p.ws + OFF_W + W_OUT) + (size_t)nt * 128 * 1024, 1024, 1024, lds);
    const float* xin = l == 0 ? (const float*)p.in[I_X] : p.out;
    const float* ada = (const float*)(p.ws + OFF_CTRL + CT_ADA) + (size_t)l * 2 * 6144;
#pragma unroll
    for (int ti = 0; ti < 4; ++ti) {
        const int tok = m0 + ti * 16 + fr, b = tok >> 13;
#pragma unroll
        for (int ni = 0; ni < 4; ++ni) {
            const int n = nb + ni * 16 + fq * 4;
            const f32x4 xv = *(const f32x4*)(xin + (size_t)tok * 1024 + n), gt = *(const f32x4*)(ada + b * 6144 + 2 * 1024 + n);
            *(f32x4*)(p.out + (size_t)tok * 1024 + n) = xv + (1.0f + gt) * acc[ti][ni];
        }
    }
}
DI void phaseI_tile(const Params& p, int mt, int nt, char* lds) {
    const int tid = threadIdx.x, lane = tid & 63, wid = tid >> 6, wm = wid >> 1, wn = wid & 1, fr = lane & 15, fq = lane >> 4;
    const int m0 = mt * 128 + wm * 64, nb = nt * 128 + wn * 64;
    f32x4 acc[4][4]; zero_acc(acc);
    gemm_mainloop<false>(acc, (const bf16_t*)(p.ws + OFF_H) + (size_t)mt * 128 * 1024, 1024, (const bf16_t*)(p.ws + OFF_W + W_QP) + (size_t)nt * 128 * 1024, 1024, 1024, lds);
    bf16_t* out = (bf16_t*)(p.ws + OFF_QP);
#pragma unroll
    for (int ti = 0; ti < 4; ++ti) {
        const int tok = m0 + ti * 16 + fr;
#pragma unroll
        for (int ni = 0; ni < 4; ++ni)
            *(u32x2*)(out + (size_t)tok * 2048 + nb + ni * 16 + fq * 4) = pack4(acc[ti][ni][0], acc[ti][ni][1], acc[ti][ni][2], acc[ti][ni][3]);
    }
}
DI void phaseJ_tile(const Params& p, int mt, int g, char* lds) {
    const int tid = threadIdx.x, lane = tid & 63, wid = tid >> 6, wm = wid >> 1, wn = wid & 1, fr = lane & 15, fq = lane >> 4;
    const int m0 = mt * 128 + wm * 64, nb = wn * 64;
    f32x4 acc[4][4]; zero_acc(acc);
    gemm_mainloop<true>(acc, (const bf16_t*)(p.ws + OFF_QP) + (size_t)mt * 128 * 2048 + g * 128, 2048, (const bf16_t*)(p.ws + OFF_W + ((g & 1) ? W_KEY2 : W_KEY1)), 128, 128, lds);
    float* out = (float*)(p.ws + OFF_SCORES);
#pragma unroll
    for (int ni = 0; ni < 4; ++ni) {
        const int n = nb + ni * 16 + fr;
#pragma unroll
        for (int ti = 0; ti < 4; ++ti) *(f32x4*)(out + (size_t)(g * 128 + n) * NT + m0 + ti * 16 + fq * 4) = acc[ti][ni];
    }
}

DI void phaseIJ_tile(const Params& p, int mt, int g, char* lds) {
    const int tid = threadIdx.x, lane = tid & 63, wid = tid >> 6, wm = wid >> 1, wn = wid & 1, fr = lane & 15, fq = lane >> 4;
    f32x4 acc[4][4]; zero_acc(acc);
    gemm_mainloop<false>(acc, (const bf16_t*)(p.ws + OFF_H) + (size_t)mt * 128 * 1024, 1024, (const bf16_t*)(p.ws + OFF_W + W_QP) + (size_t)g * 128 * 1024, 1024, 1024, lds);
    const int swz = (fr >> 1) & 7;
    __syncthreads();
#pragma unroll
    for (int ti = 0; ti < 4; ++ti) {
        const int row = wm * 64 + ti * 16 + fr;
#pragma unroll
        for (int ni = 0; ni < 4; ++ni)
            *(u32x2*)(lds + wn * GEMM_STAGE + row * 128 + (((ni * 2 + (fq >> 1)) ^ swz) << 4) + (fq & 1) * 8) = pack4(acc[ti][ni][0], acc[ti][ni][1], acc[ti][ni][2], acc[ti][ni][3]);
    }
    {
        const bf16_t* gw = (const bf16_t*)(p.ws + OFF_W + ((g & 1) ? W_KEY2 : W_KEY1)) + (size_t)(tid >> 3) * 128 + (((tid & 7) ^ ((tid >> 4) & 7)) * 8);
#pragma unroll
        for (int st = 0; st < 2; ++st)
#pragma unroll
            for (int i = 0; i < 4; ++i)
                __builtin_amdgcn_global_load_lds((const unsigned*)(gw + (size_t)(32 * i) * 128 + st * 64), (LDSP unsigned*)(lds + st * GEMM_STAGE + 16384 + tid * 16 + i * 4096), 16, 0, 0);
    }
    asm volatile("s_waitcnt vmcnt(0) lgkmcnt(0)" ::: "memory");
    __syncthreads();
    f32x4 sc[4][4]; zero_acc(sc);
#pragma unroll
    for (int kt = 0; kt < 2; ++kt) {
        const char* sx = lds + kt * GEMM_STAGE;
        const char* sw = sx + 16384;
#pragma unroll
        for (int ks = 0; ks < 2; ++ks) {
            const int cb = ((ks * 4 + fq) ^ swz) << 4;
            bf16x8 xf[4], wf[4];
#pragma unroll
            for (int i = 0; i < 4; ++i) {
                xf[i] = *(const bf16x8*)(sx + (wm * 64 + i * 16 + fr) * 128 + cb);
                wf[i] = *(const bf16x8*)(sw + (wn * 64 + i * 16 + fr) * 128 + cb);
            }
#pragma unroll
            for (int ti = 0; ti < 4; ++ti)
#pragma unroll
                for (int ni = 0; ni < 4; ++ni) sc[ti][ni] = MFMA16(xf[ti], wf[ni], sc[ti][ni]);
        }
    }
    asm volatile("" ::: "memory");
    __builtin_amdgcn_sched_barrier(0);
    const int m0 = mt * 128 + wm * 64, nb = wn * 64;
    float* out = (float*)(p.ws + OFF_SCORES);
#pragma unroll
    for (int ni = 0; ni < 4; ++ni) {
        const int n = nb + ni * 16 + fr;
#pragma unroll
        for (int ti = 0; ti < 4; ++ti) *(f32x4*)(out + (size_t)(g * 128 + n) * NT + m0 + ti * 16 + fq * 4) = sc[ti][ni];
    }
}

DI void ins16(float (&a)[16], float x) {
#pragma unroll
    for (int i = 0; i < 16; ++i) { const float t = fmaxf(a[i], x); x = fminf(a[i], x); a[i] = t; }
}
DI void topk_thread(const Params& p, int idx) {
    const int hd = idx >> 14, t = idx & (NT - 1);
    const float* s1 = (const float*)(p.ws + OFF_SCORES) + (size_t)(hd * 256) * NT + t;
    const float* s2 = s1 + (size_t)128 * NT;
    float a[16], b[16], c[16];
#pragma unroll
    for (int i = 0; i < 16; ++i) { a[i] = -INFINITY; b[i] = -INFINITY; c[i] = -INFINITY; }
#pragma unroll 8
    for (int n = 0; n < 128; ++n) {
        const float x1 = __uint_as_float((__float_as_uint(s1[(size_t)n * NT]) & 0xFFFFFF80u) | (unsigned)(127 - n));
        const float x2 = __uint_as_float((__float_as_uint(s2[(size_t)n * NT]) & 0xFFFFFF80u) | (unsigned)(127 - n));
        ins16(a, x1); ins16(b, x2);
    }
    float v1[16], v2[16]; int i1[16], i2[16];
#pragma unroll
    for (int i = 0; i < 16; ++i) {
        const unsigned ua = __float_as_uint(a[i]), ub = __float_as_uint(b[i]);
        v1[i] = __uint_as_float(ua & 0xFFFFFF80u); i1[i] = 127 - (int)(ua & 127u);
        v2[i] = __uint_as_float(ub & 0xFFFFFF80u); i2[i] = 127 - (int)(ub & 127u);
    }
#pragma unroll
    for (int i = 0; i < 16; ++i)
#pragma unroll
        for (int j = 0; j < 16; ++j)
            if ((i + 1) * (j + 1) <= 16) ins16(c, __uint_as_float((__float_as_uint(v1[i] + v2[j]) & 0xFFFFFF00u) | (unsigned)(255 - (i * 16 + j))));
    float tv[16]; int eid[16];
#pragma unroll
    for (int r = 0; r < 16; ++r) {
        const unsigned u = __float_as_uint(c[r]);
        tv[r] = __uint_as_float(u & 0xFFFFFF00u);
        const int flat = 255 - (int)(u & 255u), ii = flat >> 4, jj = flat & 15;
        int e1 = 0, e2 = 0;
#pragma unroll
        for (int i = 0; i < 16; ++i) { e1 = (ii == i) ? i1[i] : e1; e2 = (jj == i) ? i2[i] : e2; }
        eid[r] = e1 * 128 + e2;
    }
    float sm = 0.f;
    const float mx = tv[0];
#pragma unroll
    for (int r = 0; r < 16; ++r) { tv[r] = __expf(tv[r] - mx); sm += tv[r]; }
    const float inv = 1.0f / sm;
    int* ep = (int*)(p.ws + OFF_EID) + (size_t)t * 128 + hd * 16;
    float* gp = (float*)(p.ws + OFF_GATE) + (size_t)t * 128 + hd * 16;
#pragma unroll
    for (int q = 0; q < 4; ++q) {
        *(u32x4*)(ep + q * 4) = (u32x4){(unsigned)eid[q * 4], (unsigned)eid[q * 4 + 1], (unsigned)eid[q * 4 + 2], (unsigned)eid[q * 4 + 3]};
        *(f32x4*)(gp + q * 4) = (f32x4){tv[q * 4] * inv, tv[q * 4 + 1] * inv, tv[q * 4 + 2] * inv, tv[q * 4 + 3] * inv};
    }
}

DI void cvt_u8x4(unsigned w, float (&f)[4]) { f[0] = (float)(w & 255u); f[1] = (float)((w >> 8) & 255u); f[2] = (float)((w >> 16) & 255u); f[3] = (float)(w >> 24); }
DI float gelu_zs(float v) {
    const float av = fabsf(v), t = __builtin_amdgcn_rcpf(av * 0.2316418882f + 1.0f);
    float q = t * 0.5307027145f + (-0.7265760135f); q = q * t + 0.7107068705f; q = q * t + (-0.142248368f); q = q * t + 0.127414796f; q = q * t;
    const float e = __builtin_amdgcn_exp2f(v * v * (-0.72134752044f));
    const float m = v * (q * e);
    return v < 0.f ? m : v - m;
}
DI void peer_token(const Params& p, int l, int t) {
    const int lane = threadIdx.x & 63, b = t >> 13;
    const unsigned char* U = (const unsigned char*)(p.ws + OFF_PU8);
    const unsigned char* V = (const unsigned char*)(p.ws + OFF_PV8);
    const float* SU = (const float*)(p.ws + OFF_PSU);
    const float* SV = (const float*)(p.ws + OFF_PSV);
    bf16_t* H = (bf16_t*)(p.ws + OFF_H);
    int hq[4]; float sh;
    {
        float hv[16]; float f[8];
        unpack8(*(const u32x4*)(H + (size_t)t * 1024 + lane * 16), f); for (int e = 0; e < 8; ++e) hv[e] = f[e];
        unpack8(*(const u32x4*)(H + (size_t)t * 1024 + lane * 16 + 8), f); for (int e = 0; e < 8; ++e) hv[8 + e] = f[e];
        float am = 0.f;
#pragma unroll
        for (int e = 0; e < 16; ++e) am = fmaxf(am, fabsf(hv[e]));
        am = wave_max(am);
        sh = am > 0.f ? am * (1.0f / 127.0f) : 1.0f;
        const float ish = am > 0.f ? 127.0f / am : 0.f;
#pragma unroll
        for (int q = 0; q < 4; ++q) {
            unsigned w = 0;
#pragma unroll
            for (int e = 0; e < 4; ++e) w |= ((unsigned)(int)rintf(hv[q * 4 + e] * ish) & 255u) << (8 * e);
            hq[q] = (int)w;
        }
    }
    const int* eidp = (const int*)(p.ws + OFF_EID) + (size_t)t * 128;
    const float* gatep = (const float*)(p.ws + OFF_GATE) + (size_t)t * 128;
    const int id0 = eidp[lane], id1 = eidp[64 + lane];
    const float g0 = gatep[lane], g1 = gatep[64 + lane];
    const float su0 = SU[id0] * sh, su1 = SU[id1] * sh, gs0 = g0 * SV[id0], gs1 = g1 * SV[id1];
    float acc[16], csum = 0.f;
#pragma unroll
    for (int e = 0; e < 16; ++e) acc[e] = 0.f;
    const int eidx = lane >> 3;
    const bool hi32 = (lane & 32) != 0, hi16 = (lane & 16) != 0, hi8 = (lane & 8) != 0;
#pragma unroll 1
    for (int g = 0; g < 16; ++g) {
        const int jbase = (g & 7) * 8;
        const int idr = (g & 8) ? id1 : id0; const float sur = (g & 8) ? su1 : su0, gsr = (g & 8) ? gs1 : gs0;
        u32x4 uq[8], vq[8];
#pragma unroll
        for (int e = 0; e < 8; ++e) {
            const int id = __builtin_amdgcn_readlane(idr, jbase + e);
            uq[e] = *(const u32x4*)(U + (size_t)id * 1024 + lane * 16);
            vq[e] = *(const u32x4*)(V + (size_t)id * 1024 + lane * 16);
        }
        float d[8];
#pragma unroll
        for (int e = 0; e < 8; ++e) {
            int sdot = __builtin_amdgcn_sdot4((int)uq[e].x, hq[0], 0, false);
            sdot = __builtin_amdgcn_sdot4((int)uq[e].y, hq[1], sdot, false);
            sdot = __builtin_amdgcn_sdot4((int)uq[e].z, hq[2], sdot, false);
            sdot = __builtin_amdgcn_sdot4((int)uq[e].w, hq[3], sdot, false);
            d[e] = (float)sdot;
        }
        float r4[4], r2[2];
#pragma unroll
        for (int i = 0; i < 4; ++i) { const float keep = hi32 ? d[4 + i] : d[i], send = hi32 ? d[i] : d[4 + i]; r4[i] = keep + __shfl_xor(send, 32); }
#pragma unroll
        for (int i = 0; i < 2; ++i) { const float keep = hi16 ? r4[2 + i] : r4[i], send = hi16 ? r4[i] : r4[2 + i]; r2[i] = keep + __shfl_xor(send, 16); }
        float r1;
        { const float keep = hi8 ? r2[1] : r2[0], send = hi8 ? r2[0] : r2[1]; r1 = keep + __shfl_xor(send, 8); }
        r1 = row8_sum(r1);
        const float dotv = r1 * __shfl(sur, jbase + eidx);
        const float ccl = gelu_zs(dotv) * __shfl(gsr, jbase + eidx);
#pragma unroll
        for (int e = 0; e < 8; ++e) {
            const float cc = __int_as_float(__builtin_amdgcn_readlane(__float_as_int(ccl), e * 8));
            csum += cc;
            float f[4];
            cvt_u8x4(vq[e].x, f); acc[0] += cc * f[0]; acc[1] += cc * f[1]; acc[2] += cc * f[2]; acc[3] += cc * f[3];
            cvt_u8x4(vq[e].y, f); acc[4] += cc * f[0]; acc[5] += cc * f[1]; acc[6] += cc * f[2]; acc[7] += cc * f[3];
            cvt_u8x4(vq[e].z, f); acc[8] += cc * f[0]; acc[9] += cc * f[1]; acc[10] += cc * f[2]; acc[11] += cc * f[3];
            cvt_u8x4(vq[e].w, f); acc[12] += cc * f[0]; acc[13] += cc * f[1]; acc[14] += cc * f[2]; acc[15] += cc * f[3];
        }
    }
#pragma unroll
    for (int e = 0; e < 16; ++e) acc[e] -= 128.0f * csum;
    const float* ada = (const float*)(p.ws + OFF_CTRL + CT_ADA) + (size_t)(l * 2 + b) * 6144;
    float xv[16], ss = 0.f;
#pragma unroll
    for (int q = 0; q < 4; ++q) {
        const int n = lane * 16 + q * 4;
        const f32x4 x1 = *(const f32x4*)(p.out + (size_t)t * 1024 + n), gt = *(const f32x4*)(ada + 5 * 1024 + n);
#pragma unroll
        for (int e = 0; e < 4; ++e) { const float x2 = x1[e] + (1.0f + gt[e]) * acc[q * 4 + e]; xv[q * 4 + e] = x2; ss += x2 * x2; }
    }
    ss = wave_sum(ss);
    const float rstd = rsqrtf(ss * (1.0f / 1024.0f) + 1e-6f);
    if (l + 1 < DEPTH) {
        const float* ada2 = (const float*)(p.ws + OFF_CTRL + CT_ADA) + (size_t)((l + 1) * 2 + b) * 6144;
        const float* g1n = (const float*)p.in[I_N1G] + (size_t)(l + 1) * 1024;
        float o[16];
#pragma unroll
        for (int q = 0; q < 4; ++q) {
            const int n = lane * 16 + q * 4;
            const f32x4 g = *(const f32x4*)(g1n + n), sh = *(const f32x4*)(ada2 + n), sc = *(const f32x4*)(ada2 + 1024 + n);
            *(f32x4*)(p.out + (size_t)t * 1024 + n) = (f32x4){xv[q * 4], xv[q * 4 + 1], xv[q * 4 + 2], xv[q * 4 + 3]};
#pragma unroll
            for (int e = 0; e < 4; ++e) o[q * 4 + e] = xv[q * 4 + e] * rstd * g[e] * (1.0f + sc[e]) + sh[e];
        }
        u32x4 w0, w1;
        w0.x = pk2(o[0], o[1]); w0.y = pk2(o[2], o[3]); w0.z = pk2(o[4], o[5]); w0.w = pk2(o[6], o[7]);
        w1.x = pk2(o[8], o[9]); w1.y = pk2(o[10], o[11]); w1.z = pk2(o[12], o[13]); w1.w = pk2(o[14], o[15]);
        *(u32x4*)(H + (size_t)t * 1024 + lane * 16) = w0; *(u32x4*)(H + (size_t)t * 1024 + lane * 16 + 8) = w1;
    } else {
        const float* fg = (const float*)p.in[I_FG];
#pragma unroll
        for (int q = 0; q < 4; ++q) {
            const int n = lane * 16 + q * 4;
            const f32x4 g = *(const f32x4*)(fg + n);
            f32x4 o;
#pragma unroll
            for (int e = 0; e < 4; ++e) o[e] = xv[q * 4 + e] * rstd * g[e];
            *(f32x4*)(p.out + (size_t)t * 1024 + n) = o;
        }
    }
}

#define XB_TMO      128
#define XB_XCNT(j)  (256  + 64 * (j))
#define XB_XSUB(j)  (1280 + 64 * (j))
#define XB_XGEN(j)  (2304 + 64 * (j))
#define XB_TOP      3328
#define XB_TOPGEN   3392
#define XCD_BAR_WORDS 3456
#define XB_SPIN_CAP (1u << 18)
#define LAS __attribute__((address_space(3)))
DI unsigned xb_ld(unsigned* q)              { return __hip_atomic_load(q, __ATOMIC_RELAXED, __HIP_MEMORY_SCOPE_AGENT); }
DI unsigned xb_add(unsigned* q, unsigned v) { return __hip_atomic_fetch_add(q, v, __ATOMIC_RELAXED, __HIP_MEMORY_SCOPE_AGENT); }
DI unsigned xb_xcc_id() { return (unsigned)__builtin_amdgcn_s_getreg((3 << 11) | 20) & 0xFu; }
#define XB_SPIN(cond, bar) do { unsigned _sp = 0; while (cond) { __builtin_amdgcn_s_sleep(1); \
    if ((++_sp & 255u) == 0u) { if (xb_ld(&(bar)[XB_TMO])) break; if (_sp > XB_SPIN_CAP) { atomicAdd(&(bar)[XB_TMO], 1u); break; } } } } while (0)
struct XcdBarrier { unsigned* bar; unsigned x; volatile LAS unsigned* st; };
DI XcdBarrier xcd_barrier_post(unsigned* bar, volatile LAS unsigned* st) {
    XcdBarrier b; b.bar = bar; b.x = xb_xcc_id(); b.st = st;
    if (threadIdx.x == 0) (void)xb_add(&bar[XB_XCNT(b.x)], 1u);
    return b;
}
DI void xcd_barrier_complete(unsigned* bar, unsigned x, unsigned& nloc, unsigned& nx) {
    const unsigned G = gridDim.x * gridDim.y * gridDim.z;
    unsigned sum, cnt, mine, sp = 0u;
    for (;;) {
        sum = 0u; cnt = 0u; mine = 0u;
#pragma unroll
        for (unsigned j = 0; j < 16; ++j) { const unsigned c = xb_ld(&bar[XB_XCNT(j)]); sum += c; cnt += (c > 0u) ? 1u : 0u; mine = (j == x) ? c : mine; }
        if (sum == G) break;
        __builtin_amdgcn_s_sleep(1);
        if ((++sp & 255u) == 0u) { if (xb_ld(&bar[XB_TMO])) break; if (sp > XB_SPIN_CAP) { atomicAdd(&bar[XB_TMO], 1u); break; } }
    }
    nloc = mine > 0u ? mine : 1u; nx = cnt > 0u ? cnt : 1u;
}
DI void xcd_barrier(const XcdBarrier& b) {
    asm volatile("s_waitcnt vmcnt(0)" ::: "memory");
    __syncthreads();
    if (threadIdx.x == 0) {
        unsigned* bar = b.bar;
        __builtin_amdgcn_s_waitcnt(0);
        unsigned nloc = b.st[0], nx = b.st[1];
        if (nloc == 0u) { xcd_barrier_complete(bar, b.x, nloc, nx); b.st[0] = nloc; b.st[1] = nx; }
        const unsigned old = xb_add(&bar[XB_XSUB(b.x)], 1u);
        const unsigned gen = old / nloc;
        if (old + 1u == (gen + 1u) * nloc) {
            __builtin_amdgcn_fence(__ATOMIC_RELEASE, "agent");
            asm volatile("s_waitcnt vmcnt(0)" ::: "memory");
            const unsigned og = xb_add(&bar[XB_TOP], 1u);
            const unsigned tg = og / nx;
            if (og + 1u == (tg + 1u) * nx) xb_add(&bar[XB_TOPGEN], 1u);
            else XB_SPIN(xb_ld(&bar[XB_TOPGEN]) == tg, bar);
            __builtin_amdgcn_fence(__ATOMIC_ACQUIRE, "agent");
            xb_add(&bar[XB_XGEN(b.x)], 1u);
            asm volatile("s_waitcnt vmcnt(0)" ::: "memory");
        } else {
            XB_SPIN(xb_ld(&bar[XB_XGEN(b.x)]) == gen, bar);
            __builtin_amdgcn_fence(__ATOMIC_ACQUIRE, "agent");
            asm volatile("s_waitcnt vmcnt(0)" ::: "memory");
        }
    }
    __syncthreads();
}
constexpr size_t CT_BAR = 16384;

constexpr int LDS_BYTES = 2 * GEMM_STAGE + 64;
constexpr int N_PHASES = 2 + 13 * DEPTH;
constexpr int ATT_U1 = 624;
constexpr int ATT_U0 = 256;
DI void attn_queue(const Params& p, int l, char* lds, int part, int jbase, int jlim) {
    const int tid = threadIdx.x;
    unsigned* cnt = (unsigned*)(p.ws + OFF_CTRL + CT_CNT) + 64 * (l * 3 + part);
    int* s_unit = (int*)(lds + LDS_BYTES - 16);
    if (tid == 0) s_unit[1] = 0;
    for (;;) {
        __syncthreads();
        if (tid == 0) {
            const int myx = (int)(xb_xcc_id() & 7u);
            int unit = -1, qi = s_unit[1];
            while (qi < 8) {
                const int x = (myx + qi) & 7;
                const int j = jbase + (int)atomicAdd(cnt + x * 8, 1u);
                if (j < jlim) { unit = ((j >> 1) << 4) | (x * 2 + (j & 1)); break; }
                ++qi;
            }
            s_unit[0] = unit; s_unit[1] = qi;
        }
        __syncthreads();
        const int unit = s_unit[0];
        if (unit < 0) break;
        attn_unit(p, l, unit, lds);
    }
}

#ifndef MULTI_LAUNCH
#define MULTI_LAUNCH 0
#endif

template <int ph> DI void run_phase(const Params& p, char* lds) {
    const int bid = blockIdx.x, nblk = gridDim.x, tid = threadIdx.x;
    const int gw = bid * 4 + (tid >> 6), nw = nblk * 4;
    const int vb = (nblk == 512) ? (bid % 8) * 64 + ((bid / 8) % 32) * 2 + (bid / 256) : (nblk % 8 == 0) ? (bid % 8) * (nblk / 8) + bid / 8 : bid;
    float* ada = (float*)(p.ws + OFF_CTRL + CT_ADA);
    if (ph == 0) {
        const int total = 192 + 1 + 256 + NCONV_ITEMS / 2;
        for (int it = bid; it < total; it += nblk) {
            if (it < 192) ada_item(p, it, lds);
            else if (it == 192) lam_item(p);
            else if (it < 449) rope_item(p, it - 193);
            else convert_item(p, 0, it - 449, lds);
        }
        return;
    }
    if (ph == 1) {
        norm_rows(p, (const float*)p.in[I_X], (const float*)p.in[I_N1G], ada, ada + 1024, (bf16_t*)(p.ws + OFF_H));
        for (int it = NCONV_ITEMS / 2 + bid; it < NCONV_ITEMS; it += nblk) convert_item(p, 0, it, lds);
        return;
    }
    constexpr int l = (ph - 2) / 13, sub0 = (ph - 2) % 13, sub = sub0 <= 1 ? sub0 : sub0 == 2 ? 100 : sub0 == 3 ? 101 : sub0 <= 5 ? 2 : sub0 <= 10 ? sub0 - 3 : sub0 - 2;
    switch (sub) {
    case 0:
        for (int tile = vb; tile < 128 * 90; tile += nblk) { int mt, nt; tile_coords(tile, 90, mt, nt); phaseB_tile(p, mt, nt, lds); }
        break;
    case 1:
        for (int it = bid; it < 2048; it += nblk) { if (it < 1024) conv_tile(p, l, it, lds); else lora_in_tile(p, l, it - 1024); }
        break;
    case 101:
        for (int it = bid; it < 4096; it += nblk) scan_T_item(p, l, it, lds);
        attn_queue(p, l, lds, 2, 256 - ATT_U0 / 8, 256);
        break;
    case 100:
        for (int tile = vb; tile < 2048; tile += nblk) { int mt, nt; tile_coords(tile & 1023, 8, mt, nt); lora_wa_tile(p, l, tile >> 10, mt, nt, lds); }
        break;
    case 2: {
        const bool second = sub0 == 5;
#if SCAN_MFMA
        if (!second) { for (int it = bid; it < N_MS1; it += nblk) ms_item_pass1(p, l, it, lds); }
        else { for (int it = bid; it < N_MS2; it += nblk) ms_item_pass2(p, l, it, lds); }
#else
        if (!second) { for (int it = bid; it < N_SCAN1; it += nblk) scan_item_pass1(p, l, it, lds); }
        else { for (int it = bid; it < N_SCAN2; it += nblk) scan_item_pass2(p, l, it, lds); }
#endif
        attn_queue(p, l, lds, second ? 1 : 0, second ? ATT_U1 / 8 : 0, second ? 256 - ATT_U0 / 8 : ATT_U1 / 8);
        break; }
    case 3:
        for (int it = bid; it < 1024; it += nblk) rwkv_post_tile(p, l, it, lds);
        break;
    case 4:
        for (int tile = vb; tile < 128 * 8; tile += nblk) { int mt, nt; tile_coords(tile, 8, mt, nt); phaseF_tile(p, mt, nt, lds); }
        break;
    case 5:
        for (int it = vb; it < 1024 + 8192; it += nblk) {
            if (it < 1024) { int mt, nt; tile_coords(it, 8, mt, nt); phaseG_tile(p, l, mt, nt, lds); }
            else convert_uv_item(p, l, it - 1024);
        }
        break;
    case 6:
        norm_rows(p, p.out, (const float*)p.in[I_N2G] + (size_t)l * 1024, ada + (size_t)l * 2 * 6144 + 3 * 1024, ada + (size_t)l * 2 * 6144 + 4 * 1024, (bf16_t*)(p.ws + OFF_H));
        break;
    case 7:
        for (int tile = vb; tile < 128 * 16; tile += nblk) { int mt, nt; tile_coords(tile, 16, mt, nt); phaseIJ_tile(p, mt, nt, lds); }
        break;
    case 8:
        break;
    case 9:
        for (int idx = bid * NTHREADS + tid; idx < NT * 8; idx += nblk * NTHREADS) topk_thread(p, idx);
        if (l + 1 < DEPTH) for (int it = bid; it < NCONV_ITEMS; it += nblk) convert_item(p, l + 1, it, lds);
        break;
    case 10:
        for (int t = gw; t < NT; t += nw) peer_token(p, l, t);
        break;
    }
}

#ifndef PROBE_PH
#define PROBE_PH -1
#endif
#ifndef PROBE_MULT
#define PROBE_MULT 3
#endif
#define PHASE(N) if (p.ph_begin <= N && N < p.ph_end) { unsigned long long pt0 = 0; if (N == PROBE_PH) pt0 = __builtin_amdgcn_s_memrealtime(); run_phase<N>(p, lds); \
    if (N + 1 < p.ph_end) xcd_barrier(xb); \
    if (N == PROBE_PH) { const unsigned long long pt1 = __builtin_amdgcn_s_memrealtime(); while (__builtin_amdgcn_s_memrealtime() - pt1 < PROBE_MULT * (pt1 - pt0)) __builtin_amdgcn_s_sleep(8); __syncthreads(); } }
extern __shared__ __attribute__((aligned(16))) char dyn_lds[];
__global__ void __launch_bounds__(NTHREADS, 2) mega_kernel(Params p) {
    char* lds = dyn_lds;
    volatile LAS unsigned* xst = (volatile LAS unsigned*)(lds + LDS_BYTES - 32);
    if (threadIdx.x == 0) { xst[0] = 0u; xst[1] = 0u; }
    __syncthreads();
    const XcdBarrier xb = xcd_barrier_post((unsigned*)(p.ws + OFF_CTRL + CT_BAR), xst);
    if (p.ph_begin < 0) cg::this_grid().sync();
    PHASE(0) PHASE(1) PHASE(2) PHASE(3) PHASE(4) PHASE(5) PHASE(6) PHASE(7) PHASE(8) PHASE(9) PHASE(10) PHASE(11) PHASE(12) PHASE(13)
    PHASE(14) PHASE(15) PHASE(16) PHASE(17) PHASE(18) PHASE(19) PHASE(20) PHASE(21) PHASE(22) PHASE(23) PHASE(24) PHASE(25) PHASE(26) PHASE(27)
    static_assert(N_PHASES == 28, "phase list");
}

extern "C" void kernel_launch(void* const* d_in, const int* in_sizes, int n_in, void* d_out, int out_size, void* d_ws, size_t ws_size, hipStream_t stream) {
    static int grid_blocks = 0;
    if (!grid_blocks) {
        int dev = 0, cus = 0, per_cu = 0;
        hipGetDevice(&dev);
        hipDeviceGetAttribute(&cus, hipDeviceAttributeMultiprocessorCount, dev);
        hipFuncSetAttribute((const void*)mega_kernel, hipFuncAttributeMaxDynamicSharedMemorySize, LDS_BYTES);
        hipOccupancyMaxActiveBlocksPerMultiprocessor(&per_cu, mega_kernel, NTHREADS, LDS_BYTES);
        if (per_cu > 2) per_cu = 2;
        if (per_cu < 1) per_cu = 1;
        grid_blocks = cus * per_cu;
        if (ws_size < WS_END) fprintf(stderr, "workspace too small: %zu < %zu\n", ws_size, (size_t)WS_END);
    }
    Params p{};
    for (int i = 0; i < N_IN; ++i) p.in[i] = d_in[i];
    p.out = (float*)d_out; p.ws = (char*)d_ws;
    hipMemsetAsync(d_ws, 0, 32768, stream);
#if MULTI_LAUNCH
    for (int ph = 0; ph < N_PHASES; ++ph) {
        p.ph_begin = ph; p.ph_end = ph + 1;
        hipLaunchKernelGGL(mega_kernel, dim3(grid_blocks), dim3(NTHREADS), LDS_BYTES, stream, p);
    }
#else
    p.ph_begin = 0; p.ph_end = N_PHASES;
    void* args[] = {&p};
    hipError_t e = hipLaunchCooperativeKernel((void*)mega_kernel, dim3(grid_blocks), dim3(NTHREADS), args, LDS_BYTES, stream);
    if (e != hipSuccess) fprintf(stderr, "cooperative launch failed: %s (grid %d)\n", hipGetErrorString(e), grid_blocks);
#endif
}
```
